# Optimizing an MI355X kernel written in HIP

```python
import math
import jax, jax.numpy as jnp
from jax import lax
import numpy as np

D_MODEL = 1024
BATCH = 8
SEQ = 2048
DEPTH = 1

D_MIX = D_MODEL
MLA_HEADS = 8
QK_NOPE = 64
QK_ROPE = 32
V_HEAD = 64
Q_RANK = 256
KV_RANK = 128
ROPE_THETA = 10000.0
Q_BLOCK = 128
MLA_OUT = MLA_HEADS * V_HEAD
GM_GROUPS = 8
GM_CH = (D_MIX - MLA_OUT) // GM_GROUPS
GM_OUT = GM_GROUPS * GM_CH
CHUNK = 128
IN_COLS = Q_RANK + KV_RANK + QK_ROPE + 2 * GM_OUT
N_GROUPS = 4
EXP_PER_GROUP = 8
N_EXPERTS = N_GROUPS * EXP_PER_GROUP
TOP_K = 2
EXPERT_FF = 512
MOE_BLOCK = 128
PLE_DIM = 256
EPS = 1e-6
ALPHA = (2.0 * DEPTH) ** 0.25
BETA = (8.0 * DEPTH) ** -0.25

kernel_name = "hymba_mla_gmlp_hiermoe_deepnorm_ple"


def layer_norm(x, g, b):
    xf = x.astype(jnp.float32)
    mu = jnp.mean(xf, -1, keepdims=True)
    var = jnp.mean(jnp.square(xf - mu), -1, keepdims=True)
    return ((xf - mu) * lax.rsqrt(var + EPS)).astype(x.dtype) * g + b


def rms_norm(x, g):
    xf = x.astype(jnp.float32)
    return (xf * lax.rsqrt(jnp.mean(xf * xf, -1, keepdims=True) + EPS)).astype(x.dtype) * g


def rope_angles(pos):
    inv = ROPE_THETA ** (-jnp.arange(0, QK_ROPE, 2, dtype=jnp.float32) / QK_ROPE)
    ang = pos.astype(jnp.float32)[..., None] * inv
    return jnp.cos(ang), jnp.sin(ang)


def apply_rope(x, cos, sin):
    x1, x2 = jnp.split(x.astype(jnp.float32), 2, axis=-1)
    return jnp.concatenate([x1 * cos - x2 * sin, x1 * sin + x2 * cos], -1).astype(x.dtype)


def mla_mixer(c_q, c_kv, k_rope, pos, q_norm_g, w_q_up, kv_norm_g, w_kv_up):
    B, S, _ = c_q.shape
    q = (rms_norm(c_q, q_norm_g) @ w_q_up).reshape(B, S, MLA_HEADS, QK_NOPE + QK_ROPE)
    kv = (rms_norm(c_kv, kv_norm_g) @ w_kv_up).reshape(B, S, MLA_HEADS, QK_NOPE + V_HEAD)
    cos, sin = rope_angles(pos)
    q_nope = q[..., :QK_NOPE]
    q_rope = apply_rope(q[..., QK_NOPE:], cos[:, :, None], sin[:, :, None])
    k_nope, v = kv[..., :QK_NOPE], kv[..., QK_NOPE:]
    k_rope = apply_rope(k_rope, cos, sin)
    scale = (QK_NOPE + QK_ROPE) ** -0.5
    outs = []
    for i in range(S // Q_BLOCK):
        q0, q1 = i * Q_BLOCK, (i + 1) * Q_BLOCK
        s = (jnp.einsum('bqhd,bkhd->bhqk', q_nope[:, q0:q1], k_nope[:, :q1])
             + jnp.einsum('bqhr,bkr->bhqk', q_rope[:, q0:q1], k_rope[:, :q1])).astype(jnp.float32) * scale
        causal = jnp.arange(q1)[None, :] <= jnp.arange(q0, q1)[:, None]
        s = jnp.where(causal, s, -1e30)
        pr = jax.nn.softmax(s, axis=-1).astype(v.dtype)
        outs.append(jnp.einsum('bhqk,bkhd->bqhd', pr, v[:, :q1]))
    return jnp.concatenate(outs, axis=1).reshape(B, S, MLA_OUT)


def chunked_gmlp(z, ln_g, ln_b, w_s, b_s):
    B, S, _ = z.shape
    z = jax.nn.gelu(z)
    u, v = z[..., :GM_OUT], z[..., GM_OUT:]
    v = layer_norm(v.reshape(B, S, GM_GROUPS, GM_CH),
                   ln_g.reshape(GM_GROUPS, GM_CH), ln_b.reshape(GM_GROUPS, GM_CH))
    v = v.reshape(B, S // CHUNK, CHUNK, GM_GROUPS, GM_CH)
    w = w_s * jnp.tril(jnp.ones((CHUNK, CHUNK), w_s.dtype))
    v = jnp.einsum('gts,bnsgc->bntgc', w, v) + b_s.T[None, None, :, :, None]
    return u * v.reshape(B, S, GM_OUT)


def hier_moe(x, w_rg, b_rg, w_re, b_re, w_gate, w_up, w_down):
    B, S, D = x.shape
    xt = x.reshape(-1, D)
    T = xt.shape[0]
    g_prob = jax.nn.softmax((xt @ w_rg).astype(jnp.float32) + b_rg, axis=-1)
    g_p, g_idx = lax.top_k(g_prob, 1)
    e_logits = ((xt @ w_re).astype(jnp.float32) + b_re).reshape(T, N_GROUPS, EXP_PER_GROUP)
    e_logits = e_logits[jnp.arange(T), g_idx[:, 0]]
    e_p, e_loc = lax.top_k(jax.nn.softmax(e_logits, axis=-1), TOP_K)
    gate = g_p * e_p / jnp.sum(e_p, -1, keepdims=True)
    expert = g_idx * EXP_PER_GROUP + e_loc
    A = T * TOP_K
    e_flat = expert.reshape(-1)
    tok_flat = jnp.repeat(jnp.arange(T), TOP_K)
    order = jnp.argsort(e_flat)
    e_sorted, tok_sorted = e_flat[order], tok_flat[order]
    gate_sorted = gate.reshape(-1)[order]
    counts = jnp.bincount(e_flat, length=N_EXPERTS)
    starts = jnp.cumsum(counts) - counts
    padded = (counts + MOE_BLOCK - 1) // MOE_BLOCK * MOE_BLOCK
    pad_ends = jnp.cumsum(padded)
    pad_starts = pad_ends - padded
    dest = pad_starts[e_sorted] + jnp.arange(A) - starts[e_sorted]
    NB = (A + MOE_BLOCK - 1) // MOE_BLOCK + N_EXPERTS
    P = NB * MOE_BLOCK
    buf = jnp.zeros((P, D), x.dtype).at[dest].set(xt[tok_sorted])
    block_expert = jnp.minimum(
        jnp.searchsorted(pad_ends, jnp.arange(NB) * MOE_BLOCK, side='right'), N_EXPERTS - 1)

    def expert_block(args):
        xb, e = args
        h = jax.nn.silu(xb @ w_gate[e]) * (xb @ w_up[e])
        return h @ w_down[e]

    y = lax.map(expert_block, (buf.reshape(NB, MOE_BLOCK, D), block_expert)).reshape(P, D)
    y = y[dest] * gate_sorted[:, None].astype(x.dtype)
    out = jnp.zeros((T, D), x.dtype).at[tok_sorted].add(y)
    return out.reshape(B, S, D)


def setup_inputs(seed: int = 0) -> dict:
    key = jax.random.key(seed)
    ks = iter(jax.random.split(key, 40))
    f32 = jnp.float32

    def nrm(shape, scale):
        return jax.random.normal(next(ks), shape, f32) * scale

    def gain(shape):
        return 1.0 + 0.05 * jax.random.normal(next(ks), shape, f32)

    L = DEPTH
    x = jax.random.normal(next(ks), (BATCH, SEQ, D_MODEL), f32)
    p = jax.random.normal(next(ks), (DEPTH, BATCH, SEQ, PLE_DIM), f32)
    positions = (jnp.arange(SEQ, dtype=jnp.int32)[None, :]
                 + jax.random.randint(next(ks), (BATCH, 1), 0, 1024, dtype=jnp.int32))
    return {
        "x": x,
        "p": p,
        "positions": positions,
        "w_in": nrm((L, D_MODEL, IN_COLS), D_MODEL ** -0.5),
        "q_norm_g": gain((L, Q_RANK)),
        "w_q_up": nrm((L, Q_RANK, MLA_HEADS * (QK_NOPE + QK_ROPE)), Q_RANK ** -0.5),
        "kv_norm_g": gain((L, KV_RANK)),
        "w_kv_up": nrm((L, KV_RANK, MLA_HEADS * (QK_NOPE + V_HEAD)), KV_RANK ** -0.5),
        "gm_ln_g": gain((L, GM_OUT)),
        "gm_ln_b": nrm((L, GM_OUT), 0.01),
        "gm_w_s": nrm((L, GM_GROUPS, CHUNK, CHUNK), CHUNK ** -0.5),
        "gm_b_s": gain((L, GM_GROUPS, CHUNK)),
        "mla_out_g": gain((L, MLA_OUT)),
        "gm_out_g": gain((L, GM_OUT)),
        "w_o": nrm((L, D_MIX, D_MODEL), BETA * D_MIX ** -0.5),
        "ln1_g": gain((L, D_MODEL)),
        "ln1_b": nrm((L, D_MODEL), 0.01),
        "w_rg": nrm((L, D_MODEL, N_GROUPS), D_MODEL ** -0.5),
        "b_rg": nrm((L, N_GROUPS), 0.01),
        "w_re": nrm((L, D_MODEL, N_EXPERTS), D_MODEL ** -0.5),
        "b_re": nrm((L, N_EXPERTS), 0.01),
        "w_gate": nrm((L, N_EXPERTS, D_MODEL, EXPERT_FF), D_MODEL ** -0.5),
        "w_up": nrm((L, N_EXPERTS, D_MODEL, EXPERT_FF), D_MODEL ** -0.5),
        "w_down": nrm((L, N_EXPERTS, EXPERT_FF, D_MODEL), BETA * EXPERT_FF ** -0.5),
        "ln2_g": gain((L, D_MODEL)),
        "ln2_b": nrm((L, D_MODEL), 0.01),
        "w_pg": nrm((L, D_MODEL, D_MODEL), D_MODEL ** -0.5),
        "b_pg": nrm((L, D_MODEL), 0.01),
        "w_pp": nrm((L, PLE_DIM, D_MODEL), BETA * PLE_DIM ** -0.5),
        "ln3_g": gain((L, D_MODEL)),
        "ln3_b": nrm((L, D_MODEL), 0.01),
    }


def reference(x, p, positions, w_in, q_norm_g, w_q_up, kv_norm_g, w_kv_up, gm_ln_g, gm_ln_b,
              gm_w_s, gm_b_s, mla_out_g, gm_out_g, w_o, ln1_g, ln1_b, w_rg, b_rg, w_re, b_re,
              w_gate, w_up, w_down, ln2_g, ln2_b, w_pg, b_pg, w_pp, ln3_g, ln3_b):
    c1 = Q_RANK
    c2 = c1 + KV_RANK
    c3 = c2 + QK_ROPE
    for i in range(DEPTH):
        h = x @ w_in[i]
        a = mla_mixer(h[..., :c1], h[..., c1:c2], h[..., c2:c3], positions,
                      q_norm_g[i], w_q_up[i], kv_norm_g[i], w_kv_up[i])
        g = chunked_gmlp(h[..., c3:], gm_ln_g[i], gm_ln_b[i], gm_w_s[i], gm_b_s[i])
        mix = jnp.concatenate([rms_norm(a, mla_out_g[i]), rms_norm(g, gm_out_g[i])], axis=-1) @ w_o[i]
        x = layer_norm(ALPHA * x + mix, ln1_g[i], ln1_b[i])
        moe = hier_moe(x, w_rg[i], b_rg[i], w_re[i], b_re[i], w_gate[i], w_up[i], w_down[i])
        x = layer_norm(ALPHA * x + moe, ln2_g[i], ln2_b[i])
        ple = jax.nn.sigmoid(x @ w_pg[i] + b_pg[i]) * (p[i] @ w_pp[i])
        x = layer_norm(ALPHA * x + ple, ln3_g[i], ln3_b[i])
    return x
```

```cpp
#include <hip/hip_runtime.h>
#include <hip/hip_cooperative_groups.h>
#include <stdint.h>
#include <math.h>
#include <stdio.h>
namespace cg = cooperative_groups;

#ifndef N_LAUNCH_MODE
#define N_LAUNCH_MODE 0
#endif

#define DEVINL __device__ __forceinline__
typedef unsigned short bf16_t;
typedef short bf16x8 __attribute__((ext_vector_type(8)));
typedef float f32x4 __attribute__((ext_vector_type(4)));
typedef unsigned u32x4 __attribute__((ext_vector_type(4)));

constexpr int T_ = 16384, D_ = 1024, SEQ_ = 2048;
constexpr float ALPHA_ = 1.189207115002721f;
constexpr float EPS_ = 1e-6f;
constexpr int LDK = 72;
constexpr int SMEM_BYTES = 2 * 128 * LDK * 2;

constexpr size_t MiB = 1ull << 20;
constexpr size_t WS_WGU = 0;
constexpr size_t WS_WD = 64 * MiB;
constexpr size_t WS_WPG = 96 * MiB;
constexpr size_t WS_WPP = 98 * MiB;
constexpr size_t WS_WIN = 98 * MiB + 512 * 1024;
constexpr size_t WS_WO = WS_WIN + 3 * MiB;
constexpr size_t WS_WQ = WS_WO + 2 * MiB;
constexpr size_t WS_WKV = WS_WQ + 512 * 1024;
constexpr size_t WS_WS = WS_WKV + 256 * 1024;
constexpr size_t WS_WRT = WS_WS + 256 * 1024;
constexpr size_t WS_CS = WS_WRT + 256 * 1024;
constexpr size_t WS_PB = WS_CS + 2 * MiB;
constexpr size_t WS_CNT = WS_PB + 8 * MiB;
constexpr size_t WS_LIST = WS_CNT + 4096;
constexpr size_t WS_GATEW = WS_LIST + 2 * MiB;
constexpr size_t WS_LATSS = WS_GATEW + 128 * 1024;
constexpr size_t WS_ASS = WS_LATSS + 512 * 1024;
constexpr size_t WS_GSS = WS_ASS + 512 * 1024;
constexpr size_t WS_RA = 119 * MiB;
constexpr size_t WS_RB = 151 * MiB;
constexpr size_t WS_RC = 183 * MiB;
constexpr size_t WS_END = 247 * MiB;
static_assert(WS_GSS + 512 * 1024 <= WS_RA, "ws overlap");

struct Params {
    const float* x; const float* p; const int* pos;
    const float* w_in; const float* q_norm_g; const float* w_q_up; const float* kv_norm_g; const float* w_kv_up;
    const float* gm_ln_g; const float* gm_ln_b; const float* gm_w_s; const float* gm_b_s;
    const float* mla_out_g; const float* gm_out_g; const float* w_o; const float* ln1_g; const float* ln1_b;
    const float* w_rg; const float* b_rg; const float* w_re; const float* b_re;
    const float* w_gate; const float* w_up; const float* w_down; const float* ln2_g; const float* ln2_b;
    const float* w_pg; const float* b_pg; const float* w_pp; const float* ln3_g; const float* ln3_b;
    float* out; unsigned char* ws;
    float inv_freq[16];
};

DEVINL unsigned pack2(float lo, float hi) { unsigned r; asm volatile("v_cvt_pk_bf16_f32 %0, %1, %2" : "=v"(r) : "v"(lo), "v"(hi)); return r; }
DEVINL uint2 pack4(float a, float b, float c, float d) { return make_uint2(pack2(a, b), pack2(c, d)); }
DEVINL uint2 pack4v(f32x4 v) { return make_uint2(pack2(v[0], v[1]), pack2(v[2], v[3])); }
DEVINL float bf2f(unsigned short b) { return __uint_as_float(((unsigned)b) << 16); }
DEVINL float bflo(unsigned u) { return __uint_as_float(u << 16); }
DEVINL float bfhi(unsigned u) { return __uint_as_float(u & 0xffff0000u); }
DEVINL float wave_sum(float v) {
#pragma unroll
    for (int o = 32; o >= 1; o >>= 1) v += __shfl_xor(v, o);
    return v;
}
DEVINL float gelu_tanh(float x) {
    const float z = 0.7978845608028654f * (x + 0.044715f * x * x * x);
    return x / (1.f + __expf(-2.f * z));
}

template <int MI, int NI, bool TRANS>
DEVINL void mma_ktile(f32x4 (&acc)[MI][NI], const bf16_t* sA, const bf16_t* sB, int lane) {
    const int r16 = lane & 15, kg = (lane >> 4) * 8;
#pragma unroll
    for (int ks = 0; ks < 2; ++ks) {
        bf16x8 a[MI], b[NI];
#pragma unroll
        for (int mi = 0; mi < MI; ++mi) a[mi] = *(const bf16x8*)(sA + (mi * 16 + r16) * LDK + ks * 32 + kg);
#pragma unroll
        for (int ni = 0; ni < NI; ++ni) b[ni] = *(const bf16x8*)(sB + (ni * 16 + r16) * LDK + ks * 32 + kg);
#pragma unroll
        for (int mi = 0; mi < MI; ++mi)
#pragma unroll
            for (int ni = 0; ni < NI; ++ni) {
                if (TRANS) acc[mi][ni] = __builtin_amdgcn_mfma_f32_16x16x32_bf16(a[mi], b[ni], acc[mi][ni], 0, 0, 0);
                else acc[mi][ni] = __builtin_amdgcn_mfma_f32_16x16x32_bf16(b[ni], a[mi], acc[mi][ni], 0, 0, 0);
            }
    }
}

template <bool TRANS, int NI, class ARowF>
DEVINL void gemm_core(f32x4 (&acc)[4][NI], ARowF arow, const bf16_t* __restrict__ Bt, int ldb, int K, bf16_t* smem) {
    bf16_t* sA = smem; bf16_t* sB = smem + 128 * LDK;
    const int t = threadIdx.x, lane = t & 63, w = t >> 6, wr = w >> 1, wc = w & 1;
    const int lrow = t >> 3, lkc = (t & 7) * 8;
    const bf16_t* ap[4]; const bf16_t* bp[NI];
#pragma unroll
    for (int i = 0; i < 4; ++i) ap[i] = arow(lrow + 32 * i) + lkc;
#pragma unroll
    for (int i = 0; i < NI; ++i) bp[i] = Bt + (size_t)(lrow + 32 * i) * ldb + lkc;
    u32x4 ra0, ra1, ra2, ra3, rb0, rb1, rb2, rb3;
    ra0 = *(const u32x4*)(ap[0]); ra1 = *(const u32x4*)(ap[1]); ra2 = *(const u32x4*)(ap[2]); ra3 = *(const u32x4*)(ap[3]);
    rb0 = *(const u32x4*)(bp[0]); rb1 = *(const u32x4*)(bp[1]);
    if (NI == 4) { rb2 = *(const u32x4*)(bp[NI - 2]); rb3 = *(const u32x4*)(bp[NI - 1]); }
#pragma nounroll
    for (int k0 = 0; k0 < K; k0 += 64) {
        __syncthreads();
        *(u32x4*)(sA + (lrow + 0) * LDK + lkc) = ra0; *(u32x4*)(sA + (lrow + 32) * LDK + lkc) = ra1;
        *(u32x4*)(sA + (lrow + 64) * LDK + lkc) = ra2; *(u32x4*)(sA + (lrow + 96) * LDK + lkc) = ra3;
        *(u32x4*)(sB + (lrow + 0) * LDK + lkc) = rb0; *(u32x4*)(sB + (lrow + 32) * LDK + lkc) = rb1;
        if (NI == 4) { *(u32x4*)(sB + (lrow + 64) * LDK + lkc) = rb2; *(u32x4*)(sB + (lrow + 96) * LDK + lkc) = rb3; }
        __syncthreads();
        if (k0 + 64 < K) {
            const int kn = k0 + 64;
            ra0 = *(const u32x4*)(ap[0] + kn); ra1 = *(const u32x4*)(ap[1] + kn); ra2 = *(const u32x4*)(ap[2] + kn); ra3 = *(const u32x4*)(ap[3] + kn);
            rb0 = *(const u32x4*)(bp[0] + kn); rb1 = *(const u32x4*)(bp[1] + kn);
            if (NI == 4) { rb2 = *(const u32x4*)(bp[NI - 2] + kn); rb3 = *(const u32x4*)(bp[NI - 1] + kn); }
        }
        mma_ktile<4, NI, TRANS>(acc, sA + wr * 64 * LDK, sB + wc * 16 * NI * LDK, lane);
    }
}

template <int NI>
DEVINL void zero_acc(f32x4 (&acc)[4][NI]) {
#pragma unroll
    for (int i = 0; i < 4; ++i)
#pragma unroll
        for (int j = 0; j < NI; ++j) acc[i][j] = (f32x4){0.f, 0.f, 0.f, 0.f};
}

struct WS {
    bf16_t *wgu, *wd, *wpg, *wpp, *win, *wo, *wq, *wkv, *wsb, *pb;
    float* wrt; float2* cs; int* cnt; int* list; float* gatew; float *lat_ss, *a_ss, *g_ss;
    bf16_t *xb, *q, *x1b; bf16_t *u, *vln, *ao, *H, *x2b; bf16_t *lat, *kr, *k, *vT, *go, *ymoe;
};
DEVINL WS make_ws(unsigned char* ws) {
    WS s;
    s.wgu = (bf16_t*)(ws + WS_WGU); s.wd = (bf16_t*)(ws + WS_WD); s.wpg = (bf16_t*)(ws + WS_WPG); s.wpp = (bf16_t*)(ws + WS_WPP);
    s.win = (bf16_t*)(ws + WS_WIN); s.wo = (bf16_t*)(ws + WS_WO); s.wq = (bf16_t*)(ws + WS_WQ); s.wkv = (bf16_t*)(ws + WS_WKV);
    s.wsb = (bf16_t*)(ws + WS_WS); s.wrt = (float*)(ws + WS_WRT); s.cs = (float2*)(ws + WS_CS); s.pb = (bf16_t*)(ws + WS_PB);
    s.cnt = (int*)(ws + WS_CNT); s.list = (int*)(ws + WS_LIST); s.gatew = (float*)(ws + WS_GATEW);
    s.lat_ss = (float*)(ws + WS_LATSS); s.a_ss = (float*)(ws + WS_ASS); s.g_ss = (float*)(ws + WS_GSS);
    s.xb = (bf16_t*)(ws + WS_RA); s.q = s.xb; s.x1b = s.xb;
    s.u = (bf16_t*)(ws + WS_RB); s.vln = (bf16_t*)(ws + WS_RB + 16 * MiB); s.ao = s.u; s.H = s.u; s.x2b = s.u;
    s.lat = (bf16_t*)(ws + WS_RC); s.kr = (bf16_t*)(ws + WS_RC + 12 * MiB); s.k = (bf16_t*)(ws + WS_RC + 13 * MiB);
    s.vT = (bf16_t*)(ws + WS_RC + 29 * MiB); s.go = (bf16_t*)(ws + WS_RC + 45 * MiB); s.ymoe = s.lat;
    return s;
}

DEVINL int drow_map(int mode, int n) {
    switch (mode) {
        case 1: if (n < 384) return n; if (n < 416) return 1408 + (n - 384); if (n < 928) return 384 + (n - 416); return 896 + (n - 928);
        case 2: { const int h = n / 96, d = n - h * 96; return d < 64 ? h * 64 + d : 512 + h * 32 + (d - 64); }
        case 3: return (n >> 4) * 32 + (n & 15);
        case 4: return (n >> 4) * 32 + 16 + (n & 15);
        default: return n;
    }
}
DEVINL void tr_tile(const float* __restrict__ src, int ld_s, int k0, int n0, int Nlim, bf16_t* __restrict__ dst, int ld_d,
                    const float* __restrict__ gain, int mode, float* smf) {
    const int t = threadIdx.x;
    __syncthreads();
#pragma unroll
    for (int i = 0; i < 4; ++i) {
        const int c = t + 256 * i, r = c >> 4, c4 = (c & 15) * 4, n = n0 + c4;
        float4 v = make_float4(0.f, 0.f, 0.f, 0.f);
        if (n < Nlim) v = *(const float4*)(src + (size_t)(k0 + r) * ld_s + n);
        const float g = gain ? gain[k0 + r] : 1.f;
        smf[r * 65 + c4 + 0] = v.x * g; smf[r * 65 + c4 + 1] = v.y * g; smf[r * 65 + c4 + 2] = v.z * g; smf[r * 65 + c4 + 3] = v.w * g;
    }
    __syncthreads();
#pragma unroll
    for (int i = 0; i < 2; ++i) {
        const int c = t + 256 * i, nn = c >> 3, kc = (c & 7) * 8, n = n0 + nn;
        if (n < Nlim) {
            float e[8];
#pragma unroll
            for (int j = 0; j < 8; ++j) e[j] = smf[(kc + j) * 65 + nn];
            uint4 o; o.x = pack2(e[0], e[1]); o.y = pack2(e[2], e[3]); o.z = pack2(e[4], e[5]); o.w = pack2(e[6], e[7]);
            *(uint4*)(dst + (size_t)drow_map(mode, n) * ld_d + k0 + kc) = o;
        }
    }
}

DEVINL void cvt8(const float* __restrict__ s, bf16_t* __restrict__ d) {
    const float4 a = *(const float4*)s, b = *(const float4*)(s + 4);
    uint4 o; o.x = pack2(a.x, a.y); o.y = pack2(a.z, a.w); o.z = pack2(b.x, b.y); o.w = pack2(b.z, b.w);
    *(uint4*)d = o;
}

__device__ void phase0(const Params& p, unsigned char* smem) {
    const WS s = make_ws(p.ws);
    const int G = gridDim.x, bid = blockIdx.x, t = threadIdx.x;
    const size_t gtid = (size_t)bid * 256 + t, gstride = (size_t)G * 256;
    for (size_t i = gtid; i < (size_t)T_ * D_ / 8; i += gstride) cvt8(p.x + i * 8, s.xb + i * 8);
    for (size_t i = gtid; i < (size_t)T_ * 256 / 8; i += gstride) cvt8(p.p + i * 8, s.pb + i * 8);
    for (size_t i = gtid; i < 8 * 128 * 128 / 8; i += gstride) {
        const int e0 = (int)i * 8, tt = (e0 >> 7) & 127, s0 = e0 & 127;
        float v[8];
#pragma unroll
        for (int j = 0; j < 8; ++j) v[j] = (s0 + j <= tt) ? p.gm_w_s[e0 + j] : 0.f;
        uint4 o; o.x = pack2(v[0], v[1]); o.y = pack2(v[2], v[3]); o.z = pack2(v[4], v[5]); o.w = pack2(v[6], v[7]);
        *(uint4*)(s.wsb + e0) = o;
    }
    for (size_t i = gtid; i < 36 * 1024; i += gstride) {
        const int n = (int)i >> 10, k = (int)i & 1023;
        s.wrt[i] = n < 4 ? p.w_rg[k * 4 + n] : p.w_re[k * 32 + (n - 4)];
    }
    for (size_t i = gtid; i < (size_t)T_ * 16; i += gstride) {
        const int tok = (int)(i >> 4), j = (int)i & 15;
        const float ang = (float)p.pos[tok] * p.inv_freq[j];
        float sn, cs; sincosf(ang, &sn, &cs);
        s.cs[i] = make_float2(cs, sn);
    }
    for (size_t i = gtid; i < 96 * 1024 / 8; i += gstride) *(uint4*)(s.win + 1440 * 1024 + i * 8) = make_uint4(0, 0, 0, 0);
    if (bid == 0 && t < 32) s.cnt[t] = 0;
    float* smf = (float*)smem;
    constexpr int J0 = 368, J1 = J0 + 48, J2 = J1 + 32, J3 = J2 + 256, J4 = J3 + 256, J5 = J4 + 64, J6 = J5 + 4096, J7 = J6 + 4096, J8 = J7 + 4096;
    for (int u = bid; u < J8; u += G) {
        if (u < J0) { const int kt = u / 23, nt = u % 23; tr_tile(p.w_in, 1440, kt * 64, nt * 64, 1440, s.win, 1024, nullptr, 1, smf); }
        else if (u < J1) { const int v = u - J0, kt = v / 12, nt = v % 12; tr_tile(p.w_q_up, 768, kt * 64, nt * 64, 768, s.wq, 256, p.q_norm_g, 2, smf); }
        else if (u < J2) { const int v = u - J1, kt = v / 16, nt = v % 16; tr_tile(p.w_kv_up, 1024, kt * 64, nt * 64, 1024, s.wkv, 128, p.kv_norm_g, 0, smf); }
        else if (u < J3) { const int v = u - J2, kt = v / 16, nt = v % 16; tr_tile(p.w_o, 1024, kt * 64, nt * 64, 1024, s.wo, 1024, kt < 8 ? p.mla_out_g : p.gm_out_g - 512, 0, smf); }
        else if (u < J4) { const int v = u - J3, kt = v / 16, nt = v % 16; tr_tile(p.w_pg, 1024, kt * 64, nt * 64, 1024, s.wpg, 1024, nullptr, 0, smf); }
        else if (u < J5) { const int v = u - J4, kt = v / 16, nt = v % 16; tr_tile(p.w_pp, 1024, kt * 64, nt * 64, 1024, s.wpp, 256, nullptr, 0, smf); }
        else if (u < J6) { const int v = u - J5, e = v >> 7, r = v & 127, kt = r >> 3, nt = r & 7;
            tr_tile(p.w_gate + (size_t)e * 1024 * 512, 512, kt * 64, nt * 64, 512, s.wgu + (size_t)e * 1024 * 1024, 1024, nullptr, 3, smf); }
        else if (u < J7) { const int v = u - J6, e = v >> 7, r = v & 127, kt = r >> 3, nt = r & 7;
            tr_tile(p.w_up + (size_t)e * 1024 * 512, 512, kt * 64, nt * 64, 512, s.wgu + (size_t)e * 1024 * 1024, 1024, nullptr, 4, smf); }
        else { const int v = u - J7, e = v >> 7, r = v & 127, kt = r >> 4, nt = r & 15;
            tr_tile(p.w_down + (size_t)e * 512 * 1024, 1024, kt * 64, nt * 64, 1024, s.wd + (size_t)e * 1024 * 512, 512, nullptr, 0, smf); }
    }
}

__device__ void p1_tile(const Params& p, const WS& s, int tm, int tn, bf16_t* smem) {
    f32x4 acc[4][4]; zero_acc(acc);
    const int m0 = tm * 128, n0 = tn * 128;
    const bf16_t* A = s.xb + (size_t)m0 * 1024;
    gemm_core<false, 4>(acc, [=](int r) { return A + (size_t)r * 1024; }, s.win + (size_t)n0 * 1024, 1024, 1024, smem);
    const int t = threadIdx.x, lane = t & 63, w = t >> 6, wr = w >> 1, wc = w & 1, r16 = lane & 15, g4 = (lane >> 4) * 4;
    if (tn < 3) {
#pragma unroll
        for (int mi = 0; mi < 4; ++mi) {
            const int m = m0 + wr * 64 + mi * 16 + r16; float ss = 0.f;
#pragma unroll
            for (int ni = 0; ni < 4; ++ni) {
                const f32x4 v = acc[mi][ni]; ss += v[0] * v[0] + v[1] * v[1] + v[2] * v[2] + v[3] * v[3];
                *(uint2*)(s.lat + (size_t)m * 384 + n0 + wc * 64 + ni * 16 + g4) = pack4v(v);
            }
            ss += __shfl_xor(ss, 16); ss += __shfl_xor(ss, 32);
            if (lane < 16) s.lat_ss[m * 8 + tn * 2 + wc] = ss;
        }
    } else if (tn < 7) {
#pragma unroll
        for (int mi = 0; mi < 4; ++mi) {
            const int m = m0 + wr * 64 + mi * 16 + r16;
#pragma unroll
            for (int ni = 0; ni < 4; ++ni) {
                const f32x4 v = acc[mi][ni];
                *(uint2*)(s.u + (size_t)m * 512 + (n0 - 384) + wc * 64 + ni * 16 + g4) = pack4(gelu_tanh(v[0]), gelu_tanh(v[1]), gelu_tanh(v[2]), gelu_tanh(v[3]));
            }
        }
    } else if (tn < 11) {
#pragma unroll
        for (int mi = 0; mi < 4; ++mi) {
            const int m = m0 + wr * 64 + mi * 16 + r16; float sum = 0.f;
#pragma unroll
            for (int ni = 0; ni < 4; ++ni)
#pragma unroll
                for (int r = 0; r < 4; ++r) { const float gv = gelu_tanh(acc[mi][ni][r]); acc[mi][ni][r] = gv; sum += gv; }
            sum += __shfl_xor(sum, 16); sum += __shfl_xor(sum, 32);
            const float mean = sum * (1.f / 64.f); float sq = 0.f;
#pragma unroll
            for (int ni = 0; ni < 4; ++ni)
#pragma unroll
                for (int r = 0; r < 4; ++r) { const float d = acc[mi][ni][r] - mean; sq += d * d; }
            sq += __shfl_xor(sq, 16); sq += __shfl_xor(sq, 32);
            const float rstd = rsqrtf(sq * (1.f / 64.f) + EPS_);
#pragma unroll
            for (int ni = 0; ni < 4; ++ni) {
                const int ch = (n0 - 896) + wc * 64 + ni * 16 + g4;
                const float4 gg = *(const float4*)(p.gm_ln_g + ch), bb = *(const float4*)(p.gm_ln_b + ch);
                const f32x4 v = acc[mi][ni];
                *(uint2*)(s.vln + (size_t)m * 512 + ch) = pack4((v[0] - mean) * rstd * gg.x + bb.x, (v[1] - mean) * rstd * gg.y + bb.y,
                                                               (v[2] - mean) * rstd * gg.z + bb.z, (v[3] - mean) * rstd * gg.w + bb.w);
            }
        }
    } else {
        if (wc == 0) {
#pragma unroll
            for (int mi = 0; mi < 4; ++mi) {
                const int m = m0 + wr * 64 + mi * 16 + r16;
                float o1[4], o2[4];
#pragma unroll
                for (int r = 0; r < 4; ++r) {
                    const float2 c = s.cs[m * 16 + g4 + r];
                    const float x1 = acc[mi][0][r], x2 = acc[mi][1][r];
                    o1[r] = x1 * c.x - x2 * c.y; o2[r] = x1 * c.y + x2 * c.x;
                }
                *(uint2*)(s.kr + (size_t)m * 32 + g4) = pack4(o1[0], o1[1], o1[2], o1[3]);
                *(uint2*)(s.kr + (size_t)m * 32 + 16 + g4) = pack4(o2[0], o2[1], o2[2], o2[3]);
            }
        }
    }
}
__device__ void phase1(const Params& p, unsigned char* smem) {
    const WS s = make_ws(p.ws);
    for (int u = blockIdx.x; u < 128 * 12; u += gridDim.x) p1_tile(p, s, u / 12, u % 12, (bf16_t*)smem);
}

constexpr float QSCALE_ = 0.10206207261596577f * 1.4426950408889634f;
__device__ void p2_q_tile(const Params& p, const WS& s, int tm, int tn, bf16_t* smem) {
    f32x4 acc[4][4]; zero_acc(acc);
    const int m0 = tm * 128, n0 = tn * 128;
    const bf16_t* A = s.lat + (size_t)m0 * 384;
    gemm_core<false, 4>(acc, [=](int r) { return A + (size_t)r * 384; }, s.wq + (size_t)n0 * 256, 256, 256, smem);
    const int t = threadIdx.x, lane = t & 63, w = t >> 6, wr = w >> 1, wc = w & 1, r16 = lane & 15, g4 = (lane >> 4) * 4;
#pragma unroll
    for (int mi = 0; mi < 4; ++mi) {
        const int m = m0 + wr * 64 + mi * 16 + r16;
        const float4 ssv = *(const float4*)(s.lat_ss + m * 8);
        const float rstd = rsqrtf((ssv.x + ssv.y + ssv.z + ssv.w) * (1.f / 256.f) + EPS_) * QSCALE_;
        if (tn < 4) {
            const int h = tn * 2 + wc;
#pragma unroll
            for (int ni = 0; ni < 4; ++ni) {
                const f32x4 v = acc[mi][ni] * rstd;
                *(uint2*)(s.q + ((size_t)m * 8 + h) * 96 + ni * 16 + g4) = pack4v(v);
            }
        } else {
#pragma unroll
            for (int pr = 0; pr < 2; ++pr) {
                const int h = (tn - 4) * 4 + wc * 2 + pr;
                float o1[4], o2[4];
#pragma unroll
                for (int r = 0; r < 4; ++r) {
                    const float2 c = s.cs[m * 16 + g4 + r];
                    const float x1 = acc[mi][2 * pr][r] * rstd, x2 = acc[mi][2 * pr + 1][r] * rstd;
                    o1[r] = x1 * c.x - x2 * c.y; o2[r] = x1 * c.y + x2 * c.x;
                }
                *(uint2*)(s.q + ((size_t)m * 8 + h) * 96 + 64 + g4) = pack4(o1[0], o1[1], o1[2], o1[3]);
                *(uint2*)(s.q + ((size_t)m * 8 + h) * 96 + 80 + g4) = pack4(o2[0], o2[1], o2[2], o2[3]);
            }
        }
    }
}
__device__ void p2_kv_tile(const Params& p, const WS& s, int tm, int h, bf16_t* smem) {
    f32x4 acc[4][4]; zero_acc(acc);
    const int m0 = tm * 128;
    const bf16_t* A = s.lat + (size_t)m0 * 384 + 256;
    gemm_core<true, 4>(acc, [=](int r) { return A + (size_t)r * 384; }, s.wkv + (size_t)h * 128 * 128, 128, 128, smem);
    const int t = threadIdx.x, lane = t & 63, w = t >> 6, wr = w >> 1, wc = w & 1, r16 = lane & 15, g4 = (lane >> 4) * 4;
    const int b = m0 >> 11, sb = m0 & 2047;
#pragma unroll
    for (int mi = 0; mi < 4; ++mi) {
        const int mb = m0 + wr * 64 + mi * 16 + g4;
        float rs[4];
#pragma unroll
        for (int r = 0; r < 4; ++r) rs[r] = rsqrtf((s.lat_ss[(mb + r) * 8 + 4] + s.lat_ss[(mb + r) * 8 + 5]) * (1.f / 128.f) + EPS_);
        if (wc == 0) {
#pragma unroll
            for (int ni = 0; ni < 4; ++ni)
#pragma unroll
                for (int r = 0; r < 4; ++r)
                    s.k[((size_t)(mb + r) * 8 + h) * 64 + ni * 16 + r16] = (bf16_t)(pack2(acc[mi][ni][r] * rs[r], 0.f) & 0xffffu);
        } else {
#pragma unroll
            for (int ni = 0; ni < 4; ++ni) {
                const int dv = ni * 16 + r16, s0 = sb + wr * 64 + mi * 16 + g4;
                const f32x4 v = acc[mi][ni];
                *(uint2*)(s.vT + ((size_t)((b * 8 + h) * 64 + dv)) * 2048 + s0) = pack4(v[0] * rs[0], v[1] * rs[1], v[2] * rs[2], v[3] * rs[3]);
            }
        }
    }
}
__device__ void p2_gmlp_unit(const Params& p, const WS& s, int cidx, int g, bf16_t* smem) {
    bf16_t* sA = smem; bf16_t* sB = smem + 128 * LDK;
    const int t = threadIdx.x, lane = t & 63, w = t >> 6, r16 = lane & 15, g4 = (lane >> 4) * 4;
    const int tok0 = cidx * 128;
    f32x4 acc[2][4];
#pragma unroll
    for (int i = 0; i < 2; ++i)
#pragma unroll
        for (int j = 0; j < 4; ++j) acc[i][j] = (f32x4){0.f, 0.f, 0.f, 0.f};
    for (int kh = 0; kh < 2; ++kh) {
        __syncthreads();
#pragma unroll
        for (int i = 0; i < 4; ++i) {
            const int row = (t >> 3) + 32 * i, kc = (t & 7) * 8;
            *(uint4*)(sA + row * LDK + kc) = *(const uint4*)(s.wsb + ((size_t)g * 128 + row) * 128 + kh * 64 + kc);
        }
#pragma unroll
        for (int i = 0; i < 2; ++i) {
            const int c = t + 256 * i, sr = c >> 3, cc = (c & 7) * 8;
            const uint4 v = *(const uint4*)(s.vln + (size_t)(tok0 + kh * 64 + sr) * 512 + g * 64 + cc);
            sB[(cc + 0) * LDK + sr] = (bf16_t)(v.x & 0xffff); sB[(cc + 1) * LDK + sr] = (bf16_t)(v.x >> 16);
            sB[(cc + 2) * LDK + sr] = (bf16_t)(v.y & 0xffff); sB[(cc + 3) * LDK + sr] = (bf16_t)(v.y >> 16);
            sB[(cc + 4) * LDK + sr] = (bf16_t)(v.z & 0xffff); sB[(cc + 5) * LDK + sr] = (bf16_t)(v.z >> 16);
            sB[(cc + 6) * LDK + sr] = (bf16_t)(v.w & 0xffff); sB[(cc + 7) * LDK + sr] = (bf16_t)(v.w >> 16);
        }
        __syncthreads();
        mma_ktile<2, 4, false>(acc, sA + w * 32 * LDK, sB, lane);
    }
#pragma unroll
    for (int mi = 0; mi < 2; ++mi) {
        const int tt = w * 32 + mi * 16 + r16, tok = tok0 + tt;
        const float bias = p.gm_b_s[g * 128 + tt]; float ss = 0.f;
#pragma unroll
        for (int ni = 0; ni < 4; ++ni) {
            const int c = g * 64 + ni * 16 + g4;
            const uint2 uu = *(const uint2*)(s.u + (size_t)tok * 512 + c);
            const f32x4 a = acc[mi][ni];
            const float v0 = bflo(uu.x) * (a[0] + bias), v1 = bfhi(uu.x) * (a[1] + bias), v2 = bflo(uu.y) * (a[2] + bias), v3 = bfhi(uu.y) * (a[3] + bias);
            ss += v0 * v0 + v1 * v1 + v2 * v2 + v3 * v3;
            *(uint2*)(s.go + (size_t)tok * 512 + c) = pack4(v0, v1, v2, v3);
        }
        ss += __shfl_xor(ss, 16); ss += __shfl_xor(ss, 32);
        if (lane < 16) s.g_ss[tok * 8 + g] = ss;
    }
}
__device__ void phase2(const Params& p, unsigned char* smem) {
    const WS s = make_ws(p.ws);
    constexpr int NQ = 128 * 6, NKV = 128 * 8, NG = 128 * 8;
    for (int u = blockIdx.x; u < NQ + NKV + NG; u += gridDim.x) {
        if (u < NQ) p2_q_tile(p, s, u / 6, u % 6, (bf16_t*)smem);
        else if (u < NQ + NKV) { const int v = u - NQ; p2_kv_tile(p, s, v >> 3, v & 7, (bf16_t*)smem); }
        else { const int v = u - NQ - NKV; p2_gmlp_unit(p, s, v >> 3, v & 7, (bf16_t*)smem); }
    }
}

__device__ void phase3(const Params& p, unsigned char* smem) {
    const WS s = make_ws(p.ws);
    const int t = threadIdx.x, w = t >> 6;
    for (int u = blockIdx.x; u < 8 * 8 * 8; u += gridDim.x) {
        const int qb = u & 7, h = (u >> 3) & 7, b = u >> 6;
        const int qi = qb * 256 + t, tok = b * 2048 + qi;
        float q[96], o[64];
        const bf16_t* qp = s.q + ((size_t)tok * 8 + h) * 96;
#pragma unroll
        for (int d = 0; d < 96; ++d) q[d] = bf2f(qp[d]);
#pragma unroll
        for (int d = 0; d < 64; ++d) o[d] = 0.f;
        float mx = -1e30f, l = 0.f;
        const int jmax = qb * 256 + (w + 1) * 64 - 1;
        for (int j = 0; j <= jmax; ++j) {
            const int tj = b * 2048 + j;
            const bf16_t* kp = s.k + ((size_t)tj * 8 + h) * 64;
            const bf16_t* krp = s.kr + (size_t)tj * 32;
            float sc = 0.f;
#pragma unroll
            for (int d = 0; d < 64; ++d) sc += q[d] * bf2f(kp[d]);
#pragma unroll
            for (int d = 0; d < 32; ++d) sc += q[64 + d] * bf2f(krp[d]);
            if (j <= qi) {
                const float mn = fmaxf(mx, sc), al = exp2f(mx - mn), pj = exp2f(sc - mn);
                l = l * al + pj; mx = mn;
                const bf16_t* vp = s.vT + ((size_t)(b * 8 + h) * 64) * 2048 + j;
#pragma unroll
                for (int d = 0; d < 64; ++d) o[d] = o[d] * al + pj * bf2f(vp[(size_t)d * 2048]);
            }
        }
        const float inv = 1.f / l; float ss = 0.f;
#pragma unroll
        for (int d = 0; d < 64; ++d) { o[d] *= inv; ss += o[d] * o[d]; }
        bf16_t* op = s.ao + (size_t)tok * 512 + h * 64;
#pragma unroll
        for (int d = 0; d < 64; d += 4) *(uint2*)(op + d) = pack4(o[d], o[d + 1], o[d + 2], o[d + 3]);
        s.a_ss[tok * 8 + h] = ss;
    }
}

__device__ void p4_tile(const Params& p, const WS& s, int tm, int tn, bf16_t* smem, float* y1) {
    f32x4 acc[4][4]; zero_acc(acc);
    const int m0 = tm * 128, n0 = tn * 128;
    const int t = threadIdx.x, lane = t & 63, w = t >> 6, wr = w >> 1, wc = w & 1, r16 = lane & 15, g4 = (lane >> 4) * 4;
    const bf16_t* A1 = s.ao + (size_t)m0 * 512;
    gemm_core<false, 4>(acc, [=](int r) { return A1 + (size_t)r * 512; }, s.wo + (size_t)n0 * 1024, 1024, 512, smem);
    float rg[4];
#pragma unroll
    for (int mi = 0; mi < 4; ++mi) {
        const int m = m0 + wr * 64 + mi * 16 + r16;
        const float4 a0 = *(const float4*)(s.a_ss + m * 8), a1 = *(const float4*)(s.a_ss + m * 8 + 4);
        const float4 g0 = *(const float4*)(s.g_ss + m * 8), g1 = *(const float4*)(s.g_ss + m * 8 + 4);
        const float ra = rsqrtf((a0.x + a0.y + a0.z + a0.w + a1.x + a1.y + a1.z + a1.w) * (1.f / 512.f) + EPS_);
        rg[mi] = rsqrtf((g0.x + g0.y + g0.z + g0.w + g1.x + g1.y + g1.z + g1.w) * (1.f / 512.f) + EPS_);
        const float sc = ra / rg[mi];
#pragma unroll
        for (int ni = 0; ni < 4; ++ni) acc[mi][ni] = acc[mi][ni] * sc;
    }
    const bf16_t* A2 = s.go + (size_t)m0 * 512;
    gemm_core<false, 4>(acc, [=](int r) { return A2 + (size_t)r * 512; }, s.wo + (size_t)n0 * 1024 + 512, 1024, 512, smem);
#pragma unroll
    for (int mi = 0; mi < 4; ++mi) {
        const int m = m0 + wr * 64 + mi * 16 + r16;
#pragma unroll
        for (int ni = 0; ni < 4; ++ni) {
            const int c = n0 + wc * 64 + ni * 16 + g4;
            const float4 xv = *(const float4*)(p.x + (size_t)m * 1024 + c);
            const f32x4 a = acc[mi][ni] * rg[mi];
            *(float4*)(y1 + (size_t)m * 1024 + c) = make_float4(ALPHA_ * xv.x + a[0], ALPHA_ * xv.y + a[1], ALPHA_ * xv.z + a[2], ALPHA_ * xv.w + a[3]);
        }
    }
}
__device__ void phase4(const Params& p, unsigned char* smem) {
    const WS s = make_ws(p.ws);
    for (int u = blockIdx.x; u < 128 * 8; u += gridDim.x) p4_tile(p, s, u >> 3, u & 7, (bf16_t*)smem, p.out);
}

__device__ void phase5(const Params& p, unsigned char* smem) {
    const WS s = make_ws(p.ws);
    const int t = threadIdx.x, lane = t & 63, w = t >> 6;
    volatile float* slog = (volatile float*)smem + w * 160;
    const float* y1 = p.out;
    for (int wu = blockIdx.x * 4 + w; wu < T_ / 4; wu += gridDim.x * 4) {
        const int tok0 = wu * 4;
        float xv[4][16];
#pragma unroll
        for (int tk = 0; tk < 4; ++tk) {
            const float* row = y1 + (size_t)(tok0 + tk) * 1024;
            float sum = 0.f;
#pragma unroll
            for (int i = 0; i < 4; ++i) {
                const float4 v = *(const float4*)(row + i * 256 + lane * 4);
                xv[tk][i * 4 + 0] = v.x; xv[tk][i * 4 + 1] = v.y; xv[tk][i * 4 + 2] = v.z; xv[tk][i * 4 + 3] = v.w;
                sum += v.x + v.y + v.z + v.w;
            }
            const float mean = wave_sum(sum) * (1.f / 1024.f);
            float sq = 0.f;
#pragma unroll
            for (int i = 0; i < 16; ++i) { const float d = xv[tk][i] - mean; sq += d * d; }
            const float rstd = rsqrtf(wave_sum(sq) * (1.f / 1024.f) + EPS_);
#pragma unroll
            for (int i = 0; i < 4; ++i) {
                const int c = i * 256 + lane * 4;
                const float4 gg = *(const float4*)(p.ln1_g + c), bb = *(const float4*)(p.ln1_b + c);
                const float a0 = (xv[tk][i * 4 + 0] - mean) * rstd * gg.x + bb.x, a1 = (xv[tk][i * 4 + 1] - mean) * rstd * gg.y + bb.y;
                const float a2 = (xv[tk][i * 4 + 2] - mean) * rstd * gg.z + bb.z, a3 = (xv[tk][i * 4 + 3] - mean) * rstd * gg.w + bb.w;
                xv[tk][i * 4 + 0] = a0; xv[tk][i * 4 + 1] = a1; xv[tk][i * 4 + 2] = a2; xv[tk][i * 4 + 3] = a3;
                *(uint2*)(s.x1b + (size_t)(tok0 + tk) * 1024 + c) = pack4(a0, a1, a2, a3);
            }
        }
        for (int n = 0; n < 36; ++n) {
            const float* wr_ = s.wrt + n * 1024;
            float d[4] = {0.f, 0.f, 0.f, 0.f};
#pragma unroll
            for (int i = 0; i < 4; ++i) {
                const float4 wv = *(const float4*)(wr_ + i * 256 + lane * 4);
#pragma unroll
                for (int tk = 0; tk < 4; ++tk)
                    d[tk] += xv[tk][i * 4 + 0] * wv.x + xv[tk][i * 4 + 1] * wv.y + xv[tk][i * 4 + 2] * wv.z + xv[tk][i * 4 + 3] * wv.w;
            }
            const float bias = n < 4 ? p.b_rg[n] : p.b_re[n - 4];
#pragma unroll
            for (int tk = 0; tk < 4; ++tk) { const float r = wave_sum(d[tk]) + bias; if (lane == 0) slog[tk * 40 + n] = r; }
        }
        __builtin_amdgcn_wave_barrier();
        if (lane < 4) {
            const int tk = lane, tok = tok0 + tk;
            const float l0 = slog[tk * 40 + 0], l1 = slog[tk * 40 + 1], l2 = slog[tk * 40 + 2], l3 = slog[tk * 40 + 3];
            int gi = 0; float gm = l0;
            if (l1 > gm) { gm = l1; gi = 1; }
            if (l2 > gm) { gm = l2; gi = 2; }
            if (l3 > gm) { gm = l3; gi = 3; }
            const float gp = 1.f / (expf(l0 - gm) + expf(l1 - gm) + expf(l2 - gm) + expf(l3 - gm));
            float le[8];
#pragma unroll
            for (int j = 0; j < 8; ++j) le[j] = slog[tk * 40 + 4 + gi * 8 + j];
            int i0 = 0; float m0v = le[0];
#pragma unroll
            for (int j = 1; j < 8; ++j) if (le[j] > m0v) { m0v = le[j]; i0 = j; }
            int i1 = -1; float m1v = -3.0e38f;
#pragma unroll
            for (int j = 0; j < 8; ++j) if (j != i0 && le[j] > m1v) { m1v = le[j]; i1 = j; }
            const float pe1 = expf(m1v - m0v);
            const float gate0 = gp / (1.f + pe1), gate1 = gp * pe1 / (1.f + pe1);
            const int e0 = gi * 8 + i0, e1 = gi * 8 + i1;
            const int pos0 = atomicAdd(&s.cnt[e0], 1); s.list[e0 * 16384 + pos0] = tok * 2; s.gatew[tok * 2] = gate0;
            const int pos1 = atomicAdd(&s.cnt[e1], 1); s.list[e1 * 16384 + pos1] = tok * 2 + 1; s.gatew[tok * 2 + 1] = gate1;
        }
        __builtin_amdgcn_wave_barrier();
    }
}

struct MoeMeta { int cnt[32]; int tstart[33]; int hbase[33]; };
DEVINL void moe_meta(const WS& s, MoeMeta* mm) {
    __syncthreads();
    if (threadIdx.x == 0) {
        int ts = 0, hb = 0;
        for (int e = 0; e < 32; ++e) { const int c = s.cnt[e]; mm->cnt[e] = c; mm->tstart[e] = ts; mm->hbase[e] = hb; ts += (c + 127) >> 7; hb += c; }
        mm->tstart[32] = ts; mm->hbase[32] = hb;
    }
    __syncthreads();
}
__device__ void phase6(const Params& p, unsigned char* smem, MoeMeta* mm) {
    const WS s = make_ws(p.ws);
    moe_meta(s, mm);
    const int total = mm->tstart[32] * 8;
    const int t = threadIdx.x, lane = t & 63, w = t >> 6, wr = w >> 1, wc = w & 1, r16 = lane & 15, g4 = (lane >> 4) * 4;
    for (int u = blockIdx.x; u < total; u += gridDim.x) {
        const int ti = u >> 3, tn = u & 7;
        int e = 0; while (mm->tstart[e + 1] <= ti) ++e;
        const int i = ti - mm->tstart[e], nrows = min(128, mm->cnt[e] - i * 128);
        const int* lst = s.list + e * 16384 + i * 128;
        const bf16_t* x1b = s.x1b;
        f32x4 acc[4][4]; zero_acc(acc);
        gemm_core<false, 4>(acc, [=](int r) { const int aid = lst[min(r, nrows - 1)]; return x1b + (size_t)(aid >> 1) * 1024; },
                         s.wgu + (size_t)e * 1024 * 1024 + (size_t)tn * 128 * 1024, 1024, 1024, (bf16_t*)smem);
        const size_t hrow0 = (size_t)mm->hbase[e] + i * 128;
#pragma unroll
        for (int mi = 0; mi < 4; ++mi) {
            const int r = wr * 64 + mi * 16 + r16;
            if (r < nrows) {
#pragma unroll
                for (int j = 0; j < 2; ++j) {
                    const f32x4 gt = acc[mi][2 * j], up = acc[mi][2 * j + 1];
                    float hv[4];
#pragma unroll
                    for (int q = 0; q < 4; ++q) hv[q] = gt[q] / (1.f + __expf(-gt[q])) * up[q];
                    *(uint2*)(s.H + (hrow0 + r) * 512 + tn * 64 + wc * 32 + j * 16 + g4) = pack4(hv[0], hv[1], hv[2], hv[3]);
                }
            }
        }
    }
}
__device__ void phase7(const Params& p, unsigned char* smem, MoeMeta* mm) {
    const WS s = make_ws(p.ws);
    moe_meta(s, mm);
    const int total = mm->tstart[32] * 8;
    const int t = threadIdx.x, lane = t & 63, w = t >> 6, wr = w >> 1, wc = w & 1, r16 = lane & 15, g4 = (lane >> 4) * 4;
    for (int u = blockIdx.x; u < total; u += gridDim.x) {
        const int ti = u >> 3, tn = u & 7;
        int e = 0; while (mm->tstart[e + 1] <= ti) ++e;
        const int i = ti - mm->tstart[e], nrows = min(128, mm->cnt[e] - i * 128);
        const int* lst = s.list + e * 16384 + i * 128;
        const bf16_t* Hb = s.H + ((size_t)mm->hbase[e] + i * 128) * 512;
        f32x4 acc[4][4]; zero_acc(acc);
        gemm_core<false, 4>(acc, [=](int r) { return Hb + (size_t)min(r, nrows - 1) * 512; },
                         s.wd + (size_t)e * 1024 * 512 + (size_t)tn * 128 * 512, 512, 512, (bf16_t*)smem);
#pragma unroll
        for (int mi = 0; mi < 4; ++mi) {
            const int r = wr * 64 + mi * 16 + r16;
            if (r < nrows) {
                const int aid = lst[r]; const float gw = s.gatew[aid];
#pragma unroll
                for (int ni = 0; ni < 4; ++ni) {
                    const f32x4 v = acc[mi][ni] * gw;
                    *(uint2*)(s.ymoe + (size_t)aid * 1024 + tn * 128 + wc * 64 + ni * 16 + g4) = pack4v(v);
                }
            }
        }
    }
}

__device__ void phase8(const Params& p, unsigned char* smem) {
    const WS s = make_ws(p.ws);
    const int t = threadIdx.x, lane = t & 63, w = t >> 6;
    for (int tok = blockIdx.x * 4 + w; tok < T_; tok += gridDim.x * 4) {
        float v[16]; float sum = 0.f;
#pragma unroll
        for (int i = 0; i < 4; ++i) {
            const int c = i * 256 + lane * 4;
            const uint2 a = *(const uint2*)(s.x1b + (size_t)tok * 1024 + c);
            const uint2 y0 = *(const uint2*)(s.ymoe + (size_t)(tok * 2) * 1024 + c), y1 = *(const uint2*)(s.ymoe + (size_t)(tok * 2 + 1) * 1024 + c);
            v[i * 4 + 0] = ALPHA_ * bflo(a.x) + (bflo(y0.x) + bflo(y1.x)); v[i * 4 + 1] = ALPHA_ * bfhi(a.x) + (bfhi(y0.x) + bfhi(y1.x));
            v[i * 4 + 2] = ALPHA_ * bflo(a.y) + (bflo(y0.y) + bflo(y1.y)); v[i * 4 + 3] = ALPHA_ * bfhi(a.y) + (bfhi(y0.y) + bfhi(y1.y));
            sum += v[i * 4 + 0] + v[i * 4 + 1] + v[i * 4 + 2] + v[i * 4 + 3];
        }
        const float mean = wave_sum(sum) * (1.f / 1024.f); float sq = 0.f;
#pragma unroll
        for (int i = 0; i < 16; ++i) { const float d = v[i] - mean; sq += d * d; }
        const float rstd = rsqrtf(wave_sum(sq) * (1.f / 1024.f) + EPS_);
#pragma unroll
        for (int i = 0; i < 4; ++i) {
            const int c = i * 256 + lane * 4;
            const float4 gg = *(const float4*)(p.ln2_g + c), bb = *(const float4*)(p.ln2_b + c);
            *(uint2*)(s.x2b + (size_t)tok * 1024 + c) = pack4((v[i * 4 + 0] - mean) * rstd * gg.x + bb.x, (v[i * 4 + 1] - mean) * rstd * gg.y + bb.y,
                                                             (v[i * 4 + 2] - mean) * rstd * gg.z + bb.z, (v[i * 4 + 3] - mean) * rstd * gg.w + bb.w);
        }
    }
}

__device__ void p9_tile(const Params& p, const WS& s, int tm, int tn, bf16_t* smem) {
    const int m0 = tm * 128, n0 = tn * 64;
    const int t = threadIdx.x, lane = t & 63, w = t >> 6, wr = w >> 1, wc = w & 1, r16 = lane & 15, g4 = (lane >> 4) * 4;
    f32x4 acc2[4][2]; zero_acc(acc2);
    const bf16_t* A2 = s.pb + (size_t)m0 * 256;
    gemm_core<false, 2>(acc2, [=](int r) { return A2 + (size_t)r * 256; }, s.wpp + (size_t)n0 * 256, 256, 256, smem);
    f32x4 acc[4][2]; zero_acc(acc);
    const bf16_t* A1 = s.x2b + (size_t)m0 * 1024;
    gemm_core<false, 2>(acc, [=](int r) { return A1 + (size_t)r * 1024; }, s.wpg + (size_t)n0 * 1024, 1024, 1024, smem);
#pragma unroll
    for (int mi = 0; mi < 4; ++mi) {
        const int m = m0 + wr * 64 + mi * 16 + r16;
#pragma unroll
        for (int ni = 0; ni < 2; ++ni) {
            const int c = n0 + wc * 32 + ni * 16 + g4;
            const float4 bg = *(const float4*)(p.b_pg + c);
            const uint2 xr = *(const uint2*)(s.x2b + (size_t)m * 1024 + c);
            const f32x4 a = acc[mi][ni], pp = acc2[mi][ni];
            float4 o;
            o.x = ALPHA_ * bflo(xr.x) + pp[0] / (1.f + __expf(-(a[0] + bg.x)));
            o.y = ALPHA_ * bfhi(xr.x) + pp[1] / (1.f + __expf(-(a[1] + bg.y)));
            o.z = ALPHA_ * bflo(xr.y) + pp[2] / (1.f + __expf(-(a[2] + bg.z)));
            o.w = ALPHA_ * bfhi(xr.y) + pp[3] / (1.f + __expf(-(a[3] + bg.w)));
            *(float4*)(p.out + (size_t)m * 1024 + c) = o;
        }
    }
}
__device__ void phase9(const Params& p, unsigned char* smem) {
    const WS s = make_ws(p.ws);
    for (int u = blockIdx.x; u < 128 * 16; u += gridDim.x) p9_tile(p, s, u >> 4, u & 15, (bf16_t*)smem);
}

__device__ void phase10(const Params& p, unsigned char* smem) {
    const int t = threadIdx.x, lane = t & 63, w = t >> 6;
    for (int tok = blockIdx.x * 4 + w; tok < T_; tok += gridDim.x * 4) {
        float* row = p.out + (size_t)tok * 1024;
        float v[16]; float sum = 0.f;
#pragma unroll
        for (int i = 0; i < 4; ++i) {
            const float4 a = *(const float4*)(row + i * 256 + lane * 4);
            v[i * 4 + 0] = a.x; v[i * 4 + 1] = a.y; v[i * 4 + 2] = a.z; v[i * 4 + 3] = a.w; sum += a.x + a.y + a.z + a.w;
        }
        const float mean = wave_sum(sum) * (1.f / 1024.f); float sq = 0.f;
#pragma unroll
        for (int i = 0; i < 16; ++i) { const float d = v[i] - mean; sq += d * d; }
        const float rstd = rsqrtf(wave_sum(sq) * (1.f / 1024.f) + EPS_);
#pragma unroll
        for (int i = 0; i < 4; ++i) {
            const int c = i * 256 + lane * 4;
            const float4 gg = *(const float4*)(p.ln3_g + c), bb = *(const float4*)(p.ln3_b + c);
            *(float4*)(row + c) = make_float4((v[i * 4 + 0] - mean) * rstd * gg.x + bb.x, (v[i * 4 + 1] - mean) * rstd * gg.y + bb.y,
                                              (v[i * 4 + 2] - mean) * rstd * gg.z + bb.z, (v[i * 4 + 3] - mean) * rstd * gg.w + bb.w);
        }
    }
}

constexpr int NPHASE = 11;
template <int LO, int HI>
__global__ void __launch_bounds__(256, 2) fwd_kernel(Params p) {
    __shared__ __attribute__((aligned(16))) unsigned char smem[SMEM_BYTES];
    __shared__ MoeMeta mm;
#define PH(k) if (LO <= (k) && (k) < HI)
#define SYNC(k) if (LO <= (k) && (k) + 1 < HI) { cg::this_grid().sync(); }
    PH(0) { phase0(p, smem); } SYNC(0)
    PH(1) { phase1(p, smem); } SYNC(1)
    PH(2) { phase2(p, smem); } SYNC(2)
    PH(3) { phase3(p, smem); } SYNC(3)
    PH(4) { phase4(p, smem); } SYNC(4)
    PH(5) { phase5(p, smem); } SYNC(5)
    PH(6) { phase6(p, smem, &mm); } SYNC(6)
    PH(7) { phase7(p, smem, &mm); } SYNC(7)
    PH(8) { phase8(p, smem); } SYNC(8)
    PH(9) { phase9(p, smem); } SYNC(9)
    PH(10) { phase10(p, smem); }
#undef PH
#undef SYNC
}

template <int K> static void launch_one(const Params& prm, int grid, hipStream_t stream) {
    hipLaunchKernelGGL((fwd_kernel<K, K + 1>), dim3(grid), dim3(256), 0, stream, prm);
}

extern "C" void kernel_launch(void* const* d_in, const int* in_sizes, int n_in, void* d_out, int out_size, void* d_ws, size_t ws_size,
                              hipStream_t stream) {
    if (n_in != 31 || ws_size < WS_END) { fprintf(stderr, "kernel_launch: unexpected n_in %d / ws_size %zu\n", n_in, ws_size); return; }
    Params prm{};
    prm.x = (const float*)d_in[0]; prm.p = (const float*)d_in[1]; prm.pos = (const int*)d_in[2];
    prm.w_in = (const float*)d_in[3]; prm.q_norm_g = (const float*)d_in[4]; prm.w_q_up = (const float*)d_in[5];
    prm.kv_norm_g = (const float*)d_in[6]; prm.w_kv_up = (const float*)d_in[7]; prm.gm_ln_g = (const float*)d_in[8];
    prm.gm_ln_b = (const float*)d_in[9]; prm.gm_w_s = (const float*)d_in[10]; prm.gm_b_s = (const float*)d_in[11];
    prm.mla_out_g = (const float*)d_in[12]; prm.gm_out_g = (const float*)d_in[13]; prm.w_o = (const float*)d_in[14];
    prm.ln1_g = (const float*)d_in[15]; prm.ln1_b = (const float*)d_in[16]; prm.w_rg = (const float*)d_in[17];
    prm.b_rg = (const float*)d_in[18]; prm.w_re = (const float*)d_in[19]; prm.b_re = (const float*)d_in[20];
    prm.w_gate = (const float*)d_in[21]; prm.w_up = (const float*)d_in[22]; prm.w_down = (const float*)d_in[23];
    prm.ln2_g = (const float*)d_in[24]; prm.ln2_b = (const float*)d_in[25]; prm.w_pg = (const float*)d_in[26];
    prm.b_pg = (const float*)d_in[27]; prm.w_pp = (const float*)d_in[28]; prm.ln3_g = (const float*)d_in[29];
    prm.ln3_b = (const float*)d_in[30];
    prm.out = (float*)d_out; prm.ws = (unsigned char*)d_ws;
    for (int j = 0; j < 16; ++j) prm.inv_freq[j] = (float)pow(10000.0, -(double)j / 16.0);
#if N_LAUNCH_MODE == 0
    const int grid = 1024;
    launch_one<0>(prm, grid, stream); launch_one<1>(prm, grid, stream); launch_one<2>(prm, grid, stream);
    launch_one<3>(prm, grid, stream); launch_one<4>(prm, grid, stream); launch_one<5>(prm, grid, stream);
    launch_one<6>(prm, grid, stream); launch_one<7>(prm, grid, stream); launch_one<8>(prm, grid, stream);
    launch_one<9>(prm, grid, stream); launch_one<10>(prm, grid, stream);
#else
    static int grid_blocks = 0;
    if (!grid_blocks) {
        int dev = 0, cus = 0, per_cu = 0;
        hipGetDevice(&dev);
        hipDeviceGetAttribute(&cus, hipDeviceAttributeMultiprocessorCount, dev);
        hipOccupancyMaxActiveBlocksPerMultiprocessor(&per_cu, (const void*)fwd_kernel<0, NPHASE>, 256, 0);
        if (per_cu > 2) per_cu = 2;
        if (per_cu < 1) per_cu = 1;
        grid_blocks = cus * per_cu;
    }
    void* args[] = {&prm};
    hipError_t e = hipLaunchCooperativeKernel((const void*)fwd_kernel<0, NPHASE>, dim3(grid_blocks), dim3(256), args, 0, stream);
    if (e != hipSuccess) fprintf(stderr, "cooperative launch failed: %s (grid %d)\n", hipGetErrorString(e), grid_blocks);
#endif
}
```

```cpp
#include <hip/hip_runtime.h>
#include <hip/hip_cooperative_groups.h>
#include <stdint.h>
#include <math.h>
#include <stdio.h>
namespace cg = cooperative_groups;

#ifndef USE_COOP
#define USE_COOP 0
#endif
#ifndef N_LAUNCH_MODE
#define N_LAUNCH_MODE 1
#endif

#define DEVINL __device__ __forceinline__
typedef unsigned short bf16_t;
typedef short bf16x8 __attribute__((ext_vector_type(8)));
typedef float f32x4 __attribute__((ext_vector_type(4)));
typedef unsigned u32x4 __attribute__((ext_vector_type(4)));

constexpr int T_ = 16384, D_ = 1024, SEQ_ = 2048;
constexpr float ALPHA_ = 1.189207115002721f;
constexpr float EPS_ = 1e-6f;
constexpr int LDK = 72;
constexpr int NTHR = 512;
constexpr int LDS_STAGE = 131072;
constexpr int LDS_META = LDS_STAGE;
constexpr int LDS_XB = LDS_STAGE + 1024;
constexpr int LDS_BYTES = LDS_STAGE + 2048;

constexpr size_t MiB = 1ull << 20;
constexpr size_t WS_WGU = 0;
constexpr size_t WS_WD = 64 * MiB;
constexpr size_t WS_WPG = 96 * MiB;
constexpr size_t WS_WPP = 98 * MiB;
constexpr size_t WS_WIN = 98 * MiB + 512 * 1024;
constexpr size_t WS_WO = WS_WIN + 3 * MiB;
constexpr size_t WS_WQ = WS_WO + 2 * MiB;
constexpr size_t WS_WKV = WS_WQ + 512 * 1024;
constexpr size_t WS_WS = WS_WKV + 256 * 1024;
constexpr size_t WS_WRT = WS_WS + 256 * 1024;
constexpr size_t WS_CS = WS_WRT + 256 * 1024;
constexpr size_t WS_PB = WS_CS + 2 * MiB;
constexpr size_t WS_CNT = WS_PB + 8 * MiB;
constexpr size_t WS_LIST = WS_CNT + 8192;
constexpr size_t WS_GATEW = WS_LIST + 2 * MiB;
constexpr size_t WS_ASGEP = WS_GATEW + 128 * 1024;
constexpr size_t WS_LATSS = WS_ASGEP + 128 * 1024;
constexpr size_t WS_ASS = WS_LATSS + 512 * 1024;
constexpr size_t WS_GSS = WS_ASS + 512 * 1024;
constexpr size_t WS_BAR = 247 * MiB;
constexpr size_t WS_ROWSC = WS_BAR + 64 * 1024;
constexpr size_t WS_PART = WS_ROWSC + 128 * 1024;
constexpr size_t WS_RA = 119 * MiB;
constexpr size_t WS_RB = 151 * MiB;
constexpr size_t WS_RC = 183 * MiB;
constexpr size_t WS_WKV2 = 248 * MiB;
constexpr size_t WS_GCNT = 248 * MiB + 512 * 1024;
constexpr size_t WS_END = 249 * MiB;
static_assert(WS_GSS + 512 * 1024 <= 119 * MiB && WS_PART + 512 * 1024 <= WS_END, "ws overlap");

struct Params {
    const float* x; const float* p; const int* pos;
    const float* w_in; const float* q_norm_g; const float* w_q_up; const float* kv_norm_g; const float* w_kv_up;
    const float* gm_ln_g; const float* gm_ln_b; const float* gm_w_s; const float* gm_b_s;
    const float* mla_out_g; const float* gm_out_g; const float* w_o; const float* ln1_g; const float* ln1_b;
    const float* w_rg; const float* b_rg; const float* w_re; const float* b_re;
    const float* w_gate; const float* w_up; const float* w_down; const float* ln2_g; const float* ln2_b;
    const float* w_pg; const float* b_pg; const float* w_pp; const float* ln3_g; const float* ln3_b;
    float* out; unsigned char* ws;
    float inv_freq[16];
    int use_cg_sync; int pad_;
};

typedef __bf16 bf16x2_t __attribute__((ext_vector_type(2)));
typedef float f32x2_t __attribute__((ext_vector_type(2)));
DEVINL unsigned pack2(float lo, float hi) { const f32x2_t v = {lo, hi}; return __builtin_bit_cast(unsigned, __builtin_convertvector(v, bf16x2_t)); }
DEVINL uint2 pack4(float a, float b, float c, float d) { return make_uint2(pack2(a, b), pack2(c, d)); }
DEVINL uint2 pack4v(f32x4 v) { return make_uint2(pack2(v[0], v[1]), pack2(v[2], v[3])); }
DEVINL float bf2f(unsigned short b) { return __uint_as_float(((unsigned)b) << 16); }
DEVINL float bflo(unsigned u) { return __uint_as_float(u << 16); }
DEVINL float bfhi(unsigned u) { return __uint_as_float(u & 0xffff0000u); }
DEVINL float wave_sum(float v) {
#pragma unroll
    for (int o = 32; o >= 1; o >>= 1) v += __shfl_xor(v, o);
    return v;
}
DEVINL float fast_sigmoid(float x) { return __builtin_amdgcn_rcpf(1.f + __builtin_amdgcn_exp2f(-1.4426950408889634f * x)); }
DEVINL float gelu_tanh(float x) {
    const float z2 = 1.5957691216057308f * (x + 0.044715f * x * x * x);
    return x * fast_sigmoid(z2);
}

template <int MI, int NI, bool TRANS>
DEVINL void mma_ktile(f32x4 (&acc)[MI][NI], const bf16_t* sA, const bf16_t* sB, int lane) {
    const int r16 = lane & 15, kg = (lane >> 4) * 8;
#pragma unroll
    for (int ks = 0; ks < 2; ++ks) {
        bf16x8 a[MI], b[NI];
#pragma unroll
        for (int mi = 0; mi < MI; ++mi) a[mi] = *(const bf16x8*)(sA + (mi * 16 + r16) * LDK + ks * 32 + kg);
#pragma unroll
        for (int ni = 0; ni < NI; ++ni) b[ni] = *(const bf16x8*)(sB + (ni * 16 + r16) * LDK + ks * 32 + kg);
#pragma unroll
        for (int mi = 0; mi < MI; ++mi)
#pragma unroll
            for (int ni = 0; ni < NI; ++ni) {
                if (TRANS) acc[mi][ni] = __builtin_amdgcn_mfma_f32_16x16x32_bf16(a[mi], b[ni], acc[mi][ni], 0, 0, 0);
                else acc[mi][ni] = __builtin_amdgcn_mfma_f32_16x16x32_bf16(b[ni], a[mi], acc[mi][ni], 0, 0, 0);
            }
    }
}

template <bool TRANS, int NI, class ARowF>
DEVINL void gemm_core(f32x4 (&acc)[4][NI], ARowF arow, const bf16_t* __restrict__ Bt, int ldb, int K, bf16_t* smem) {
    bf16_t* sA = smem; bf16_t* sB = smem + 256 * LDK;
    const int t = threadIdx.x, lane = t & 63, w = t >> 6, wr = w >> 1, wc = w & 1;
    const int lrow = t >> 3, lkc = (t & 7) * 8;
    const bf16_t* ap[4]; const bf16_t* bp[2];
#pragma unroll
    for (int i = 0; i < 4; ++i) ap[i] = arow(lrow + 64 * i) + lkc;
    bp[0] = Bt + (size_t)lrow * ldb + lkc;
    bp[1] = Bt + (size_t)(lrow + (NI == 4 ? 64 : 0)) * ldb + lkc;
    u32x4 ra0, ra1, ra2, ra3, rb0, rb1;
    ra0 = *(const u32x4*)(ap[0]); ra1 = *(const u32x4*)(ap[1]); ra2 = *(const u32x4*)(ap[2]); ra3 = *(const u32x4*)(ap[3]);
    rb0 = *(const u32x4*)(bp[0]);
    if (NI == 4) rb1 = *(const u32x4*)(bp[1]);
#pragma nounroll
    for (int k0 = 0; k0 < K; k0 += 64) {
        __syncthreads();
        *(u32x4*)(sA + (lrow + 0) * LDK + lkc) = ra0; *(u32x4*)(sA + (lrow + 64) * LDK + lkc) = ra1;
        *(u32x4*)(sA + (lrow + 128) * LDK + lkc) = ra2; *(u32x4*)(sA + (lrow + 192) * LDK + lkc) = ra3;
        *(u32x4*)(sB + (lrow + 0) * LDK + lkc) = rb0;
        if (NI == 4) *(u32x4*)(sB + (lrow + 64) * LDK + lkc) = rb1;
        __syncthreads();
        if (k0 + 64 < K) {
            const int kn = k0 + 64;
            ra0 = *(const u32x4*)(ap[0] + kn); ra1 = *(const u32x4*)(ap[1] + kn); ra2 = *(const u32x4*)(ap[2] + kn); ra3 = *(const u32x4*)(ap[3] + kn);
            rb0 = *(const u32x4*)(bp[0] + kn);
            if (NI == 4) rb1 = *(const u32x4*)(bp[1] + kn);
        }
        mma_ktile<4, NI, TRANS>(acc, sA + wr * 64 * LDK, sB + wc * 16 * NI * LDK, lane);
    }
}

template <int NI>
DEVINL void zero_acc(f32x4 (&acc)[4][NI]) {
#pragma unroll
    for (int i = 0; i < 4; ++i)
#pragma unroll
        for (int j = 0; j < NI; ++j) acc[i][j] = (f32x4){0.f, 0.f, 0.f, 0.f};
}

struct WS {
    bf16_t *wgu, *wd, *wpg, *wpp, *win, *wo, *wq, *wkv, *wsb, *pb;
    float2* rowsc; float2* part; float* wrt; float2* cs; int* cnt; int* list; float* gatew; int* asgep; float *lat_ss, *a_ss, *g_ss;
    bf16_t *xb, *q, *x1b; bf16_t *u, *vln, *ao, *H, *x2b; bf16_t *latq, *latkv, *wkv2, *kr, *k, *vT, *go, *ymoe;
};
DEVINL WS make_ws(unsigned char* ws, float* out = nullptr) {
    WS s;
    s.vln = (bf16_t*)out;
    s.q = (bf16_t*)((unsigned char*)out + 16 * MiB);
    s.wgu = (bf16_t*)(ws + WS_WGU); s.wd = (bf16_t*)(ws + WS_WD); s.wpg = (bf16_t*)(ws + WS_WPG); s.wpp = (bf16_t*)(ws + WS_WPP);
    s.win = (bf16_t*)(ws + WS_WIN); s.wo = (bf16_t*)(ws + WS_WO); s.wq = (bf16_t*)(ws + WS_WQ); s.wkv = (bf16_t*)(ws + WS_WKV);
    s.wsb = (bf16_t*)(ws + WS_WS); s.wrt = (float*)(ws + WS_WRT); s.cs = (float2*)(ws + WS_CS); s.pb = (bf16_t*)(ws + WS_PB);
    s.rowsc = (float2*)(ws + WS_ROWSC); s.part = (float2*)(ws + WS_PART); s.cnt = (int*)(ws + WS_CNT); s.list = (int*)(ws + WS_LIST); s.gatew = (float*)(ws + WS_GATEW); s.asgep = (int*)(ws + WS_ASGEP);
    s.lat_ss = (float*)(ws + WS_LATSS); s.a_ss = (float*)(ws + WS_ASS); s.g_ss = (float*)(ws + WS_GSS);
    s.xb = (bf16_t*)(ws + WS_RA); s.x1b = s.xb;
    s.ao = (bf16_t*)(ws + WS_RB); s.u = s.ao + 512; s.go = s.u; s.H = s.ao; s.x2b = s.ao;
    s.latq = (bf16_t*)(ws + WS_RC); s.latkv = (bf16_t*)(ws + WS_RC + 8 * MiB); s.kr = (bf16_t*)(ws + WS_RC + 16 * MiB); s.k = (bf16_t*)(ws + WS_RC + 17 * MiB); s.wkv2 = (bf16_t*)(ws + WS_WKV2);
    s.vT = (bf16_t*)(ws + WS_RC + 33 * MiB); s.ymoe = s.latq;
    return s;
}

#define XB_TMO      128
#define XB_XCNT(j)  (256  + 64 * (j))
#define XB_XSUB(j)  (1280 + 64 * (j))
#define XB_XGEN(j)  (2304 + 64 * (j))
#define XB_TOP      3328
#define XB_TOPGEN   3392
#define XCD_BAR_WORDS 3456
#define XB_SPIN_CAP (1u << 24)
#ifndef LAS
#define LAS __attribute__((address_space(3)))
#endif
DEVINL unsigned xb_ld(unsigned* p) { return __hip_atomic_load(p, __ATOMIC_RELAXED, __HIP_MEMORY_SCOPE_AGENT); }
DEVINL unsigned xb_add(unsigned* p, unsigned v) { return __hip_atomic_fetch_add(p, v, __ATOMIC_RELAXED, __HIP_MEMORY_SCOPE_AGENT); }
DEVINL unsigned xb_xcc_id() { return (unsigned)__builtin_amdgcn_s_getreg((3 << 11) | 20) & 0xFu; }
#define XB_SPIN(cond, bar) do { unsigned _sp = 0; while (cond) { __builtin_amdgcn_s_sleep(1); \
    if ((++_sp & 255u) == 0u) { if (xb_ld(&(bar)[XB_TMO])) break; if (_sp > XB_SPIN_CAP) { atomicAdd(&(bar)[XB_TMO], 1u); break; } } } } while (0)
struct XcdBarrier { unsigned* bar; unsigned x; volatile LAS unsigned* st; };
DEVINL XcdBarrier xcd_barrier_post(unsigned* bar, volatile LAS unsigned* st) {
    XcdBarrier b; b.bar = bar; b.x = xb_xcc_id(); b.st = st;
    if (threadIdx.x == 0) (void)xb_add(&bar[XB_XCNT(b.x)], 1u);
    return b;
}
DEVINL void xcd_barrier_complete(unsigned* bar, unsigned x, unsigned& nloc, unsigned& nx) {
    const unsigned G = gridDim.x * gridDim.y * gridDim.z;
    unsigned sum, cnt, mine, sp = 0u;
    for (;;) {
        sum = 0u; cnt = 0u; mine = 0u;
#pragma unroll
        for (unsigned j = 0; j < 16; ++j) { const unsigned c = xb_ld(&bar[XB_XCNT(j)]); sum += c; cnt += (c > 0u) ? 1u : 0u; mine = (j == x) ? c : mine; }
        if (sum == G) break;
        __builtin_amdgcn_s_sleep(1);
        if ((++sp & 255u) == 0u) { if (xb_ld(&bar[XB_TMO])) break; if (sp > XB_SPIN_CAP) { atomicAdd(&bar[XB_TMO], 1u); break; } }
    }
    nloc = mine > 0u ? mine : 1u; nx = cnt > 0u ? cnt : 1u;
}
template <bool FIRST = false>
DEVINL void xcd_barrier(const XcdBarrier& b) {
    asm volatile("s_waitcnt vmcnt(0)" ::: "memory");
    __syncthreads();
    if (threadIdx.x == 0) {
        unsigned* bar = b.bar;
        const unsigned bx = xb_xcc_id();
        __builtin_amdgcn_s_waitcnt(0);
        unsigned nloc = b.st[0], nx = b.st[1];
        if (FIRST) { xcd_barrier_complete(bar, bx, nloc, nx); b.st[0] = nloc; b.st[1] = nx; }
        const unsigned old = xb_add(&bar[XB_XSUB(bx)], 1u);
        const unsigned gen = old / nloc;
        if (old + 1u == (gen + 1u) * nloc) {
            __builtin_amdgcn_fence(__ATOMIC_RELEASE, "agent");
            asm volatile("s_waitcnt vmcnt(0)" ::: "memory");
            const unsigned og = xb_add(&bar[XB_TOP], 1u);
            const unsigned tg = og / nx;
            if (og + 1u == (tg + 1u) * nx) xb_add(&bar[XB_TOPGEN], 1u);
            else XB_SPIN(xb_ld(&bar[XB_TOPGEN]) == tg, bar);
            __builtin_amdgcn_fence(__ATOMIC_ACQUIRE, "agent");
            xb_add(&bar[XB_XGEN(bx)], 1u);
            asm volatile("s_waitcnt vmcnt(0)" ::: "memory");
        } else {
            XB_SPIN(xb_ld(&bar[XB_XGEN(bx)]) == gen, bar);
            __builtin_amdgcn_fence(__ATOMIC_ACQUIRE, "agent");
            asm volatile("s_waitcnt vmcnt(0)" ::: "memory");
        }
    }
    __syncthreads();
}

DEVINL void st_wt8(void* p, uint2 v) { __hip_atomic_store((unsigned long long*)p, ((unsigned long long)v.y << 32) | v.x, __ATOMIC_RELAXED, __HIP_MEMORY_SCOPE_AGENT); }
DEVINL void group_sync(unsigned* cnt, unsigned target) {
    asm volatile("s_waitcnt vmcnt(0)" ::: "memory");
    __syncthreads();
    if (threadIdx.x == 0) {
        xb_add(cnt, 1u);
        unsigned sp = 0;
        while (xb_ld(cnt) < target) { __builtin_amdgcn_s_sleep(1); if (++sp > XB_SPIN_CAP) break; }
        __builtin_amdgcn_fence(__ATOMIC_ACQUIRE, "agent");
        asm volatile("s_waitcnt vmcnt(0)" ::: "memory");
    }
    __syncthreads();
}

#define LAS __attribute__((address_space(3)))
#ifndef E_SPLIT_V
#define E_SPLIT_V 12
#endif
#ifndef EPI2
#define EPI2 0
#endif
#ifndef P0_REP
#define P0_REP 1
#endif
#ifndef REP_P1
#define REP_P1 1
#endif
#ifndef REP_P4
#define REP_P4 1
#endif
#ifndef REP_P6
#define REP_P6 1
#endif
#ifndef REP_P7
#define REP_P7 1
#endif
#ifndef REP_P9
#define REP_P9 1
#endif
namespace pg8 {
constexpr int BK = 64, HALF = 128, HTB = HALF * BK * 2, STAGE_BYTES = 8 * HTB;
DEVINL int lds_byte(int r, int c) { const int st = (r >> 4) * 2 + (c >> 5), rr = r & 15, cc = c & 31, ob = rr * 64 + cc * 2; return st * 1024 + (ob ^ (((ob >> 9) & 1) << 5)); }
DEVINL void stage_rc(int b, int& R, int& C) { const int st = b / 1024, sb = b % 1024, swz = sb ^ (((sb >> 9) & 1) << 5); R = (st >> 1) * 16 + swz / 64; C = (st & 1) * 32 + (swz % 64) / 2; }
struct Unit { const char* A; const char* B; int a0, a1, a2, a3; };
template <int MIDT, bool FUSED, int EPIREP = 1, class Epi, class Sched>
DEVINL void gemm_phase(LAS unsigned char* lds, const Sched& S, const Epi& E, const int K, const int ldb) {
    int tid_ = threadIdx.x; asm volatile("" : "+v"(tid_));
    const int tid = tid_, wid = __builtin_amdgcn_readfirstlane(tid >> 6), lane = tid & 63, wr = wid >> 2, wc = wid & 3, fr = lane & 15, fq = lane >> 4;
    const int nt = K / BK;
    int RA[2], CA[2]; unsigned voffB[2];
#pragma unroll
    for (int i = 0; i < 2; ++i) { stage_rc(tid * 16 + i * 8192, RA[i], CA[i]); voffB[i] = (unsigned)(RA[i] * ldb + CA[i]) * 2u; }
    const size_t kstep = (size_t)(BK * 2);
    const size_t hstepB = (size_t)HALF * ldb * 2;
    const unsigned ldsw = (unsigned)wid * 1024u;
    const int aoff = lds_byte(wr * 64 + fr, fq * 8), boff = lds_byte(wc * 32 + fr, fq * 8);
#define PG8_SA(b, h) (((b) * 2 + (h)) * HTB)
#define PG8_SB(b, h) ((4 + (b) * 2 + (h)) * HTB)
#define PG8_STG(bufoff, gbase, v0, v1) do { \
        __builtin_amdgcn_global_load_lds((const unsigned*)((const char*)(gbase) + (v0)), (LAS unsigned*)(lds + (bufoff) + ldsw), 16, 0, 0); \
        __builtin_amdgcn_global_load_lds((const unsigned*)((const char*)(gbase) + (v1)), (LAS unsigned*)(lds + (bufoff) + ldsw + 8192), 16, 0, 0); } while (0)
#define PG8_STGB(bufoff, gbase) PG8_STG(bufoff, gbase, voffB[0], voffB[1])
#define PG8_LDA(dst, b, h) do { _Pragma("unroll") for (int m = 0; m < 4; ++m) _Pragma("unroll") for (int k = 0; k < 2; ++k) dst[m][k] = *(const LAS bf16x8*)(lds + PG8_SA(b, h) + aoff + m * 2048 + k * 1024); } while (0)
#define PG8_LDB(dst, b, h) do { _Pragma("unroll") for (int n = 0; n < 2; ++n) _Pragma("unroll") for (int k = 0; k < 2; ++k) dst[n][k] = *(const LAS bf16x8*)(lds + PG8_SB(b, h) + boff + n * 2048 + k * 1024); } while (0)
#define PG8_MMA(ai, bj, At, Bt) do { __builtin_amdgcn_s_setprio(1); _Pragma("unroll") for (int m = 0; m < 4; ++m) _Pragma("unroll") for (int n = 0; n < 2; ++n) _Pragma("unroll") for (int k = 0; k < 2; ++k) \
        acc[ai][bj][m][n] = __builtin_amdgcn_mfma_f32_16x16x32_bf16(Bt[n][k], At[m][k], acc[ai][bj][m][n], 0, 0, 0); __builtin_amdgcn_s_setprio(0); } while (0)
#define PG8_WAIT_V(n) asm volatile("s_waitcnt vmcnt(" #n ")" ::: "memory")
#define PG8_WAIT_L(n) asm volatile("s_waitcnt lgkmcnt(" #n ")" ::: "memory")
#define PG8_BAR __builtin_amdgcn_s_barrier()
#define PG8_SCHED __builtin_amdgcn_sched_barrier(0)
    Unit cur, nxt; int ui = 0;
    if (!S.next(0, cur)) return;
    f32x4 acc[2][2][4][2];
#pragma unroll
    for (int a = 0; a < 2; ++a)
#pragma unroll
        for (int b = 0; b < 2; ++b)
#pragma unroll
            for (int m = 0; m < 4; ++m)
#pragma unroll
                for (int n = 0; n < 2; ++n) acc[a][b][m][n] = (f32x4){0.f, 0.f, 0.f, 0.f};
    bf16x8 At[4][2], B0[2][2], B1[2][2];
    unsigned vc00, vc01, vc10, vc11, vn00, vn01, vn10, vn11;
    vc00 = S.arow(cur, RA[0]) + CA[0] * 2; vc01 = S.arow(cur, RA[1]) + CA[1] * 2;
    vc10 = S.arow(cur, 128 + RA[0]) + CA[0] * 2; vc11 = S.arow(cur, 128 + RA[1]) + CA[1] * 2;
    const char* cA = cur.A; const char* cB = cur.B;
    PG8_STGB(PG8_SB(0, 0), cB); PG8_STG(PG8_SA(0, 0), cA, vc00, vc01); PG8_STGB(PG8_SB(0, 1), cB + hstepB); PG8_STG(PG8_SA(0, 1), cA, vc10, vc11);
    if (wr == 1) PG8_BAR;
    PG8_WAIT_V(4); PG8_BAR;
    PG8_STGB(PG8_SB(1, 0), cB + kstep); PG8_STG(PG8_SA(1, 0), cA + kstep, vc00, vc01); PG8_STGB(PG8_SB(1, 1), cB + hstepB + kstep);
    PG8_WAIT_V(6); PG8_BAR;
    for (;;) {
        const bool has_next = S.next(ui + 1, nxt);
        const char* nA = has_next ? nxt.A : cA; const char* nB = has_next ? nxt.B : cB;
        if (has_next) {
            vn00 = S.arow(nxt, RA[0]) + CA[0] * 2; vn01 = S.arow(nxt, RA[1]) + CA[1] * 2;
            vn10 = S.arow(nxt, 128 + RA[0]) + CA[0] * 2; vn11 = S.arow(nxt, 128 + RA[1]) + CA[1] * 2;
        } else { vn00 = vc00; vn01 = vc01; vn10 = vc10; vn11 = vc11; }
#pragma nounroll
        for (int t = 0; t < nt; t += 2) {
            const bool last = (t == nt - 2);
            if (MIDT > 0 && t == MIDT) E.mid(acc, cur, wr, wc, fr, fq);
            const char* a1 = cA + (size_t)(t + 1) * kstep;
            const char* a2 = last ? nA : cA + (size_t)(t + 2) * kstep; const char* b2 = last ? nB : cB + (size_t)(t + 2) * kstep;
            const char* a3 = a2 + kstep; const char* b3 = b2 + kstep;
            const unsigned w00 = last ? vn00 : vc00, w01 = last ? vn01 : vc01, w10 = last ? vn10 : vc10, w11 = last ? vn11 : vc11;
            PG8_LDB(B0, 0, 0); PG8_SCHED; PG8_LDA(At, 0, 0); PG8_STG(PG8_SA(1, 1), a1, vc10, vc11);
            PG8_WAIT_L(8); PG8_BAR; PG8_WAIT_L(0); PG8_MMA(0, 0, At, B0); PG8_BAR; PG8_SCHED;
            PG8_LDB(B1, 0, 1); PG8_STGB(PG8_SB(0, 0), b2);
            PG8_BAR; PG8_WAIT_L(0); PG8_MMA(0, 1, At, B1); PG8_BAR;
            PG8_LDA(At, 0, 1); PG8_STG(PG8_SA(0, 0), a2, w00, w01);
            PG8_BAR; PG8_WAIT_L(0); PG8_MMA(1, 0, At, B0); PG8_BAR; PG8_SCHED;
            PG8_STGB(PG8_SB(0, 1), b2 + hstepB);
            PG8_WAIT_V(6); PG8_BAR; PG8_MMA(1, 1, At, B1); PG8_BAR;
            PG8_LDB(B0, 1, 0); PG8_SCHED; PG8_LDA(At, 1, 0); PG8_STG(PG8_SA(0, 1), a2, w10, w11);
            PG8_WAIT_L(8); PG8_BAR; PG8_WAIT_L(0); PG8_MMA(0, 0, At, B0); PG8_BAR; PG8_SCHED;
            PG8_LDB(B1, 1, 1); PG8_STGB(PG8_SB(1, 0), b3);
            PG8_BAR; PG8_WAIT_L(0); PG8_MMA(0, 1, At, B1); PG8_BAR;
            PG8_LDA(At, 1, 1); PG8_STG(PG8_SA(1, 0), a3, w00, w01);
            PG8_BAR; PG8_WAIT_L(0); PG8_MMA(1, 0, At, B0); PG8_BAR; PG8_SCHED;
            PG8_STGB(PG8_SB(1, 1), b3 + hstepB);
            PG8_WAIT_V(6); PG8_BAR; PG8_MMA(1, 1, At, B1); PG8_BAR;
        }
        if (!FUSED) { E(acc, cur, wr, wc, fr, fq); if (EPIREP > 1) { asm volatile("s_waitcnt vmcnt(0)" ::: "memory"); E(acc, cur, wr, wc, fr, fq); } }
        if (!has_next) break;
#pragma unroll
        for (int a = 0; a < 2; ++a)
#pragma unroll
            for (int b = 0; b < 2; ++b)
#pragma unroll
                for (int m = 0; m < 4; ++m)
#pragma unroll
                    for (int n = 0; n < 2; ++n) acc[a][b][m][n] = (f32x4){0.f, 0.f, 0.f, 0.f};
        cur = nxt; cA = nA; cB = nB; ++ui;
        vc00 = vn00; vc01 = vn01; vc10 = vn10; vc11 = vn11;
    }
    PG8_WAIT_V(0);
    if (wr == 0) PG8_BAR;
    PG8_BAR;
    if constexpr (FUSED) E.final(acc, cur, wr, wc, fr, fq, lds);
#undef PG8_SA
#undef PG8_SB
#undef PG8_STG
#undef PG8_STGB
#undef PG8_LDA
#undef PG8_LDB
#undef PG8_MMA
#undef PG8_WAIT_V
#undef PG8_WAIT_L
#undef PG8_BAR
#undef PG8_SCHED
}
struct DenseOrder {
    const char* A; const char* B; int lda, ldb, nM, nN, G, c, rep;
    DEVINL bool next(int i, Unit& u) const {
        const int nwg = nM * nN; const long L = (long)i * G + c; if (L >= (long)nwg * rep) return false;
        int wgid = (int)(L % nwg); { const int q = nwg / 8, r = nwg % 8, xcd = wgid % 8, off = wgid / 8; wgid = (xcd < r ? xcd * (q + 1) : r * (q + 1) + (xcd - r) * q) + off; }
        const int nig = 8 * nN, gid = wgid / nig, fm = gid * 8, gsz = (nM - fm) < 8 ? (nM - fm) : 8;
        const int pm = fm + ((wgid % nig) % gsz), pn = (wgid % nig) / gsz;
        u.A = A + (size_t)pm * 256 * lda * 2; u.B = B + (size_t)pn * 256 * ldb * 2; u.a0 = pm; u.a1 = pn; u.a2 = 0; u.a3 = 0; return true;
    }
    DEVINL unsigned arow(const Unit&, int r) const { return (unsigned)(r * lda) * 2u; }
};
}

DEVINL int drow_map(int mode, int n) {
    switch (mode) {
        case 1: {
            if (n < 256) return n;
            if (n < 384) return 256 + (n - 256);
            if (n < 416) return 384 + (n - 384);
            if (n < 928) return 512 + (n - 416);
            const int c = n - 928, gq = c >> 6, ch = c & 63;
            return 1024 + (gq >> 2) * 256 + 128 * (ch >> 5) + 32 * (gq & 3) + (ch & 31);
        }
        case 2: { const int h = n / 96, d = n - h * 96; return d < 64 ? h * 64 + d : 512 + h * 32 + (d - 64); }
        case 5: { const int h = n >> 7, d = n & 127; return d < 64 ? h * 64 + d : 512 + h * 64 + (d - 64); }
        case 3: return (n >> 4) * 32 + (n & 15);
        case 4: return (n >> 4) * 32 + 16 + (n & 15);
        default: return n;
    }
}
DEVINL void tr_tile(const float* __restrict__ src, int ld_s, int k0, int n0, int Nlim, bf16_t* __restrict__ dst, int ld_d,
                    const float* __restrict__ gain, int mode, float* smf) {
    int t = threadIdx.x; asm volatile("" : "+v"(t));
    __syncthreads();
#pragma unroll
    for (int i = 0; i < 2; ++i) {
        const int c = t + NTHR * i, r = c >> 4, c4 = (c & 15) * 4, n = n0 + c4;
        float4 v = make_float4(0.f, 0.f, 0.f, 0.f);
        if (n < Nlim) { const f32x4 t4 = __builtin_nontemporal_load((const f32x4*)(src + (size_t)(k0 + r) * ld_s + n)); v = make_float4(t4[0], t4[1], t4[2], t4[3]); }
        const float g = gain ? gain[k0 + r] : 1.f;
        smf[r * 65 + c4 + 0] = v.x * g; smf[r * 65 + c4 + 1] = v.y * g; smf[r * 65 + c4 + 2] = v.z * g; smf[r * 65 + c4 + 3] = v.w * g;
    }
    __syncthreads();
    {
        const int c = t, nn = c >> 3, kc = (c & 7) * 8, n = n0 + nn;
        if (n < Nlim) {
            float e[8];
#pragma unroll
            for (int j = 0; j < 8; ++j) e[j] = smf[(kc + j) * 65 + nn];
            uint4 o; o.x = pack2(e[0], e[1]); o.y = pack2(e[2], e[3]); o.z = pack2(e[4], e[5]); o.w = pack2(e[6], e[7]);
            *(uint4*)(dst + (size_t)drow_map(mode, n) * ld_d + k0 + kc) = o;
        }
    }
}

DEVINL void cvt8(const float* __restrict__ s, bf16_t* __restrict__ d) {
    const f32x4 a4 = __builtin_nontemporal_load((const f32x4*)s), b4 = __builtin_nontemporal_load((const f32x4*)(s + 4));
    const float4 a = make_float4(a4[0], a4[1], a4[2], a4[3]), b = make_float4(b4[0], b4[1], b4[2], b4[3]);
    uint4 o; o.x = pack2(a.x, a.y); o.y = pack2(a.z, a.w); o.z = pack2(b.x, b.y); o.w = pack2(b.z, b.w);
    *(uint4*)d = o;
}

constexpr int E_SPLIT = E_SPLIT_V;
DEVINL void conv_gateup_tile(const Params& p, const WS& s, int v, float* smf) {
    const int e = v >> 8, r = v & 255, up = r >> 7, q = r & 127, kt = q >> 3, nt = q & 7;
    tr_tile((up ? p.w_up : p.w_gate) + (size_t)e * 1024 * 512, 512, kt * 64, nt * 64, 512, s.wgu + (size_t)e * 1024 * 1024, 1024, nullptr, up ? 4 : 3, smf);
}
DEVINL void conv_down_tile(const Params& p, const WS& s, int v, float* smf) {
    const int e = v >> 7, r = v & 127, kt = r >> 4, nt = r & 15;
    tr_tile(p.w_down + (size_t)e * 512 * 1024, 1024, kt * 64, nt * 64, 1024, s.wd + (size_t)e * 1024 * 512, 512, nullptr, 0, smf);
}
DEVINL void conv_expert_tiles(const Params& p, const WS& s, int kind, int first, int last, int stride, float* smf) {
    if (first >= last) return;
    int t = threadIdx.x; asm volatile("" : "+v"(t));
    const int lr = t >> 4, lc4 = (t & 15) * 4;
    const int nn = t >> 3, kc = (t & 7) * 8;
    float4 r0, r1; const float* src; int ld_s; bf16_t* dst; int ld_d, mode, k0, n0;
#define CET_DECODE(v) do { if (kind == 0) { const int e_ = (v) >> 8, r_ = (v) & 255, up_ = r_ >> 7, q_ = r_ & 127; k0 = (q_ >> 3) * 64; n0 = (q_ & 7) * 64; \
            src = (up_ ? p.w_up : p.w_gate) + (size_t)e_ * 1024 * 512; ld_s = 512; dst = s.wgu + (size_t)e_ * 1024 * 1024; ld_d = 1024; mode = up_ ? 4 : 3; } \
        else { const int e_ = (v) >> 7, r_ = (v) & 127; k0 = (r_ >> 4) * 64; n0 = (r_ & 15) * 64; src = p.w_down + (size_t)e_ * 512 * 1024; ld_s = 1024; dst = s.wd + (size_t)e_ * 1024 * 512; ld_d = 512; mode = 0; } } while (0)
#define CET_LOAD() do { const f32x4 t0_ = __builtin_nontemporal_load((const f32x4*)(src + (size_t)(k0 + lr) * ld_s + n0 + lc4)), t1_ = __builtin_nontemporal_load((const f32x4*)(src + (size_t)(k0 + lr + 32) * ld_s + n0 + lc4)); \
        r0 = make_float4(t0_[0], t0_[1], t0_[2], t0_[3]); r1 = make_float4(t1_[0], t1_[1], t1_[2], t1_[3]); } while (0)
    CET_DECODE(first); CET_LOAD();
    __syncthreads();
    int buf = 0;
    for (int v = first; v < last; v += stride) {
        float* sm = smf + buf * (64 * 65);
        sm[lr * 65 + lc4 + 0] = r0.x; sm[lr * 65 + lc4 + 1] = r0.y; sm[lr * 65 + lc4 + 2] = r0.z; sm[lr * 65 + lc4 + 3] = r0.w;
        sm[(lr + 32) * 65 + lc4 + 0] = r1.x; sm[(lr + 32) * 65 + lc4 + 1] = r1.y; sm[(lr + 32) * 65 + lc4 + 2] = r1.z; sm[(lr + 32) * 65 + lc4 + 3] = r1.w;
        bf16_t* dcur = dst; const int ldc = ld_d, mcur = mode, kcur = k0, ncur = n0;
        if (v + stride < last) { CET_DECODE(v + stride); CET_LOAD(); }
        __syncthreads();
        float e[8];
#pragma unroll
        for (int j = 0; j < 8; ++j) e[j] = sm[(kc + j) * 65 + nn];
        uint4 o; o.x = pack2(e[0], e[1]); o.y = pack2(e[2], e[3]); o.z = pack2(e[4], e[5]); o.w = pack2(e[6], e[7]);
        __builtin_nontemporal_store((u32x4){o.x, o.y, o.z, o.w}, (u32x4*)(dcur + (size_t)drow_map(mcur, ncur + nn) * ldc + kcur + kc));
        buf ^= 1;
    }
    __syncthreads();
#undef CET_DECODE
#undef CET_LOAD
}
DEVINL void helper_slot(int U, int G, int c, int& j, int& nh) {
    const int R = (U + G - 1) / G, nidle = R * G - U;
    if (nidle >= 64) { nh = nidle; j = c - (G - nidle); } else { nh = G; j = c; }
}
__device__ void phase0(const Params& p, unsigned char* smem) {
    const WS s = make_ws(p.ws, p.out);
    const int G = gridDim.x, bid = blockIdx.x, t = threadIdx.x;
    const size_t gtid = (size_t)bid * NTHR + t, gstride = (size_t)G * NTHR;
    for (size_t i0 = gtid; i0 < (size_t)T_ * D_ / 8 * P0_REP; i0 += gstride) { const size_t i = i0 % ((size_t)T_ * D_ / 8); cvt8(p.x + i * 8, s.xb + i * 8); }
    for (size_t i = gtid; i < 8 * 128 * 128 / 8; i += gstride) {
        const int e0 = (int)i * 8, tt = (e0 >> 7) & 127, s0 = e0 & 127;
        float v[8];
#pragma unroll
        for (int j = 0; j < 8; ++j) v[j] = (s0 + j <= tt) ? p.gm_w_s[e0 + j] : 0.f;
        uint4 o; o.x = pack2(v[0], v[1]); o.y = pack2(v[2], v[3]); o.z = pack2(v[4], v[5]); o.w = pack2(v[6], v[7]);
        *(uint4*)(s.wsb + e0) = o;
    }
    for (size_t i = gtid; i < 48 * 1024; i += gstride) {
        const int n = (int)i >> 10, k = (int)i & 1023;
        s.wrt[i] = n < 4 ? p.w_rg[k * 4 + n] : (n < 36 ? p.w_re[k * 32 + (n - 4)] : 0.f);
    }
    for (size_t i = gtid; i < (size_t)T_ * 16; i += gstride) {
        const int tok = (int)(i >> 4), j = (int)i & 15;
        const float ang = (float)p.pos[tok] * p.inv_freq[j];
        float sn, cs; sincosf(ang, &sn, &cs);
        s.cs[i] = make_float2(cs, sn);
    }
    for (size_t i = gtid; i < 96 * 1024 / 8; i += gstride) *(uint4*)(s.win + 416 * 1024 + i * 8) = make_uint4(0, 0, 0, 0);
    if (bid == 0 && t < 32) s.cnt[t * 64] = 0;
    for (size_t i = gtid; i < 1024 * 16; i += gstride) *(uint4*)(s.wkv2 + (i >> 4) * 256 + 128 + (i & 15) * 8) = make_uint4(0, 0, 0, 0);
    for (size_t i = gtid; i < (size_t)T_ * 16; i += gstride) *(uint4*)(s.latkv + (i >> 4) * 256 + 128 + (i & 15) * 8) = make_uint4(0, 0, 0, 0);
    float* smf = (float*)smem;
    constexpr int J0 = 368, J1 = J0 + 48, J2 = J1 + 32, J3 = J2 + 256, J4 = J3 + 256, J5 = J4 + 64, J6 = J5;
    for (int u0 = bid; u0 < J6 * P0_REP; u0 += G) {
        const int u = u0 % J6;
        if (u < J0) { const int kt = u / 23, nt = u % 23; tr_tile(p.w_in, 1440, kt * 64, nt * 64, 1440, s.win, 1024, nullptr, 1, smf); }
        else if (u < J1) { const int v = u - J0, kt = v / 12, nt = v % 12; tr_tile(p.w_q_up, 768, kt * 64, nt * 64, 768, s.wq, 256, p.q_norm_g, 2, smf); }
        else if (u < J2) { const int v = u - J1, kt = v / 16, nt = v % 16; tr_tile(p.w_kv_up, 1024, kt * 64, nt * 64, 1024, s.wkv2, 256, p.kv_norm_g, 5, smf); }
        else if (u < J3) { const int v = u - J2, kt = v / 16, nt = v % 16; tr_tile(p.w_o, 1024, kt * 64, nt * 64, 1024, s.wo, 1024, kt < 8 ? p.mla_out_g : p.gm_out_g - 512, 0, smf); }
        else if (u < J4) { const int v = u - J3, kt = v / 16, nt = v % 16; tr_tile(p.w_pg, 1024, kt * 64, nt * 64, 1024, s.wpg, 1024, nullptr, 0, smf); }
        else if (u < J5) { const int v = u - J4, kt = v / 16, nt = v % 16; tr_tile(p.w_pp, 1024, kt * 64, nt * 64, 1024, s.wpp, 256, nullptr, 0, smf); }
    }
    conv_expert_tiles(p, s, 0, bid, E_SPLIT * 256, G, smf);
}

struct EpiP1 {
    const Params* p; WS s;
    DEVINL void mid(f32x4 (&)[2][2][4][2], const pg8::Unit&, int, int, int, int) const {}
    DEVINL void operator()(const f32x4 (&acc)[2][2][4][2], const pg8::Unit& u, int wr, int wc, int fr, int fq) const {
        const int pm = u.a0, pn = u.a1;
#pragma unroll
        for (int ai = 0; ai < 2; ++ai)
#pragma unroll
            for (int m = 0; m < 4; ++m) {
                const int row = pm * 256 + ai * 128 + wr * 64 + m * 16 + fr;
                if (pn == 0) {
                    float ss = 0.f;
#pragma unroll
                    for (int bj = 0; bj < 2; ++bj)
#pragma unroll
                        for (int n = 0; n < 2; ++n) { const f32x4 v = acc[ai][bj][m][n]; ss += v[0] * v[0] + v[1] * v[1] + v[2] * v[2] + v[3] * v[3];
                            *(uint2*)(s.latq + (size_t)row * 256 + bj * 128 + wc * 32 + n * 16 + fq * 4) = pack4v(v); }
                    ss += __shfl_xor(ss, 16); ss += __shfl_xor(ss, 32);
                    if (fq == 0) s.lat_ss[row * 8 + wc] = ss;
                } else if (pn == 1) {
                    float ss = 0.f;
#pragma unroll
                    for (int n = 0; n < 2; ++n) { const f32x4 v = acc[ai][0][m][n]; ss += v[0] * v[0] + v[1] * v[1] + v[2] * v[2] + v[3] * v[3];
                        *(uint2*)(s.latkv + (size_t)row * 256 + wc * 32 + n * 16 + fq * 4) = pack4v(v); }
                    ss += __shfl_xor(ss, 16); ss += __shfl_xor(ss, 32);
                    if (fq == 0) s.lat_ss[row * 8 + 4 + wc] = ss;
                    if (wc == 0) {
                        float o1[4], o2[4];
#pragma unroll
                        for (int r = 0; r < 4; ++r) {
                            const float2 c = s.cs[row * 16 + fq * 4 + r];
                            const float x1 = acc[ai][1][m][0][r], x2 = acc[ai][1][m][1][r];
                            o1[r] = x1 * c.x - x2 * c.y; o2[r] = x1 * c.y + x2 * c.x;
                        }
                        *(uint2*)(s.kr + (size_t)row * 32 + fq * 4) = pack4(o1[0], o1[1], o1[2], o1[3]);
                        *(uint2*)(s.kr + (size_t)row * 32 + 16 + fq * 4) = pack4(o2[0], o2[1], o2[2], o2[3]);
                    }
                } else if (pn < 4) {
#pragma unroll
                    for (int bj = 0; bj < 2; ++bj)
#pragma unroll
                        for (int n = 0; n < 2; ++n) { const f32x4 v = acc[ai][bj][m][n];
                            *(uint2*)(s.u + (size_t)row * 1024 + (pn - 2) * 256 + bj * 128 + wc * 32 + n * 16 + fq * 4) = pack4(gelu_tanh(v[0]), gelu_tanh(v[1]), gelu_tanh(v[2]), gelu_tanh(v[3])); }
                } else {
                    float gv[2][2][4]; float sum = 0.f;
#pragma unroll
                    for (int bj = 0; bj < 2; ++bj)
#pragma unroll
                        for (int n = 0; n < 2; ++n)
#pragma unroll
                            for (int r = 0; r < 4; ++r) { gv[bj][n][r] = gelu_tanh(acc[ai][bj][m][n][r]); sum += gv[bj][n][r]; }
                    sum += __shfl_xor(sum, 16); sum += __shfl_xor(sum, 32);
                    const float mean = sum * (1.f / 64.f); float sq = 0.f;
#pragma unroll
                    for (int bj = 0; bj < 2; ++bj)
#pragma unroll
                        for (int n = 0; n < 2; ++n)
#pragma unroll
                            for (int r = 0; r < 4; ++r) { const float d = gv[bj][n][r] - mean; sq += d * d; }
                    sq += __shfl_xor(sq, 16); sq += __shfl_xor(sq, 32);
                    const float rstd = rsqrtf(sq * (1.f / 64.f) + EPS_);
                    const int g = (pn - 4) * 4 + wc;
#pragma unroll
                    for (int bj = 0; bj < 2; ++bj)
#pragma unroll
                        for (int n = 0; n < 2; ++n) {
                            const int ch = g * 64 + bj * 32 + n * 16 + fq * 4;
                            const float4 gg = *(const float4*)(p->gm_ln_g + ch), bb = *(const float4*)(p->gm_ln_b + ch);
                            *(uint2*)(s.vln + (size_t)row * 512 + ch) = pack4((gv[bj][n][0] - mean) * rstd * gg.x + bb.x, (gv[bj][n][1] - mean) * rstd * gg.y + bb.y,
                                                                             (gv[bj][n][2] - mean) * rstd * gg.z + bb.z, (gv[bj][n][3] - mean) * rstd * gg.w + bb.w);
                        }
                }
            }
    }
};
__device__ void phase1(const Params& p, unsigned char* smem) {
    const WS s = make_ws(p.ws, p.out);
    pg8::DenseOrder S{(const char*)s.xb, (const char*)s.win, 1024, 1024, 64, 6, (int)gridDim.x, (int)blockIdx.x, REP_P1};
    EpiP1 E{&p, s};
    pg8::gemm_phase<0, false, (EPI2 == 1 ? 2 : 1)>((LAS unsigned char*)smem, S, E, 1024, 1024);
    int j, nh; helper_slot(64 * 6 * REP_P1, (int)gridDim.x, (int)blockIdx.x, j, nh);
    if (j >= 0) conv_expert_tiles(p, s, 0, E_SPLIT * 256 + j, 32 * 256, nh, (float*)smem);
}

constexpr float QSCALE_ = 0.10206207261596577f * 1.4426950408889634f;
struct P2Order {
    const char *latq, *latkv, *wq, *wkv2; int G, c;
    DEVINL bool next(int i, pg8::Unit& u) const {
        const int L = i * G + c; if (L >= 448) return false;
        if (L < 192) { const int pm = L / 3, pn = L - pm * 3; u.A = latq + (size_t)pm * 256 * 512; u.B = wq + (size_t)pn * 256 * 512; u.a0 = pm; u.a1 = pn; u.a2 = 0; }
        else if (L < 320) { const int v = L - 192, pm = v >> 1, pn = v & 1; u.A = latkv + (size_t)pm * 256 * 512; u.B = wkv2 + (size_t)pn * 256 * 512; u.a0 = pm; u.a1 = pn; u.a2 = 1; }
        else { const int v = L - 320, pn = v >> 1, pm = v & 1; u.A = wkv2 + (size_t)(512 + pm * 256) * 512; u.B = latkv + (size_t)pn * 256 * 512; u.a0 = pm; u.a1 = pn; u.a2 = 2; }
        u.a3 = 0; return true;
    }
    DEVINL unsigned arow(const pg8::Unit&, int r) const { return (unsigned)r * 512u; }
};
struct EpiP2 {
    WS s;
    DEVINL void mid(f32x4 (&)[2][2][4][2], const pg8::Unit&, int, int, int, int) const {}
    DEVINL void operator()(const f32x4 (&acc)[2][2][4][2], const pg8::Unit& u, int wr, int wc, int fr, int fq) const {
        if (u.a2 == 0) {
#pragma unroll
            for (int ai = 0; ai < 2; ++ai)
#pragma unroll
                for (int m = 0; m < 4; ++m) {
                    const int row = u.a0 * 256 + ai * 128 + wr * 64 + m * 16 + fr;
                    const float4 ssv = *(const float4*)(s.lat_ss + row * 8);
                    const float rstd = rsqrtf((ssv.x + ssv.y + ssv.z + ssv.w) * (1.f / 256.f) + EPS_) * QSCALE_;
                    if (u.a1 < 2) {
#pragma unroll
                        for (int bj = 0; bj < 2; ++bj)
#pragma unroll
                            for (int n = 0; n < 2; ++n) {
                                const int col = u.a1 * 256 + bj * 128 + wc * 32 + n * 16 + fq * 4;
                                *(uint2*)(s.q + ((size_t)row * 8 + (col >> 6)) * 96 + (col & 63)) = pack4v(acc[ai][bj][m][n] * rstd);
                            }
                    } else {
#pragma unroll
                        for (int bj = 0; bj < 2; ++bj) {
                            const int h = bj * 4 + wc; float o1[4], o2[4];
#pragma unroll
                            for (int r = 0; r < 4; ++r) {
                                const float2 c = s.cs[row * 16 + fq * 4 + r];
                                const float x1 = acc[ai][bj][m][0][r] * rstd, x2 = acc[ai][bj][m][1][r] * rstd;
                                o1[r] = x1 * c.x - x2 * c.y; o2[r] = x1 * c.y + x2 * c.x;
                            }
                            *(uint2*)(s.q + ((size_t)row * 8 + h) * 96 + 64 + fq * 4) = pack4(o1[0], o1[1], o1[2], o1[3]);
                            *(uint2*)(s.q + ((size_t)row * 8 + h) * 96 + 80 + fq * 4) = pack4(o2[0], o2[1], o2[2], o2[3]);
                        }
                    }
                    asm volatile("" ::: "memory");
                }
        } else if (u.a2 == 1) {
#pragma unroll
            for (int ai = 0; ai < 2; ++ai)
#pragma unroll
                for (int m = 0; m < 4; ++m) {
                    const int row = u.a0 * 256 + ai * 128 + wr * 64 + m * 16 + fr;
                    const float4 kv4 = *(const float4*)(s.lat_ss + row * 8 + 4);
                    const float rstd = rsqrtf((kv4.x + kv4.y + kv4.z + kv4.w) * (1.f / 128.f) + EPS_);
#pragma unroll
                    for (int bj = 0; bj < 2; ++bj)
#pragma unroll
                        for (int n = 0; n < 2; ++n) {
                            const int col = u.a1 * 256 + bj * 128 + wc * 32 + n * 16 + fq * 4;
                            *(uint2*)(s.k + ((size_t)row * 8 + (col >> 6)) * 64 + (col & 63)) = pack4v(acc[ai][bj][m][n] * rstd);
                        }
                    asm volatile("" ::: "memory");
                }
        } else {
#pragma unroll
            for (int bj = 0; bj < 2; ++bj)
#pragma unroll
                for (int n = 0; n < 2; ++n) {
                    const int tok = u.a1 * 256 + bj * 128 + wc * 32 + n * 16 + fq * 4;
                    f32x4 rs;
#pragma unroll
                    for (int j = 0; j < 4; ++j) { const float4 kv4 = *(const float4*)(s.lat_ss + (tok + j) * 8 + 4); rs[j] = rsqrtf((kv4.x + kv4.y + kv4.z + kv4.w) * (1.f / 128.f) + EPS_); }
                    const int b = tok >> 11, sq = tok & 2047;
#pragma unroll
                    for (int ai = 0; ai < 2; ++ai)
#pragma unroll
                        for (int m = 0; m < 4; ++m) {
                            const int ch = u.a0 * 256 + ai * 128 + wr * 64 + m * 16 + fr;
                            *(uint2*)(s.vT + ((size_t)(b * 512 + ch)) * 2048 + sq) = pack4v(acc[ai][bj][m][n] * rs);
                        }
                    asm volatile("" ::: "memory");
                }
        }
    }
};
__device__ void gmlp_phase(const Params& p, const WS& s, bf16_t* smem) {
    constexpr int LDG = 136;
    int t = threadIdx.x; asm volatile("" : "+v"(t));
    const int lane = t & 63, w = t >> 6, r16 = lane & 15, g4 = (lane >> 4) * 4, kg = (lane >> 4) * 8;
    const int G = gridDim.x;
    int u = blockIdx.x;
    if (u >= 1024) return;
    u32x4 ra0, ra1, ra2, ra3, rb0, rb1; uint2 ru0, ru1, ru2, ru3, cu0, cu1, cu2, cu3;
#define GM_LOAD(uu) do { const int cidx_ = (uu) >> 3, g_ = (uu) & 7, tok0_ = cidx_ * 128; \
        const bf16_t* wp_ = s.wsb + ((size_t)g_ * 128 + (t >> 4)) * 128 + (t & 15) * 8; \
        ra0 = *(const u32x4*)(wp_); ra1 = *(const u32x4*)(wp_ + 32 * 128); ra2 = *(const u32x4*)(wp_ + 64 * 128); ra3 = *(const u32x4*)(wp_ + 96 * 128); \
        const bf16_t* vp_ = s.vln + (size_t)(tok0_ + 2 * lane) * 512 + g_ * 64 + w * 8; \
        rb0 = *(const u32x4*)(vp_); rb1 = *(const u32x4*)(vp_ + 512); \
        const bf16_t* up_ = s.u + (size_t)(tok0_ + w * 16 + r16) * 1024 + g_ * 64 + g4; \
        ru0 = *(const uint2*)(up_); ru1 = *(const uint2*)(up_ + 16); ru2 = *(const uint2*)(up_ + 32); ru3 = *(const uint2*)(up_ + 48); } while (0)
#define GM_STORE(buf) do { bf16_t* sA_ = smem + (buf) * (192 * LDG); bf16_t* sB_ = sA_ + 128 * LDG; \
        bf16_t* ad_ = sA_ + (t >> 4) * LDG + (t & 15) * 8; \
        *(u32x4*)(ad_) = ra0; *(u32x4*)(ad_ + 32 * LDG) = ra1; *(u32x4*)(ad_ + 64 * LDG) = ra2; *(u32x4*)(ad_ + 96 * LDG) = ra3; \
        unsigned* bd_ = (unsigned*)(sB_ + (w * 8) * LDG + 2 * lane); \
        bd_[0 * (LDG / 2)] = (rb0[0] & 0xffffu) | (rb1[0] << 16); bd_[1 * (LDG / 2)] = (rb0[0] >> 16) | (rb1[0] & 0xffff0000u); \
        bd_[2 * (LDG / 2)] = (rb0[1] & 0xffffu) | (rb1[1] << 16); bd_[3 * (LDG / 2)] = (rb0[1] >> 16) | (rb1[1] & 0xffff0000u); \
        bd_[4 * (LDG / 2)] = (rb0[2] & 0xffffu) | (rb1[2] << 16); bd_[5 * (LDG / 2)] = (rb0[2] >> 16) | (rb1[2] & 0xffff0000u); \
        bd_[6 * (LDG / 2)] = (rb0[3] & 0xffffu) | (rb1[3] << 16); bd_[7 * (LDG / 2)] = (rb0[3] >> 16) | (rb1[3] & 0xffff0000u); } while (0)
    __syncthreads();
    GM_LOAD(u);
    GM_STORE(0);
    cu0 = ru0; cu1 = ru1; cu2 = ru2; cu3 = ru3;
    __syncthreads();
    int cur = 0;
#pragma nounroll
    for (;;) {
        const int un = u + G; const bool has_next = un < 1024;
        if (has_next) GM_LOAD(un);
        const bf16_t* sA = smem + cur * (192 * LDG); const bf16_t* sB = sA + 128 * LDG;
        f32x4 acc[4];
#pragma unroll
        for (int j = 0; j < 4; ++j) acc[j] = (f32x4){0.f, 0.f, 0.f, 0.f};
#pragma unroll
        for (int ks = 0; ks < 4; ++ks) {
            const bf16x8 af = *(const bf16x8*)(sA + (w * 16 + r16) * LDG + ks * 32 + kg);
#pragma unroll
            for (int ni = 0; ni < 4; ++ni) {
                const bf16x8 bfr = *(const bf16x8*)(sB + (ni * 16 + r16) * LDG + ks * 32 + kg);
                acc[ni] = __builtin_amdgcn_mfma_f32_16x16x32_bf16(bfr, af, acc[ni], 0, 0, 0);
            }
        }
        {
            const int cidx = u >> 3, g = u & 7, tt = w * 16 + r16, tok = cidx * 128 + tt;
            const float bias = p.gm_b_s[g * 128 + tt]; float ss = 0.f;
            const uint2 uu[4] = {cu0, cu1, cu2, cu3};
#pragma unroll
            for (int ni = 0; ni < 4; ++ni) {
                const f32x4 a = acc[ni];
                const float v0 = bflo(uu[ni].x) * (a[0] + bias), v1 = bfhi(uu[ni].x) * (a[1] + bias), v2 = bflo(uu[ni].y) * (a[2] + bias), v3 = bfhi(uu[ni].y) * (a[3] + bias);
                ss += v0 * v0 + v1 * v1 + v2 * v2 + v3 * v3;
                *(uint2*)(s.go + (size_t)tok * 1024 + g * 64 + ni * 16 + g4) = pack4(v0, v1, v2, v3);
            }
            ss += __shfl_xor(ss, 16); ss += __shfl_xor(ss, 32);
            if (lane < 16) s.g_ss[tok * 8 + g] = ss;
        }
        if (!has_next) break;
        GM_STORE(cur ^ 1);
        cu0 = ru0; cu1 = ru1; cu2 = ru2; cu3 = ru3;
        __syncthreads();
        cur ^= 1; u = un;
    }
#undef GM_LOAD
#undef GM_STORE
}
__device__ void phase2(const Params& p, unsigned char* smem, bool do_gmlp = true) {
    const WS s = make_ws(p.ws, p.out);
    {
        P2Order S{(const char*)s.latq, (const char*)s.latkv, (const char*)s.wq, (const char*)s.wkv2, (int)gridDim.x, (int)blockIdx.x};
        EpiP2 E{s};
        pg8::gemm_phase<0, false>((LAS unsigned char*)smem, S, E, 256, 256);
    }
    if (do_gmlp) gmlp_phase(p, s, (bf16_t*)smem);
}

DEVINL float quad_max(float x) {
    const unsigned u = __float_as_uint(x);
    const auto r = __builtin_amdgcn_permlane16_swap(u, u, false, false);
    const float m = fmaxf(__uint_as_float(r[0]), __uint_as_float(r[1]));
    const unsigned v = __float_as_uint(m);
    const auto q = __builtin_amdgcn_permlane32_swap(v, v, false, false);
    return fmaxf(__uint_as_float(q[0]), __uint_as_float(q[1]));
}
DEVINL bf16x8 as_bf16x8(u32x4 v) { return __builtin_bit_cast(bf16x8, v); }
__device__ void attn_unit(const WS& s, int b, int h, int qb, bf16_t* smem) {
    constexpr int LK = 104, LV = 72;
    const int t = threadIdx.x, lane = t & 63, w = t >> 6, r16 = lane & 15, g = lane >> 4, kg = g * 8;
    const int q0 = qb * 256, tokb = b * 2048, qw0 = q0 + w * 32;
    bf16x8 qf[2][3];
#pragma unroll
    for (int ni = 0; ni < 2; ++ni)
#pragma unroll
        for (int ks = 0; ks < 3; ++ks)
            qf[ni][ks] = *(const bf16x8*)(s.q + ((size_t)(tokb + qw0 + ni * 16 + r16) * 8 + h) * 96 + ks * 32 + kg);
    f32x4 accO[4][2];
#pragma unroll
    for (int i = 0; i < 4; ++i)
#pragma unroll
        for (int j = 0; j < 2; ++j) accO[i][j] = (f32x4){0.f, 0.f, 0.f, 0.f};
    float mrow[2] = {-1e30f, -1e30f};
    f32x4 accL[2] = {(f32x4){0.f, 0.f, 0.f, 0.f}, (f32x4){0.f, 0.f, 0.f, 0.f}};
    const unsigned one2 = (r16 == 0) ? 0x3f803f80u : 0u;
    const bf16x8 vones = as_bf16x8((u32x4){one2, one2, one2, one2});
    const int nt = 4 * (qb + 1);
    const bf16_t* kp0; const bf16_t* kp1; int ks0, ks1, kd0, kd1;
    const bool k2 = t < 256;
    {
        int c = t, row = c / 12, part = c - row * 12;
        kp0 = part < 8 ? s.k + ((size_t)(tokb + row) * 8 + h) * 64 + part * 8 : s.kr + (size_t)(tokb + row) * 32 + (part - 8) * 8; ks0 = part < 8 ? 512 : 32; kd0 = row * LK + part * 8;
        c = k2 ? t + 512 : t; row = c / 12; part = c - row * 12;
        kp1 = part < 8 ? s.k + ((size_t)(tokb + row) * 8 + h) * 64 + part * 8 : s.kr + (size_t)(tokb + row) * 32 + (part - 8) * 8; ks1 = part < 8 ? 512 : 32; kd1 = row * LK + part * 8;
    }
    const int vrow = t >> 3, vkc = (t & 7) * 8;
    const bf16_t* vp0 = s.vT + ((size_t)((b * 8 + h) * 64 + vrow)) * 2048 + vkc;
    u32x4 rk0, rk1, rv0;
    rk0 = *(const u32x4*)kp0; rk1 = *(const u32x4*)kp1; rv0 = *(const u32x4*)vp0;
    constexpr int STG = 64 * LK + 64 * LV;
    __syncthreads();
    *(u32x4*)(smem + kd0) = rk0; if (k2) *(u32x4*)(smem + kd1) = rk1;
    *(u32x4*)(smem + 64 * LK + vrow * LV + vkc) = rv0;
    __syncthreads();
#pragma nounroll
    for (int kt = 0; kt < nt; ++kt) {
        const bf16_t* sK = smem + (kt & 1) * STG; const bf16_t* sV = sK + 64 * LK;
        if (kt + 1 < nt) {
            const int kn = (kt + 1) * 64;
            rk0 = *(const u32x4*)(kp0 + (size_t)kn * ks0); rk1 = *(const u32x4*)(kp1 + (size_t)kn * ks1);
            rv0 = *(const u32x4*)(vp0 + kn);
        }
        const int key0 = kt * 64;
        if (key0 <= qw0 + 31) {
            f32x4 sacc[4][2];
#pragma unroll
            for (int i = 0; i < 4; ++i)
#pragma unroll
                for (int j = 0; j < 2; ++j) sacc[i][j] = (f32x4){0.f, 0.f, 0.f, 0.f};
#pragma unroll
            for (int ks = 0; ks < 3; ++ks) {
                bf16x8 a[4];
#pragma unroll
                for (int mi = 0; mi < 4; ++mi) a[mi] = *(const bf16x8*)(sK + (mi * 16 + r16) * LK + ks * 32 + kg);
#pragma unroll
                for (int mi = 0; mi < 4; ++mi)
#pragma unroll
                    for (int ni = 0; ni < 2; ++ni) sacc[mi][ni] = __builtin_amdgcn_mfma_f32_16x16x32_bf16(a[mi], qf[ni][ks], sacc[mi][ni], 0, 0, 0);
            }
            if (key0 + 63 > qw0) {
#pragma unroll
                for (int mi = 0; mi < 4; ++mi)
#pragma unroll
                    for (int ni = 0; ni < 2; ++ni)
#pragma unroll
                        for (int r = 0; r < 4; ++r)
                            if (key0 + mi * 16 + g * 4 + r > qw0 + ni * 16 + r16) sacc[mi][ni][r] = -1e30f;
            }
#pragma unroll
            for (int ni = 0; ni < 2; ++ni) {
                float mx = -1e30f;
#pragma unroll
                for (int mi = 0; mi < 4; ++mi)
#pragma unroll
                    for (int r = 0; r < 4; ++r) mx = fmaxf(mx, sacc[mi][ni][r]);
                mx = quad_max(mx);
                const float mn = fmaxf(mrow[ni], mx);
                const bool grow = __any(mx > mrow[ni]);
#pragma unroll
                for (int mi = 0; mi < 4; ++mi)
#pragma unroll
                    for (int r = 0; r < 4; ++r) sacc[mi][ni][r] = __builtin_amdgcn_exp2f(sacc[mi][ni][r] - mn);
                if (grow) {
                    const float al = __builtin_amdgcn_exp2f(mrow[ni] - mn);
                    accL[ni] = accL[ni] * al;
#pragma unroll
                    for (int mo = 0; mo < 4; ++mo) accO[mo][ni] = accO[mo][ni] * al;
                }
                mrow[ni] = mn;
            }
#pragma unroll
            for (int kb = 0; kb < 2; ++kb) {
                bf16x8 pf[2];
#pragma unroll
                for (int ni = 0; ni < 2; ++ni) {
                    const f32x4 s0 = sacc[2 * kb][ni], s1 = sacc[2 * kb + 1][ni];
                    u32x4 pk; pk[0] = pack2(s0[0], s0[1]); pk[1] = pack2(s0[2], s0[3]); pk[2] = pack2(s1[0], s1[1]); pk[3] = pack2(s1[2], s1[3]);
                    pf[ni] = as_bf16x8(pk);
                    accL[ni] = __builtin_amdgcn_mfma_f32_16x16x32_bf16(vones, pf[ni], accL[ni], 0, 0, 0);
                }
#pragma unroll
                for (int mo = 0; mo < 4; ++mo) {
                    const bf16_t* vsrc = sV + (mo * 16 + r16) * LV + 32 * kb + 4 * g;
                    const uint2 lo = *(const uint2*)vsrc, hi = *(const uint2*)(vsrc + 16);
                    u32x4 vv; vv[0] = lo.x; vv[1] = lo.y; vv[2] = hi.x; vv[3] = hi.y;
                    const bf16x8 vf = as_bf16x8(vv);
#pragma unroll
                    for (int ni = 0; ni < 2; ++ni) accO[mo][ni] = __builtin_amdgcn_mfma_f32_16x16x32_bf16(vf, pf[ni], accO[mo][ni], 0, 0, 0);
                }
            }
        }
        if (kt + 1 < nt) {
            bf16_t* dK = smem + ((kt + 1) & 1) * STG;
            *(u32x4*)(dK + kd0) = rk0; if (k2) *(u32x4*)(dK + kd1) = rk1;
            *(u32x4*)(dK + 64 * LK + vrow * LV + vkc) = rv0;
        }
        __syncthreads();
    }
#pragma unroll
    for (int ni = 0; ni < 2; ++ni) {
        float l = accL[ni][0]; l += __shfl_xor(l, 16); l += __shfl_xor(l, 32);
        const float inv = 1.f / l;
        const int tok = tokb + qw0 + ni * 16 + r16; float ss = 0.f;
#pragma unroll
        for (int mo = 0; mo < 4; ++mo) {
            const f32x4 v = accO[mo][ni] * inv;
            ss += v[0] * v[0] + v[1] * v[1] + v[2] * v[2] + v[3] * v[3];
            *(uint2*)(s.ao + (size_t)tok * 1024 + h * 64 + mo * 16 + 4 * g) = pack4v(v);
        }
        ss += __shfl_xor(ss, 16); ss += __shfl_xor(ss, 32);
        if (lane < 16) s.a_ss[tok * 8 + h] = ss;
    }
}
__device__ void phase3(const Params& p, unsigned char* smem) {
    const WS s = make_ws(p.ws, p.out);
    for (int u = blockIdx.x; u < 512; u += gridDim.x) {
        const int half = u >> 8, v = u & 255, x = v >> 6, bh = v & 63;
        attn_unit(s, bh >> 3, bh & 7, half ? x : 7 - x, (bf16_t*)smem);
    }
}

DEVINL void router_superunit(const Params& p, const WS& s, unsigned char* smem, const int u) {
    int t = threadIdx.x; asm volatile("" : "+v"(t));
    const int lane = t & 63, w = t >> 6, i16 = lane & 15, g = lane >> 4;
    f32x4* racc = (f32x4*)smem;
    float* slog = (float*)(smem + 98304);
    int* hist = (int*)(smem + 98304 + 12288);
    {
        const int kb = 128 * w + 8 * g;
        f32x4 acc[4][3];
#pragma unroll
        for (int tl = 0; tl < 4; ++tl)
#pragma unroll
            for (int nt = 0; nt < 3; ++nt) acc[tl][nt] = (f32x4){0.f, 0.f, 0.f, 0.f};
#pragma unroll
        for (int q = 0; q < 4; ++q) {
            const int k = kb + 32 * q;
            f32x4 w0[3], w1[3];
#pragma unroll
            for (int nt = 0; nt < 3; ++nt) { w0[nt] = *(const f32x4*)(s.wrt + (size_t)(nt * 16 + i16) * 1024 + k); w1[nt] = *(const f32x4*)(s.wrt + (size_t)(nt * 16 + i16) * 1024 + k + 4); }
#pragma unroll
            for (int tl = 0; tl < 4; ++tl) {
                const u32x4 xr = *(const u32x4*)(s.x1b + (size_t)(u * 64 + tl * 16 + i16) * 1024 + k);
                const float x0[4] = {bflo(xr[0]), bfhi(xr[0]), bflo(xr[1]), bfhi(xr[1])};
                const float x1[4] = {bflo(xr[2]), bfhi(xr[2]), bflo(xr[3]), bfhi(xr[3])};
#pragma unroll
                for (int nt = 0; nt < 3; ++nt) {
#pragma unroll
                    for (int c = 0; c < 4; ++c) acc[tl][nt] = __builtin_amdgcn_mfma_f32_16x16x4f32(x0[c], w0[nt][c], acc[tl][nt], 0, 0, 0);
#pragma unroll
                    for (int c = 0; c < 4; ++c) acc[tl][nt] = __builtin_amdgcn_mfma_f32_16x16x4f32(x1[c], w1[nt][c], acc[tl][nt], 0, 0, 0);
                }
            }
        }
        __syncthreads();
#pragma unroll
        for (int tl = 0; tl < 4; ++tl)
#pragma unroll
            for (int nt = 0; nt < 3; ++nt) racc[(w * 12 + tl * 3 + nt) * 64 + lane] = acc[tl][nt];
        if (t < 32) hist[t] = 0;
        __syncthreads();
        for (int item = t; item < 12 * 64; item += NTHR) {
            const int tn = item >> 6, ln = item & 63, tl = tn / 3, nt = tn - tl * 3;
            f32x4 v = racc[tn * 64 + ln];
#pragma unroll
            for (int ww = 1; ww < 8; ++ww) v = v + racc[(ww * 12 + tn) * 64 + ln];
            const int n = nt * 16 + (ln & 15), gq = ln >> 4;
#pragma unroll
            for (int r = 0; r < 4; ++r) slog[(tl * 16 + 4 * gq + r) * 48 + n] = v[r];
        }
        __syncthreads();
        int e0 = 0, e1 = 0, rk0 = 0, rk1 = 0; float gate0 = 0.f, gate1 = 0.f;
        if (t < 64) {
            const float* lg = slog + t * 48;
            const float l0 = lg[0] + p.b_rg[0], l1 = lg[1] + p.b_rg[1], l2 = lg[2] + p.b_rg[2], l3 = lg[3] + p.b_rg[3];
            int gi = 0; float gm = l0;
            if (l1 > gm) { gm = l1; gi = 1; }
            if (l2 > gm) { gm = l2; gi = 2; }
            if (l3 > gm) { gm = l3; gi = 3; }
            const float gp = 1.f / (expf(l0 - gm) + expf(l1 - gm) + expf(l2 - gm) + expf(l3 - gm));
            float le[8];
#pragma unroll
            for (int j = 0; j < 8; ++j) le[j] = lg[4 + gi * 8 + j] + p.b_re[gi * 8 + j];
            int i0 = 0; float m0v = le[0];
#pragma unroll
            for (int j = 1; j < 8; ++j) if (le[j] > m0v) { m0v = le[j]; i0 = j; }
            int i1 = -1; float m1v = -3.0e38f;
#pragma unroll
            for (int j = 0; j < 8; ++j) if (j != i0 && le[j] > m1v) { m1v = le[j]; i1 = j; }
            const float pe1 = expf(m1v - m0v);
            gate0 = gp / (1.f + pe1); gate1 = gp * pe1 / (1.f + pe1);
            e0 = gi * 8 + i0; e1 = gi * 8 + i1;
            rk0 = atomicAdd(&hist[e0], 1); rk1 = atomicAdd(&hist[e1], 1);
        }
        __syncthreads();
        if (t < 32) { const int c = hist[t]; hist[32 + t] = c ? atomicAdd(&s.cnt[t * 64], c) : 0; }
        __syncthreads();
        if (t < 64) {
            const int tk = u * 64 + t;
            const int pos0 = hist[32 + e0] + rk0, pos1 = hist[32 + e1] + rk1;
            s.list[e0 * 16384 + pos0] = tk * 2; s.gatew[tk * 2] = gate0; s.asgep[tk * 2] = (e0 << 16) | pos0;
            s.list[e1 * 16384 + pos1] = tk * 2 + 1; s.gatew[tk * 2 + 1] = gate1; s.asgep[tk * 2 + 1] = (e1 << 16) | pos1;
        }
    }
}

__device__ void phase5(const Params& p, unsigned char* smem) {
    const WS s = make_ws(p.ws, p.out);
    for (int u = blockIdx.x; u < T_ / 64; u += gridDim.x) router_superunit(p, s, smem, u);
}

struct EpiP4 {
    const Params* p; WS s; unsigned* gcnt;
    DEVINL void mid(f32x4 (&acc)[2][2][4][2], const pg8::Unit& u, int wr, int wc, int fr, int fq) const {
#pragma unroll
        for (int ai = 0; ai < 2; ++ai)
#pragma unroll
            for (int m = 0; m < 4; ++m) {
                const float sc = s.rowsc[u.a0 * 256 + ai * 128 + wr * 64 + m * 16 + fr].x;
#pragma unroll
                for (int bj = 0; bj < 2; ++bj)
#pragma unroll
                    for (int n = 0; n < 2; ++n) acc[ai][bj][m][n] = acc[ai][bj][m][n] * sc;
            }
    }
    DEVINL void operator()(const f32x4 (&)[2][2][4][2], const pg8::Unit&, int, int, int, int) const {}
    DEVINL void final(f32x4 (&acc)[2][2][4][2], const pg8::Unit& u, int wr_, int wc_, int fr_, int fq_, LAS unsigned char* lds) const {
        float2* red = (float2*)lds;
        int t2 = threadIdx.x; asm volatile("" : "+v"(t2));
        const int wid2 = t2 >> 6, wr = wid2 >> 2, wc = wid2 & 3, fr = t2 & 15, fq = (t2 >> 4) & 3;
        const int row0 = u.a0 * 256 + wr * 64 + fr, col0 = u.a1 * 256 + wc * 32 + fq * 4;
        float rgv[2][4];
#pragma unroll
        for (int ai = 0; ai < 2; ++ai)
#pragma unroll
            for (int m = 0; m < 4; ++m) rgv[ai][m] = s.rowsc[row0 + ai * 128 + m * 16].y;
        uint2 xn[2][2];
#pragma unroll
        for (int bj = 0; bj < 2; ++bj)
#pragma unroll
            for (int n = 0; n < 2; ++n) xn[bj][n] = *(const uint2*)(s.xb + (size_t)row0 * 1024 + col0 + bj * 128 + n * 16);
#pragma unroll
        for (int it = 0; it < 8; ++it) {
            const int ai = it >> 2, m = it & 3, rl = ai * 128 + wr * 64 + m * 16 + fr;
            uint2 xc[2][2];
#pragma unroll
            for (int bj = 0; bj < 2; ++bj)
#pragma unroll
                for (int n = 0; n < 2; ++n) xc[bj][n] = xn[bj][n];
            asm volatile("" ::: "memory");
            if (it < 7) {
                const int ai2 = (it + 1) >> 2, m2 = (it + 1) & 3;
#pragma unroll
                for (int bj = 0; bj < 2; ++bj)
#pragma unroll
                    for (int n = 0; n < 2; ++n) xn[bj][n] = *(const uint2*)(s.xb + (size_t)(row0 + ai2 * 128 + m2 * 16) * 1024 + col0 + bj * 128 + n * 16);
            }
            float sum = 0.f, sq = 0.f;
#pragma unroll
            for (int bj = 0; bj < 2; ++bj)
#pragma unroll
                for (int n = 0; n < 2; ++n) {
                    const f32x4 xf = {bflo(xc[bj][n].x), bfhi(xc[bj][n].x), bflo(xc[bj][n].y), bfhi(xc[bj][n].y)};
                    const f32x4 a = acc[ai][bj][m][n] * rgv[ai][m] + xf * ALPHA_;
                    acc[ai][bj][m][n] = a;
                    sum += (a[0] + a[1]) + (a[2] + a[3]); sq += (a[0] * a[0] + a[1] * a[1]) + (a[2] * a[2] + a[3] * a[3]);
                }
            sum += __shfl_xor(sum, 16); sum += __shfl_xor(sum, 32); sq += __shfl_xor(sq, 16); sq += __shfl_xor(sq, 32);
            if (fq == 0) red[rl * 4 + wc] = make_float2(sum, sq);
        }
        __syncthreads();
        int tl = threadIdx.x; asm volatile("" : "+v"(tl));
        if (tl < 256) {
            const float2 r0 = red[tl * 4 + 0], r1 = red[tl * 4 + 1], r2 = red[tl * 4 + 2], r3 = red[tl * 4 + 3];
            st_wt8(&s.part[(size_t)(u.a0 * 256 + tl) * 4 + u.a1], make_uint2(__float_as_uint((r0.x + r1.x) + (r2.x + r3.x)), __float_as_uint((r0.y + r1.y) + (r2.y + r3.y))));
        }
        group_sync(gcnt + (u.a0 * 4 + 0) * 64, 4u);
        float mean[2][4], rstd[2][4];
#pragma unroll
        for (int ai = 0; ai < 2; ++ai)
#pragma unroll
            for (int m = 0; m < 4; ++m) {
                const int row = row0 + ai * 128 + m * 16;
                const float4 p01 = *(const float4*)(s.part + (size_t)row * 4), p23 = *(const float4*)(s.part + (size_t)row * 4 + 2);
                const float mu = ((p01.x + p01.z) + (p23.x + p23.z)) * (1.f / 1024.f);
                const float var = ((p01.y + p01.w) + (p23.y + p23.w)) * (1.f / 1024.f) - mu * mu;
                mean[ai][m] = mu; rstd[ai][m] = rsqrtf(fmaxf(var, 0.f) + EPS_);
            }
        f32x4 gg[2][2], bb[2][2];
#pragma unroll
        for (int bj = 0; bj < 2; ++bj)
#pragma unroll
            for (int n = 0; n < 2; ++n) { gg[bj][n] = *(const f32x4*)(p->ln1_g + col0 + bj * 128 + n * 16); bb[bj][n] = *(const f32x4*)(p->ln1_b + col0 + bj * 128 + n * 16); }
#pragma unroll
        for (int ai = 0; ai < 2; ++ai)
#pragma unroll
            for (int m = 0; m < 4; ++m) {
                const int row = row0 + ai * 128 + m * 16;
#pragma unroll
                for (int bj = 0; bj < 2; ++bj)
#pragma unroll
                    for (int n = 0; n < 2; ++n) {
                        const f32x4 o = (acc[ai][bj][m][n] - mean[ai][m]) * rstd[ai][m] * gg[bj][n] + bb[bj][n];
                        st_wt8(s.x1b + (size_t)row * 1024 + col0 + bj * 128 + n * 16, pack4v(o));
                    }
            }
        group_sync(gcnt + (u.a0 * 4 + 1) * 64, 4u);
        router_superunit(*p, s, (unsigned char*)lds, u.a0 * 4 + u.a1);
    }
};
__device__ void phase4(const Params& p, unsigned char* smem) {
    const WS s = make_ws(p.ws, p.out);
    pg8::DenseOrder S{(const char*)s.ao, (const char*)s.wo, 1024, 1024, 64, 4, (int)gridDim.x, (int)blockIdx.x, REP_P4};
    { pg8::Unit u;
      for (int i = 0; S.next(i, u); ++i)
          if (threadIdx.x < 256) {
              const int row = u.a0 * 256 + threadIdx.x;
              const float4 a0 = *(const float4*)(s.a_ss + row * 8), a1 = *(const float4*)(s.a_ss + row * 8 + 4);
              const float4 g0 = *(const float4*)(s.g_ss + row * 8), g1 = *(const float4*)(s.g_ss + row * 8 + 4);
              const float ra = rsqrtf((a0.x + a0.y + a0.z + a0.w + a1.x + a1.y + a1.z + a1.w) * (1.f / 512.f) + EPS_);
              const float rg = rsqrtf((g0.x + g0.y + g0.z + g0.w + g1.x + g1.y + g1.z + g1.w) * (1.f / 512.f) + EPS_);
              s.rowsc[row] = make_float2(ra / rg, rg);
          }
      asm volatile("s_waitcnt vmcnt(0)" ::: "memory");
      __syncthreads(); }
    EpiP4 E{&p, s, (unsigned*)(p.ws + WS_GCNT)};
    pg8::gemm_phase<8, true>((LAS unsigned char*)smem, S, E, 1024, 1024);
}

struct MoeMeta { int cnt[32]; int tstart[33]; int hbase[33]; };
DEVINL void moe_meta(const WS& s, MoeMeta* mm) {
    __syncthreads();
    if (threadIdx.x == 0) {
        int ts = 0, hb = 0;
        for (int e = 0; e < 32; ++e) { const int c = s.cnt[e * 64]; mm->cnt[e] = c; mm->tstart[e] = ts; mm->hbase[e] = hb; ts += (c + 255) >> 8; hb += c; }
        mm->tstart[32] = ts; mm->hbase[32] = hb;
    }
    __syncthreads();
}
struct MoeOrder {
    const MoeMeta* mm; const int* list; const char* Abase; const char* Bbase; size_t bstride_e, bstride_pn; int mode, G, c, rep;
    DEVINL bool next(int i, pg8::Unit& u) const {
        const int nwg = mm->tstart[32] * 4; const long L = (long)i * G + c; if (L >= (long)nwg * rep) return false;
        int wgid = (int)(L % nwg); { const int q = nwg / 8, r = nwg % 8, xcd = wgid % 8, off = wgid / 8; wgid = (xcd < r ? xcd * (q + 1) : r * (q + 1) + (xcd - r) * q) + off; }
        const int ti = wgid >> 2, pn = wgid & 3;
        int e = 0; while (mm->tstart[e + 1] <= ti) ++e;
        const int it = ti - mm->tstart[e];
        u.A = Abase; u.B = Bbase + (size_t)e * bstride_e + (size_t)pn * bstride_pn;
        u.a0 = e * 16384 + it * 256; u.a1 = mm->hbase[e] + it * 256; u.a2 = pn; u.a3 = min(256, mm->cnt[e] - it * 256);
        return true;
    }
    DEVINL unsigned arow(const pg8::Unit& u, int r) const {
        const int rr = min(r, u.a3 - 1);
        if (mode == 0) return (unsigned)(list[u.a0 + rr] >> 1) * 2048u;
        return (unsigned)(u.a1 + rr) * 1024u;
    }
};
struct EpiP6 {
    WS s;
    DEVINL void mid(f32x4 (&)[2][2][4][2], const pg8::Unit&, int, int, int, int) const {}
    DEVINL void operator()(const f32x4 (&acc)[2][2][4][2], const pg8::Unit& u, int wr, int wc, int fr, int fq) const {
#pragma unroll
        for (int ai = 0; ai < 2; ++ai)
#pragma unroll
            for (int m = 0; m < 4; ++m) {
                const int r = ai * 128 + wr * 64 + m * 16 + fr;
                if (r < u.a3) {
#pragma unroll
                    for (int bj = 0; bj < 2; ++bj) {
                        const f32x4 gt = acc[ai][bj][m][0], up = acc[ai][bj][m][1];
                        float hv[4];
#pragma unroll
                        for (int q = 0; q < 4; ++q) hv[q] = gt[q] * fast_sigmoid(gt[q]) * up[q];
                        *(uint2*)(s.H + (size_t)(u.a1 + r) * 512 + u.a2 * 128 + bj * 64 + wc * 16 + fq * 4) = pack4(hv[0], hv[1], hv[2], hv[3]);
                    }
                }
            }
    }
};
struct EpiP7 {
    WS s;
    DEVINL void mid(f32x4 (&)[2][2][4][2], const pg8::Unit&, int, int, int, int) const {}
    DEVINL void operator()(const f32x4 (&acc)[2][2][4][2], const pg8::Unit& u, int wr, int wc, int fr, int fq) const {
#pragma unroll
        for (int ai = 0; ai < 2; ++ai)
#pragma unroll
            for (int m = 0; m < 4; ++m) {
                const int r = ai * 128 + wr * 64 + m * 16 + fr;
                if (r < u.a3) {
#pragma unroll
                    for (int bj = 0; bj < 2; ++bj)
#pragma unroll
                        for (int n = 0; n < 2; ++n)
                            *(uint2*)(s.ymoe + (size_t)(u.a1 + r) * 1024 + u.a2 * 256 + bj * 128 + wc * 32 + n * 16 + fq * 4) = pack4v(acc[ai][bj][m][n]);
                }
            }
    }
};
DEVINL size_t pp_off(int row, int col) { return (size_t)(row >> 8) * 524288 + 262144 + (size_t)(row & 255) * 1024 + col; }
struct EpiP9a {
    bf16_t* pp;
    DEVINL void mid(f32x4 (&)[2][2][4][2], const pg8::Unit&, int, int, int, int) const {}
    DEVINL void operator()(const f32x4 (&acc)[2][2][4][2], const pg8::Unit& u, int wr, int wc, int fr, int fq) const {
#pragma unroll
        for (int ai = 0; ai < 2; ++ai)
#pragma unroll
            for (int m = 0; m < 4; ++m) {
                const int row = u.a0 * 256 + ai * 128 + wr * 64 + m * 16 + fr;
#pragma unroll
                for (int bj = 0; bj < 2; ++bj)
#pragma unroll
                    for (int n = 0; n < 2; ++n)
                        *(uint2*)(pp + pp_off(row, u.a1 * 256 + bj * 128 + wc * 32 + n * 16 + fq * 4)) = pack4v(acc[ai][bj][m][n]);
            }
    }
};
DEVINL void ln2_rows64(const Params& p, const WS& s, const MoeMeta* mm, const int tok0) {
    int t = threadIdx.x; asm volatile("" : "+v"(t));
    const int lane = t & 63, w = t >> 6;
#pragma unroll 1
    for (int half = 0; half < 2; ++half) {
        float v[4][16];
#pragma unroll
        for (int r = 0; r < 4; ++r) {
            const int tok = tok0 + w + 8 * (half * 4 + r);
            const int ep0 = s.asgep[tok * 2], ep1 = s.asgep[tok * 2 + 1];
            const float g0 = s.gatew[tok * 2], g1 = s.gatew[tok * 2 + 1];
            const size_t r0 = (size_t)(mm->hbase[ep0 >> 16] + (ep0 & 0xffff)) * 1024, r1 = (size_t)(mm->hbase[ep1 >> 16] + (ep1 & 0xffff)) * 1024;
#pragma unroll
            for (int i = 0; i < 4; ++i) {
                const int c = i * 256 + lane * 4;
                const uint2 a = *(const uint2*)(s.x1b + (size_t)tok * 1024 + c);
                const uint2 y0 = *(const uint2*)(s.ymoe + r0 + c), y1 = *(const uint2*)(s.ymoe + r1 + c);
                v[r][i * 4 + 0] = ALPHA_ * bflo(a.x) + (g0 * bflo(y0.x) + g1 * bflo(y1.x)); v[r][i * 4 + 1] = ALPHA_ * bfhi(a.x) + (g0 * bfhi(y0.x) + g1 * bfhi(y1.x));
                v[r][i * 4 + 2] = ALPHA_ * bflo(a.y) + (g0 * bflo(y0.y) + g1 * bflo(y1.y)); v[r][i * 4 + 3] = ALPHA_ * bfhi(a.y) + (g0 * bfhi(y0.y) + g1 * bfhi(y1.y));
            }
        }
#pragma unroll
        for (int r = 0; r < 4; ++r) {
            const int tok = tok0 + w + 8 * (half * 4 + r);
            float sum = 0.f;
#pragma unroll
            for (int i = 0; i < 16; ++i) sum += v[r][i];
            const float mean = wave_sum(sum) * (1.f / 1024.f); float sq = 0.f;
#pragma unroll
            for (int i = 0; i < 16; ++i) { const float d = v[r][i] - mean; sq += d * d; }
            const float rstd = rsqrtf(wave_sum(sq) * (1.f / 1024.f) + EPS_);
#pragma unroll
            for (int i = 0; i < 4; ++i) {
                const int c = i * 256 + lane * 4;
                const float4 gg = *(const float4*)(p.ln2_g + c), bb = *(const float4*)(p.ln2_b + c);
                st_wt8(s.x2b + (size_t)tok * 1024 + c, pack4((v[r][i * 4 + 0] - mean) * rstd * gg.x + bb.x, (v[r][i * 4 + 1] - mean) * rstd * gg.y + bb.y,
                                                              (v[r][i * 4 + 2] - mean) * rstd * gg.z + bb.z, (v[r][i * 4 + 3] - mean) * rstd * gg.w + bb.w));
            }
        }
    }
}

__device__ void phase6(const Params& p, unsigned char* smem, MoeMeta* mm) {
    const WS s = make_ws(p.ws, p.out);
    moe_meta(s, mm);
    MoeOrder S{mm, s.list, (const char*)s.x1b, (const char*)s.wgu, (size_t)1024 * 1024 * 2, (size_t)256 * 1024 * 2, 0, (int)gridDim.x, (int)blockIdx.x, REP_P6};
    EpiP6 E{s};
    pg8::gemm_phase<0, false, (EPI2 == 6 ? 2 : 1)>((LAS unsigned char*)smem, S, E, 1024, 1024);
    int j, nh; helper_slot(mm->tstart[32] * 4 * REP_P6, (int)gridDim.x, (int)blockIdx.x, j, nh);
    if (j >= 0) {
        conv_expert_tiles(p, s, 1, j, 32 * 128, nh, (float*)smem);
        for (size_t i = (size_t)j * NTHR + threadIdx.x; i < (size_t)T_ * 256 / 8; i += (size_t)nh * NTHR) cvt8(p.p + i * 8, s.pb + i * 8);
    }
}
__device__ void phase7(const Params& p, unsigned char* smem, MoeMeta* mm) {
    const WS s = make_ws(p.ws, p.out);
    moe_meta(s, mm);
    MoeOrder S{mm, s.list, (const char*)s.H, (const char*)s.wd, (size_t)1024 * 512 * 2, (size_t)256 * 512 * 2, 1, (int)gridDim.x, (int)blockIdx.x, REP_P7};
    EpiP7 E{s};
    pg8::gemm_phase<0, false, (EPI2 == 7 ? 2 : 1)>((LAS unsigned char*)smem, S, E, 512, 512);
    int j, nh; helper_slot(mm->tstart[32] * 4 * REP_P7, (int)gridDim.x, (int)blockIdx.x, j, nh);
    if (j >= 0) {
        pg8::DenseOrder Sa{(const char*)s.pb, (const char*)s.wpp, 256, 256, 64, 4, nh, j, 1};
        EpiP9a Ea{(bf16_t*)p.out};
        pg8::gemm_phase<0, false, (EPI2 == 9 ? 2 : 1)>((LAS unsigned char*)smem, Sa, Ea, 256, 256);
    }
}

struct EpiP9b {
    const Params* p; WS s; const bf16_t* pp; unsigned* gcnt;
    DEVINL void mid(f32x4 (&)[2][2][4][2], const pg8::Unit&, int, int, int, int) const {}
    DEVINL void operator()(const f32x4 (&)[2][2][4][2], const pg8::Unit&, int, int, int, int) const {}
    DEVINL void final(f32x4 (&acc)[2][2][4][2], const pg8::Unit& u, int wr_, int wc_, int fr_, int fq_, LAS unsigned char* lds) const {
        float2* red = (float2*)lds;
        int t2 = threadIdx.x; asm volatile("" : "+v"(t2));
        const int wid2 = t2 >> 6, wr = wid2 >> 2, wc = wid2 & 3, fr = t2 & 15, fq = (t2 >> 4) & 3;
        const int row0 = u.a0 * 256 + wr * 64 + fr, col0 = u.a1 * 256 + wc * 32 + fq * 4;
        uint2 xn[2][2], pn_[2][2];
#pragma unroll
        for (int bj = 0; bj < 2; ++bj)
#pragma unroll
            for (int n = 0; n < 2; ++n) { xn[bj][n] = *(const uint2*)(s.x2b + (size_t)row0 * 1024 + col0 + bj * 128 + n * 16); pn_[bj][n] = *(const uint2*)(pp + pp_off(row0, col0 + bj * 128 + n * 16)); }
#pragma unroll
        for (int it = 0; it < 8; ++it) {
            const int ai = it >> 2, m = it & 3, rl = ai * 128 + wr * 64 + m * 16 + fr;
            float sum = 0.f, sq = 0.f;
#pragma unroll
            for (int bj = 0; bj < 2; ++bj)
#pragma unroll
                for (int n = 0; n < 2; ++n) {
                    const f32x4 a = acc[ai][bj][m][n] + *(const f32x4*)(p->b_pg + col0 + bj * 128 + n * 16);
                    const uint2 xr = xn[bj][n], pr = pn_[bj][n];
                    f32x4 o;
                    o[0] = ALPHA_ * bflo(xr.x) + bflo(pr.x) * fast_sigmoid(a[0]);
                    o[1] = ALPHA_ * bfhi(xr.x) + bfhi(pr.x) * fast_sigmoid(a[1]);
                    o[2] = ALPHA_ * bflo(xr.y) + bflo(pr.y) * fast_sigmoid(a[2]);
                    o[3] = ALPHA_ * bfhi(xr.y) + bfhi(pr.y) * fast_sigmoid(a[3]);
                    acc[ai][bj][m][n] = o;
                    sum += (o[0] + o[1]) + (o[2] + o[3]); sq += (o[0] * o[0] + o[1] * o[1]) + (o[2] * o[2] + o[3] * o[3]);
                }
            asm volatile("" ::: "memory");
            if (it < 7) {
                const int rn = row0 + ((it + 1) >> 2) * 128 + ((it + 1) & 3) * 16; const size_t ro = (size_t)rn * 1024 + col0;
#pragma unroll
                for (int bj = 0; bj < 2; ++bj)
#pragma unroll
                    for (int n = 0; n < 2; ++n) { xn[bj][n] = *(const uint2*)(s.x2b + ro + bj * 128 + n * 16); pn_[bj][n] = *(const uint2*)(pp + pp_off(rn, col0 + bj * 128 + n * 16)); }
            }
            sum += __shfl_xor(sum, 16); sum += __shfl_xor(sum, 32); sq += __shfl_xor(sq, 16); sq += __shfl_xor(sq, 32);
            if (fq == 0) red[rl * 4 + wc] = make_float2(sum, sq);
        }
        __syncthreads();
        int tl = threadIdx.x; asm volatile("" : "+v"(tl));
        if (tl < 256) {
            const float2 r0 = red[tl * 4 + 0], r1 = red[tl * 4 + 1], r2 = red[tl * 4 + 2], r3 = red[tl * 4 + 3];
            st_wt8(&s.part[(size_t)(u.a0 * 256 + tl) * 4 + u.a1], make_uint2(__float_as_uint((r0.x + r1.x) + (r2.x + r3.x)), __float_as_uint((r0.y + r1.y) + (r2.y + r3.y))));
        }
        group_sync(gcnt + (u.a0 * 4 + 2) * 64, 4u);
        float mean[2][4], rstd[2][4];
#pragma unroll
        for (int ai = 0; ai < 2; ++ai)
#pragma unroll
            for (int m = 0; m < 4; ++m) {
                const int row = row0 + ai * 128 + m * 16;
                const float4 p01 = *(const float4*)(s.part + (size_t)row * 4), p23 = *(const float4*)(s.part + (size_t)row * 4 + 2);
                const float mu = ((p01.x + p01.z) + (p23.x + p23.z)) * (1.f / 1024.f);
                const float var = ((p01.y + p01.w) + (p23.y + p23.w)) * (1.f / 1024.f) - mu * mu;
                mean[ai][m] = mu; rstd[ai][m] = rsqrtf(fmaxf(var, 0.f) + EPS_);
            }
#pragma unroll
        for (int ai = 0; ai < 2; ++ai)
#pragma unroll
            for (int m = 0; m < 4; ++m) {
                const int row = row0 + ai * 128 + m * 16;
#pragma unroll
                for (int bj = 0; bj < 2; ++bj)
#pragma unroll
                    for (int n = 0; n < 2; ++n) {
                        const f32x4 gg = *(const f32x4*)(p->ln3_g + col0 + bj * 128 + n * 16), bb = *(const f32x4*)(p->ln3_b + col0 + bj * 128 + n * 16);
                        __builtin_nontemporal_store((acc[ai][bj][m][n] - mean[ai][m]) * rstd[ai][m] * gg + bb, (f32x4*)(p->out + (size_t)row * 1024 + col0 + bj * 128 + n * 16));
                    }
                asm volatile("" ::: "memory");
            }
    }
};
__device__ void phase9(const Params& p, unsigned char* smem, MoeMeta* mm) {
    const WS s = make_ws(p.ws, p.out);
    moe_meta(s, mm);
    unsigned* gcnt = (unsigned*)(p.ws + WS_GCNT);
    pg8::DenseOrder S{(const char*)s.x2b, (const char*)s.wpg, 1024, 1024, 64, 4, (int)gridDim.x, (int)blockIdx.x, 1};
    pg8::Unit u0;
    if (!S.next(0, u0)) return;
    ln2_rows64(p, s, mm, u0.a0 * 256 + u0.a1 * 64);
    group_sync(gcnt + (u0.a0 * 4 + 3) * 64, 4u);
    const bf16_t* pp = (const bf16_t*)p.out;
    {
        EpiP9b E{&p, s, pp, gcnt};
        pg8::gemm_phase<0, true>((LAS unsigned char*)smem, S, E, 1024, 1024);
    }
}

constexpr int NPHASE = 11;
template <int LO, int HI>
__global__ void __launch_bounds__(NTHR, 2) fwd_kernel(Params p) {
    extern __shared__ __attribute__((aligned(16))) unsigned char smem[];
    MoeMeta& mm = *(MoeMeta*)(smem + LDS_META);
    XcdBarrier bar;
    if (HI - LO > 1) {
        if (threadIdx.x < 4) ((unsigned*)(smem + LDS_XB))[threadIdx.x] = 0u;
        __syncthreads();
        bar = xcd_barrier_post((unsigned*)(p.ws + WS_BAR), (volatile LAS unsigned*)(smem + LDS_XB));
#if USE_COOP
        if (p.use_cg_sync) cg::this_grid().sync();
#endif
    }
#ifndef REP_PHASE
#define REP_PHASE -1
#endif
#define PH(k) _Pragma("nounroll") for (int rep_ = 0; rep_ < ((REP_PHASE == (k)) ? 2 + p.use_cg_sync : 1); ++rep_) if (LO <= (k) && (k) < HI)
#define SYNC(k) if (LO <= (k) && (k) + 1 < HI) { if ((k) == LO) xcd_barrier<true>(bar); else xcd_barrier<false>(bar); }
    PH(0) { phase0(p, smem); if (REP_PHASE == 0 && rep_ == 0) xcd_barrier<true>(bar); } SYNC(0)
    PH(1) { phase1(p, smem); if (REP_PHASE == 1 && rep_ == 0) xcd_barrier(bar); } SYNC(1)
    PH(2) { phase2(p, smem, REP_PHASE != 2 || rep_ == 1); if (REP_PHASE == 2 && rep_ == 0) xcd_barrier(bar); } SYNC(2)
    PH(3) { phase3(p, smem); if (REP_PHASE == 3 && rep_ == 0) xcd_barrier(bar); } SYNC(3)
    PH(4) { phase4(p, smem); } SYNC(4)
    PH(6) { phase6(p, smem, &mm); if (REP_PHASE == 6 && rep_ == 0) xcd_barrier(bar); } SYNC(6)
    PH(7) { phase7(p, smem, &mm); if (REP_PHASE == 7 && rep_ == 0) xcd_barrier(bar); } SYNC(7)
    PH(9) { phase9(p, smem, &mm); }
#undef PH
#undef SYNC
}

template <int K> static void launch_one(const Params& prm, int grid, hipStream_t stream) {
    hipFuncSetAttribute((const void*)fwd_kernel<K, K + 1>, hipFuncAttributeMaxDynamicSharedMemorySize, LDS_BYTES);
    hipLaunchKernelGGL((fwd_kernel<K, K + 1>), dim3(grid), dim3(NTHR), LDS_BYTES, stream, prm);
}

extern "C" void kernel_launch(void* const* d_in, const int* in_sizes, int n_in, void* d_out, int out_size, void* d_ws, size_t ws_size,
                              hipStream_t stream) {
    if (n_in != 31 || ws_size < WS_END) { fprintf(stderr, "kernel_launch: unexpected n_in %d / ws_size %zu\n", n_in, ws_size); return; }
    Params prm{};
    prm.x = (const float*)d_in[0]; prm.p = (const float*)d_in[1]; prm.pos = (const int*)d_in[2];
    prm.w_in = (const float*)d_in[3]; prm.q_norm_g = (const float*)d_in[4]; prm.w_q_up = (const float*)d_in[5];
    prm.kv_norm_g = (const float*)d_in[6]; prm.w_kv_up = (const float*)d_in[7]; prm.gm_ln_g = (const float*)d_in[8];
    prm.gm_ln_b = (const float*)d_in[9]; prm.gm_w_s = (const float*)d_in[10]; prm.gm_b_s = (const float*)d_in[11];
    prm.mla_out_g = (const float*)d_in[12]; prm.gm_out_g = (const float*)d_in[13]; prm.w_o = (const float*)d_in[14];
    prm.ln1_g = (const float*)d_in[15]; prm.ln1_b = (const float*)d_in[16]; prm.w_rg = (const float*)d_in[17];
    prm.b_rg = (const float*)d_in[18]; prm.w_re = (const float*)d_in[19]; prm.b_re = (const float*)d_in[20];
    prm.w_gate = (const float*)d_in[21]; prm.w_up = (const float*)d_in[22]; prm.w_down = (const float*)d_in[23];
    prm.ln2_g = (const float*)d_in[24]; prm.ln2_b = (const float*)d_in[25]; prm.w_pg = (const float*)d_in[26];
    prm.b_pg = (const float*)d_in[27]; prm.w_pp = (const float*)d_in[28]; prm.ln3_g = (const float*)d_in[29];
    prm.ln3_b = (const float*)d_in[30];
    prm.out = (float*)d_out; prm.ws = (unsigned char*)d_ws;
    for (int j = 0; j < 16; ++j) prm.inv_freq[j] = (float)pow(10000.0, -(double)j / 16.0);
#if N_LAUNCH_MODE == 0
    const int grid = 1024;
    launch_one<0>(prm, grid, stream); launch_one<1>(prm, grid, stream); launch_one<2>(prm, grid, stream);
    launch_one<3>(prm, grid, stream); launch_one<4>(prm, grid, stream); launch_one<5>(prm, grid, stream);
    launch_one<6>(prm, grid, stream); launch_one<7>(prm, grid, stream); launch_one<8>(prm, grid, stream);
    launch_one<9>(prm, grid, stream); launch_one<10>(prm, grid, stream);
#else
    static int grid_blocks = 0;
    if (!grid_blocks) {
        int dev = 0, cus = 0, per_cu = 0;
        hipGetDevice(&dev);
        hipDeviceGetAttribute(&cus, hipDeviceAttributeMultiprocessorCount, dev);
        if (hipFuncSetAttribute((const void*)fwd_kernel<0, NPHASE>, hipFuncAttributeMaxDynamicSharedMemorySize, LDS_BYTES) != hipSuccess)
            fprintf(stderr, "kernel_launch: hipFuncSetAttribute(%d B dynamic LDS) failed\n", LDS_BYTES);
        hipOccupancyMaxActiveBlocksPerMultiprocessor(&per_cu, (const void*)fwd_kernel<0, NPHASE>, NTHR, LDS_BYTES);
        if (per_cu < 1) fprintf(stderr, "kernel_launch: occupancy query reports %d blocks per CU\n", per_cu);
        (void)hipGetLastError();
        grid_blocks = cus;
    }
    hipMemsetAsync((unsigned char*)d_ws + WS_BAR, 0, XCD_BAR_WORDS * 4, stream);
    hipMemsetAsync((unsigned char*)d_ws + WS_GCNT, 0, 64 * 4 * 256, stream);
#if USE_COOP
    void* args[] = {&prm};
    hipError_t e = hipLaunchCooperativeKernel((const void*)fwd_kernel<0, NPHASE>, dim3(grid_blocks), dim3(NTHR), args, LDS_BYTES, stream);
    if (e != hipSuccess) fprintf(stderr, "cooperative launch failed: %s (grid %d)\n", hipGetErrorString(e), grid_blocks);
#else
    hipLaunchKernelGGL((fwd_kernel<0, NPHASE>), dim3(grid_blocks), dim3(NTHR), LDS_BYTES, stream, prm);
#endif
#endif
}
```

```cpp
#include <hip/hip_runtime.h>
#include <hip/hip_cooperative_groups.h>
#include <stdint.h>
#include <math.h>
#include <stdio.h>
namespace cg = cooperative_groups;

#ifndef USE_COOP
#define USE_COOP 0
#endif
#ifndef N_LAUNCH_MODE
#define N_LAUNCH_MODE 1
#endif

#define DEVINL __device__ __forceinline__
typedef unsigned short bf16_t;
typedef short bf16x8 __attribute__((ext_vector_type(8)));
typedef float f32x4 __attribute__((ext_vector_type(4)));
typedef unsigned u32x4 __attribute__((ext_vector_type(4)));

constexpr int T_ = 16384, D_ = 1024, SEQ_ = 2048;
constexpr float ALPHA_ = 1.189207115002721f;
constexpr float EPS_ = 1e-6f;
constexpr int LDK = 72;
constexpr int NTHR = 512;
constexpr int LDS_STAGE = 131072;
constexpr int LDS_META = LDS_STAGE;
constexpr int LDS_XB = LDS_STAGE + 1024;
constexpr int LDS_BYTES = LDS_STAGE + 2048;

constexpr size_t MiB = 1ull << 20;
constexpr size_t WS_WGU = 0;
constexpr size_t WS_WD = 64 * MiB;
constexpr size_t WS_WPG = 96 * MiB;
constexpr size_t WS_WPP = 98 * MiB;
constexpr size_t WS_WIN = 98 * MiB + 512 * 1024;
constexpr size_t WS_WO = WS_WIN + 3 * MiB;
constexpr size_t WS_WQ = WS_WO + 2 * MiB;
constexpr size_t WS_WKV = WS_WQ + 512 * 1024;
constexpr size_t WS_WS = WS_WKV + 256 * 1024;
constexpr size_t WS_WRT = WS_WS + 256 * 1024;
constexpr size_t WS_CS = WS_WRT + 256 * 1024;
constexpr size_t WS_PB = WS_CS + 2 * MiB;
constexpr size_t WS_CNT = WS_PB + 8 * MiB;
constexpr size_t WS_LIST = WS_CNT + 8192;
constexpr size_t WS_GATEW = WS_LIST + 2 * MiB;
constexpr size_t WS_ASGEP = WS_GATEW + 128 * 1024;
constexpr size_t WS_LATSS = WS_ASGEP + 128 * 1024;
constexpr size_t WS_ASS = WS_LATSS + 512 * 1024;
constexpr size_t WS_GSS = WS_ASS + 512 * 1024;
constexpr size_t WS_BAR = 247 * MiB;
constexpr size_t WS_ROWSC = WS_BAR + 64 * 1024;
constexpr size_t WS_PART = WS_ROWSC + 128 * 1024;
constexpr size_t WS_RA = 119 * MiB;
constexpr size_t WS_RB = 151 * MiB;
constexpr size_t WS_RC = 183 * MiB;
constexpr size_t WS_WKV2 = 248 * MiB;
constexpr size_t WS_GCNT = 248 * MiB + 512 * 1024;
constexpr size_t WS_END = 249 * MiB;
static_assert(WS_GSS + 512 * 1024 <= 119 * MiB && WS_PART + 512 * 1024 <= WS_END, "ws overlap");

struct Params {
    const float* x; const float* p; const int* pos;
    const float* w_in; const float* q_norm_g; const float* w_q_up; const float* kv_norm_g; const float* w_kv_up;
    const float* gm_ln_g; const float* gm_ln_b; const float* gm_w_s; const float* gm_b_s;
    const float* mla_out_g; const float* gm_out_g; const float* w_o; const float* ln1_g; const float* ln1_b;
    const float* w_rg; const float* b_rg; const float* w_re; const float* b_re;
    const float* w_gate; const float* w_up; const float* w_down; const float* ln2_g; const float* ln2_b;
    const float* w_pg; const float* b_pg; const float* w_pp; const float* ln3_g; const float* ln3_b;
    float* out; unsigned char* ws;
    float inv_freq[16];
    int use_cg_sync; int pad_;
};

typedef __bf16 bf16x2_t __attribute__((ext_vector_type(2)));
typedef float f32x2_t __attribute__((ext_vector_type(2)));
DEVINL unsigned pack2(float lo, float hi) { const f32x2_t v = {lo, hi}; return __builtin_bit_cast(unsigned, __builtin_convertvector(v, bf16x2_t)); }
DEVINL uint2 pack4(float a, float b, float c, float d) { return make_uint2(pack2(a, b), pack2(c, d)); }
DEVINL uint2 pack4v(f32x4 v) { return make_uint2(pack2(v[0], v[1]), pack2(v[2], v[3])); }
DEVINL float bf2f(unsigned short b) { return __uint_as_float(((unsigned)b) << 16); }
DEVINL float bflo(unsigned u) { return __uint_as_float(u << 16); }
DEVINL float bfhi(unsigned u) { return __uint_as_float(u & 0xffff0000u); }
DEVINL float wave_sum(float v) {
#pragma unroll
    for (int o = 32; o >= 1; o >>= 1) v += __shfl_xor(v, o);
    return v;
}
DEVINL float fast_sigmoid(float x) { return __builtin_amdgcn_rcpf(1.f + __builtin_amdgcn_exp2f(-1.4426950408889634f * x)); }
DEVINL float gelu_tanh(float x) {
    const float z2 = 1.5957691216057308f * (x + 0.044715f * x * x * x);
    return x * fast_sigmoid(z2);
}

template <int MI, int NI, bool TRANS>
DEVINL void mma_ktile(f32x4 (&acc)[MI][NI], const bf16_t* sA, const bf16_t* sB, int lane) {
    const int r16 = lane & 15, kg = (lane >> 4) * 8;
#pragma unroll
    for (int ks = 0; ks < 2; ++ks) {
        bf16x8 a[MI], b[NI];
#pragma unroll
        for (int mi = 0; mi < MI; ++mi) a[mi] = *(const bf16x8*)(sA + (mi * 16 + r16) * LDK + ks * 32 + kg);
#pragma unroll
        for (int ni = 0; ni < NI; ++ni) b[ni] = *(const bf16x8*)(sB + (ni * 16 + r16) * LDK + ks * 32 + kg);
#pragma unroll
        for (int mi = 0; mi < MI; ++mi)
#pragma unroll
            for (int ni = 0; ni < NI; ++ni) {
                if (TRANS) acc[mi][ni] = __builtin_amdgcn_mfma_f32_16x16x32_bf16(a[mi], b[ni], acc[mi][ni], 0, 0, 0);
                else acc[mi][ni] = __builtin_amdgcn_mfma_f32_16x16x32_bf16(b[ni], a[mi], acc[mi][ni], 0, 0, 0);
            }
    }
}

template <bool TRANS, int NI, class ARowF>
DEVINL void gemm_core(f32x4 (&acc)[4][NI], ARowF arow, const bf16_t* __restrict__ Bt, int ldb, int K, bf16_t* smem) {
    bf16_t* sA = smem; bf16_t* sB = smem + 256 * LDK;
    const int t = threadIdx.x, lane = t & 63, w = t >> 6, wr = w >> 1, wc = w & 1;
    const int lrow = t >> 3, lkc = (t & 7) * 8;
    const bf16_t* ap[4]; const bf16_t* bp[2];
#pragma unroll
    for (int i = 0; i < 4; ++i) ap[i] = arow(lrow + 64 * i) + lkc;
    bp[0] = Bt + (size_t)lrow * ldb + lkc;
    bp[1] = Bt + (size_t)(lrow + (NI == 4 ? 64 : 0)) * ldb + lkc;
    u32x4 ra0, ra1, ra2, ra3, rb0, rb1;
    ra0 = *(const u32x4*)(ap[0]); ra1 = *(const u32x4*)(ap[1]); ra2 = *(const u32x4*)(ap[2]); ra3 = *(const u32x4*)(ap[3]);
    rb0 = *(const u32x4*)(bp[0]);
    if (NI == 4) rb1 = *(const u32x4*)(bp[1]);
#pragma nounroll
    for (int k0 = 0; k0 < K; k0 += 64) {
        __syncthreads();
        *(u32x4*)(sA + (lrow + 0) * LDK + lkc) = ra0; *(u32x4*)(sA + (lrow + 64) * LDK + lkc) = ra1;
        *(u32x4*)(sA + (lrow + 128) * LDK + lkc) = ra2; *(u32x4*)(sA + (lrow + 192) * LDK + lkc) = ra3;
        *(u32x4*)(sB + (lrow + 0) * LDK + lkc) = rb0;
        if (NI == 4) *(u32x4*)(sB + (lrow + 64) * LDK + lkc) = rb1;
        __syncthreads();
        if (k0 + 64 < K) {
            const int kn = k0 + 64;
            ra0 = *(const u32x4*)(ap[0] + kn); ra1 = *(const u32x4*)(ap[1] + kn); ra2 = *(const u32x4*)(ap[2] + kn); ra3 = *(const u32x4*)(ap[3] + kn);
            rb0 = *(const u32x4*)(bp[0] + kn);
            if (NI == 4) rb1 = *(const u32x4*)(bp[1] + kn);
        }
        mma_ktile<4, NI, TRANS>(acc, sA + wr * 64 * LDK, sB + wc * 16 * NI * LDK, lane);
    }
}

template <int NI>
DEVINL void zero_acc(f32x4 (&acc)[4][NI]) {
#pragma unroll
    for (int i = 0; i < 4; ++i)
#pragma unroll
        for (int j = 0; j < NI; ++j) acc[i][j] = (f32x4){0.f, 0.f, 0.f, 0.f};
}

struct WS {
    bf16_t *wgu, *wd, *wpg, *wpp, *win, *wo, *wq, *wkv, *wsb, *pb;
    float2* rowsc; float2* part; float* wrt; float2* cs; int* cnt; int* list; float* gatew; int* asgep; float *lat_ss, *a_ss, *g_ss;
    bf16_t *xb, *q, *x1b; bf16_t *u, *vln, *ao, *H, *x2b; bf16_t *latq, *latkv, *wkv2, *kr, *k, *vT, *go, *ymoe;
};
DEVINL WS make_ws(unsigned char* ws, float* out = nullptr) {
    WS s;
    s.vln = (bf16_t*)out;
    s.q = (bf16_t*)((unsigned char*)out + 16 * MiB);
    s.wgu = (bf16_t*)(ws + WS_WGU); s.wd = (bf16_t*)(ws + WS_WD); s.wpg = (bf16_t*)(ws + WS_WPG); s.wpp = (bf16_t*)(ws + WS_WPP);
    s.win = (bf16_t*)(ws + WS_WIN); s.wo = (bf16_t*)(ws + WS_WO); s.wq = (bf16_t*)(ws + WS_WQ); s.wkv = (bf16_t*)(ws + WS_WKV);
    s.wsb = (bf16_t*)(ws + WS_WS); s.wrt = (float*)(ws + WS_WRT); s.cs = (float2*)(ws + WS_CS); s.pb = (bf16_t*)(ws + WS_PB);
    s.rowsc = (float2*)(ws + WS_ROWSC); s.part = (float2*)(ws + WS_PART); s.cnt = (int*)(ws + WS_CNT); s.list = (int*)(ws + WS_LIST); s.gatew = (float*)(ws + WS_GATEW); s.asgep = (int*)(ws + WS_ASGEP);
    s.lat_ss = (float*)(ws + WS_LATSS); s.a_ss = (float*)(ws + WS_ASS); s.g_ss = (float*)(ws + WS_GSS);
    s.xb = (bf16_t*)(ws + WS_RA); s.x1b = s.xb;
    s.ao = (bf16_t*)(ws + WS_RB); s.u = s.ao + 512; s.go = s.u; s.H = s.ao; s.x2b = s.ao;
    s.latq = (bf16_t*)(ws + WS_RC); s.latkv = (bf16_t*)(ws + WS_RC + 8 * MiB); s.kr = (bf16_t*)(ws + WS_RC + 16 * MiB); s.k = (bf16_t*)(ws + WS_RC + 17 * MiB); s.wkv2 = (bf16_t*)(ws + WS_WKV2);
    s.vT = (bf16_t*)(ws + WS_RC + 33 * MiB); s.ymoe = s.latq;
    return s;
}

#define XB_TMO      128
#define XB_XCNT(j)  (256  + 64 * (j))
#define XB_XSUB(j)  (1280 + 64 * (j))
#define XB_XGEN(j)  (2304 + 64 * (j))
#define XB_TOP      3328
#define XB_TOPGEN   3392
#define XCD_BAR_WORDS 3456
#define XB_SPIN_CAP (1u << 24)
#ifndef LAS
#define LAS __attribute__((address_space(3)))
#endif
DEVINL unsigned xb_ld(unsigned* p) { return __hip_atomic_load(p, __ATOMIC_RELAXED, __HIP_MEMORY_SCOPE_AGENT); }
DEVINL unsigned xb_add(unsigned* p, unsigned v) { return __hip_atomic_fetch_add(p, v, __ATOMIC_RELAXED, __HIP_MEMORY_SCOPE_AGENT); }
DEVINL unsigned xb_xcc_id() { return (unsigned)__builtin_amdgcn_s_getreg((3 << 11) | 20) & 0xFu; }
#define XB_SPIN(cond, bar) do { unsigned _sp = 0; while (cond) { __builtin_amdgcn_s_sleep(1); \
    if ((++_sp & 255u) == 0u) { if (xb_ld(&(bar)[XB_TMO])) break; if (_sp > XB_SPIN_CAP) { atomicAdd(&(bar)[XB_TMO], 1u); break; } } } } while (0)
struct XcdBarrier { unsigned* bar; unsigned x; volatile LAS unsigned* st; };
DEVINL XcdBarrier xcd_barrier_post(unsigned* bar, volatile LAS unsigned* st) {
    XcdBarrier b; b.bar = bar; b.x = xb_xcc_id(); b.st = st;
    if (threadIdx.x == 0) (void)xb_add(&bar[XB_XCNT(b.x)], 1u);
    return b;
}
DEVINL void xcd_barrier_complete(unsigned* bar, unsigned x, unsigned& nloc, unsigned& nx) {
    const unsigned G = gridDim.x * gridDim.y * gridDim.z;
    unsigned sum, cnt, mine, sp = 0u;
    for (;;) {
        sum = 0u; cnt = 0u; mine = 0u;
#pragma unroll
        for (unsigned j = 0; j < 16; ++j) { const unsigned c = xb_ld(&bar[XB_XCNT(j)]); sum += c; cnt += (c > 0u) ? 1u : 0u; mine = (j == x) ? c : mine; }
        if (sum == G) break;
        __builtin_amdgcn_s_sleep(1);
        if ((++sp & 255u) == 0u) { if (xb_ld(&bar[XB_TMO])) break; if (sp > XB_SPIN_CAP) { atomicAdd(&bar[XB_TMO], 1u); break; } }
    }
    nloc = mine > 0u ? mine : 1u; nx = cnt > 0u ? cnt : 1u;
}
template <bool FIRST = false>
DEVINL void xcd_barrier(const XcdBarrier& b) {
    asm volatile("s_waitcnt vmcnt(0)" ::: "memory");
    __syncthreads();
    if (threadIdx.x == 0) {
        unsigned* bar = b.bar;
        const unsigned bx = xb_xcc_id();
        __builtin_amdgcn_s_waitcnt(0);
        unsigned nloc = b.st[0], nx = b.st[1];
        if (FIRST) { xcd_barrier_complete(bar, bx, nloc, nx); b.st[0] = nloc; b.st[1] = nx; }
        const unsigned old = xb_add(&bar[XB_XSUB(bx)], 1u);
        const unsigned gen = old / nloc;
        if (old + 1u == (gen + 1u) * nloc) {
            __builtin_amdgcn_fence(__ATOMIC_RELEASE, "agent");
            asm volatile("s_waitcnt vmcnt(0)" ::: "memory");
            const unsigned og = xb_add(&bar[XB_TOP], 1u);
            const unsigned tg = og / nx;
            if (og + 1u == (tg + 1u) * nx) xb_add(&bar[XB_TOPGEN], 1u);
            else XB_SPIN(xb_ld(&bar[XB_TOPGEN]) == tg, bar);
            __builtin_amdgcn_fence(__ATOMIC_ACQUIRE, "agent");
            xb_add(&bar[XB_XGEN(bx)], 1u);
            asm volatile("s_waitcnt vmcnt(0)" ::: "memory");
        } else {
            XB_SPIN(xb_ld(&bar[XB_XGEN(bx)]) == gen, bar);
            __builtin_amdgcn_fence(__ATOMIC_ACQUIRE, "agent");
            asm volatile("s_waitcnt vmcnt(0)" ::: "memory");
        }
    }
    __syncthreads();
}

DEVINL void st_wt8(void* p, uint2 v) { __hip_atomic_store((unsigned long long*)p, ((unsigned long long)v.y << 32) | v.x, __ATOMIC_RELAXED, __HIP_MEMORY_SCOPE_AGENT); }
DEVINL void group_sync(unsigned* cnt, unsigned target) {
    asm volatile("s_waitcnt vmcnt(0)" ::: "memory");
    __syncthreads();
    if (threadIdx.x == 0) {
        xb_add(cnt, 1u);
        unsigned sp = 0;
        while (xb_ld(cnt) < target) { __builtin_amdgcn_s_sleep(1); if (++sp > XB_SPIN_CAP) break; }
        __builtin_amdgcn_fence(__ATOMIC_ACQUIRE, "agent");
        asm volatile("s_waitcnt vmcnt(0)" ::: "memory");
    }
    __syncthreads();
}

#define LAS __attribute__((address_space(3)))
#ifndef E_SPLIT_V
#define E_SPLIT_V 12
#endif
#ifndef EPI2
#define EPI2 0
#endif
#ifndef P0_REP
#define P0_REP 1
#endif
#ifndef REP_P1
#define REP_P1 1
#endif
#ifndef REP_P4
#define REP_P4 1
#endif
#ifndef REP_P6
#define REP_P6 1
#endif
#ifndef REP_P7
#define REP_P7 1
#endif
#ifndef REP_P9
#define REP_P9 1
#endif
namespace pg8 {
constexpr int BK = 64, HALF = 128, HTB = HALF * BK * 2, STAGE_BYTES = 8 * HTB;
DEVINL int lds_byte(int r, int c) { const int st = (r >> 4) * 2 + (c >> 5), rr = r & 15, cc = c & 31, ob = rr * 64 + cc * 2; return st * 1024 + (ob ^ (((ob >> 9) & 1) << 5)); }
DEVINL void stage_rc(int b, int& R, int& C) { const int st = b / 1024, sb = b % 1024, swz = sb ^ (((sb >> 9) & 1) << 5); R = (st >> 1) * 16 + swz / 64; C = (st & 1) * 32 + (swz % 64) / 2; }
struct Unit { const char* A; const char* B; int a0, a1, a2, a3; };
template <int MIDT, bool FUSED, int EPIREP = 1, class Epi, class Sched>
DEVINL void gemm_phase(LAS unsigned char* lds, const Sched& S, const Epi& E, const int K, const int ldb) {
    int tid_ = threadIdx.x; asm volatile("" : "+v"(tid_));
    const int tid = tid_, wid = __builtin_amdgcn_readfirstlane(tid >> 6), lane = tid & 63, wr = wid >> 2, wc = wid & 3, fr = lane & 15, fq = lane >> 4;
    const int nt = K / BK;
    int RA[2], CA[2]; unsigned voffB[2];
#pragma unroll
    for (int i = 0; i < 2; ++i) { stage_rc(tid * 16 + i * 8192, RA[i], CA[i]); voffB[i] = (unsigned)(RA[i] * ldb + CA[i]) * 2u; }
    const size_t kstep = (size_t)(BK * 2);
    const size_t hstepB = (size_t)HALF * ldb * 2;
    const unsigned ldsw = (unsigned)wid * 1024u;
    const int aoff = lds_byte(wr * 64 + fr, fq * 8), boff = lds_byte(wc * 32 + fr, fq * 8);
#define PG8_SA(b, h) (((b) * 2 + (h)) * HTB)
#define PG8_SB(b, h) ((4 + (b) * 2 + (h)) * HTB)
#define PG8_STG(bufoff, gbase, v0, v1) do { \
        __builtin_amdgcn_global_load_lds((const unsigned*)((const char*)(gbase) + (v0)), (LAS unsigned*)(lds + (bufoff) + ldsw), 16, 0, 0); \
        __builtin_amdgcn_global_load_lds((const unsigned*)((const char*)(gbase) + (v1)), (LAS unsigned*)(lds + (bufoff) + ldsw + 8192), 16, 0, 0); } while (0)
#define PG8_STGB(bufoff, gbase) PG8_STG(bufoff, gbase, voffB[0], voffB[1])
#define PG8_LDA(dst, b, h) do { _Pragma("unroll") for (int m = 0; m < 4; ++m) _Pragma("unroll") for (int k = 0; k < 2; ++k) dst[m][k] = *(const LAS bf16x8*)(lds + PG8_SA(b, h) + aoff + m * 2048 + k * 1024); } while (0)
#define PG8_LDB(dst, b, h) do { _Pragma("unroll") for (int n = 0; n < 2; ++n) _Pragma("unroll") for (int k = 0; k < 2; ++k) dst[n][k] = *(const LAS bf16x8*)(lds + PG8_SB(b, h) + boff + n * 2048 + k * 1024); } while (0)
#define PG8_MMA(ai, bj, At, Bt) do { __builtin_amdgcn_s_setprio(1); _Pragma("unroll") for (int m = 0; m < 4; ++m) _Pragma("unroll") for (int n = 0; n < 2; ++n) _Pragma("unroll") for (int k = 0; k < 2; ++k) \
        acc[ai][bj][m][n] = __builtin_amdgcn_mfma_f32_16x16x32_bf16(Bt[n][k], At[m][k], acc[ai][bj][m][n], 0, 0, 0); __builtin_amdgcn_s_setprio(0); } while (0)
#define PG8_WAIT_V(n) asm volatile("s_waitcnt vmcnt(" #n ")" ::: "memory")
#define PG8_WAIT_L(n) asm volatile("s_waitcnt lgkmcnt(" #n ")" ::: "memory")
#define PG8_BAR __builtin_amdgcn_s_barrier()
#define PG8_SCHED __builtin_amdgcn_sched_barrier(0)
    Unit cur, nxt; int ui = 0;
    if (!S.next(0, cur)) return;
    f32x4 acc[2][2][4][2];
#pragma unroll
    for (int a = 0; a < 2; ++a)
#pragma unroll
        for (int b = 0; b < 2; ++b)
#pragma unroll
            for (int m = 0; m < 4; ++m)
#pragma unroll
                for (int n = 0; n < 2; ++n) acc[a][b][m][n] = (f32x4){0.f, 0.f, 0.f, 0.f};
    bf16x8 At[4][2], B0[2][2], B1[2][2];
    unsigned vc00, vc01, vc10, vc11, vn00, vn01, vn10, vn11;
    vc00 = S.arow(cur, RA[0]) + CA[0] * 2; vc01 = S.arow(cur, RA[1]) + CA[1] * 2;
    vc10 = S.arow(cur, 128 + RA[0]) + CA[0] * 2; vc11 = S.arow(cur, 128 + RA[1]) + CA[1] * 2;
    const char* cA = cur.A; const char* cB = cur.B;
    PG8_STGB(PG8_SB(0, 0), cB); PG8_STG(PG8_SA(0, 0), cA, vc00, vc01); PG8_STGB(PG8_SB(0, 1), cB + hstepB); PG8_STG(PG8_SA(0, 1), cA, vc10, vc11);
    if (wr == 1) PG8_BAR;
    PG8_WAIT_V(4); PG8_BAR;
    PG8_STGB(PG8_SB(1, 0), cB + kstep); PG8_STG(PG8_SA(1, 0), cA + kstep, vc00, vc01); PG8_STGB(PG8_SB(1, 1), cB + hstepB + kstep);
    PG8_WAIT_V(6); PG8_BAR;
    for (;;) {
        const bool has_next = S.next(ui + 1, nxt);
        const char* nA = has_next ? nxt.A : cA; const char* nB = has_next ? nxt.B : cB;
        if (has_next) {
            vn00 = S.arow(nxt, RA[0]) + CA[0] * 2; vn01 = S.arow(nxt, RA[1]) + CA[1] * 2;
            vn10 = S.arow(nxt, 128 + RA[0]) + CA[0] * 2; vn11 = S.arow(nxt, 128 + RA[1]) + CA[1] * 2;
        } else { vn00 = vc00; vn01 = vc01; vn10 = vc10; vn11 = vc11; }
#pragma nounroll
        for (int t = 0; t < nt; t += 2) {
            const bool last = (t == nt - 2);
            if (MIDT > 0 && t == MIDT) E.mid(acc, cur, wr, wc, fr, fq);
            const char* a1 = cA + (size_t)(t + 1) * kstep;
            const char* a2 = last ? nA : cA + (size_t)(t + 2) * kstep; const char* b2 = last ? nB : cB + (size_t)(t + 2) * kstep;
            const char* a3 = a2 + kstep; const char* b3 = b2 + kstep;
            const unsigned w00 = last ? vn00 : vc00, w01 = last ? vn01 : vc01, w10 = last ? vn10 : vc10, w11 = last ? vn11 : vc11;
            PG8_LDB(B0, 0, 0); PG8_SCHED; PG8_LDA(At, 0, 0); PG8_STG(PG8_SA(1, 1), a1, vc10, vc11);
            PG8_WAIT_L(8); PG8_BAR; PG8_WAIT_L(0); PG8_MMA(0, 0, At, B0); PG8_BAR; PG8_SCHED;
            PG8_LDB(B1, 0, 1); PG8_STGB(PG8_SB(0, 0), b2);
            PG8_BAR; PG8_WAIT_L(0); PG8_MMA(0, 1, At, B1); PG8_BAR;
            PG8_LDA(At, 0, 1); PG8_STG(PG8_SA(0, 0), a2, w00, w01);
            PG8_BAR; PG8_WAIT_L(0); PG8_MMA(1, 0, At, B0); PG8_BAR; PG8_SCHED;
            PG8_STGB(PG8_SB(0, 1), b2 + hstepB);
            PG8_WAIT_V(6); PG8_BAR; PG8_MMA(1, 1, At, B1); PG8_BAR;
            PG8_LDB(B0, 1, 0); PG8_SCHED; PG8_LDA(At, 1, 0); PG8_STG(PG8_SA(0, 1), a2, w10, w11);
            PG8_WAIT_L(8); PG8_BAR; PG8_WAIT_L(0); PG8_MMA(0, 0, At, B0); PG8_BAR; PG8_SCHED;
            PG8_LDB(B1, 1, 1); PG8_STGB(PG8_SB(1, 0), b3);
            PG8_BAR; PG8_WAIT_L(0); PG8_MMA(0, 1, At, B1); PG8_BAR;
            PG8_LDA(At, 1, 1); PG8_STG(PG8_SA(1, 0), a3, w00, w01);
            PG8_BAR; PG8_WAIT_L(0); PG8_MMA(1, 0, At, B0); PG8_BAR; PG8_SCHED;
            PG8_STGB(PG8_SB(1, 1), b3 + hstepB);
            PG8_WAIT_V(6); PG8_BAR; PG8_MMA(1, 1, At, B1); PG8_BAR;
        }
        if (!FUSED) { E(acc, cur, wr, wc, fr, fq); if (EPIREP > 1) { asm volatile("s_waitcnt vmcnt(0)" ::: "memory"); E(acc, cur, wr, wc, fr, fq); } }
        if (!has_next) break;
#pragma unroll
        for (int a = 0; a < 2; ++a)
#pragma unroll
            for (int b = 0; b < 2; ++b)
#pragma unroll
                for (int m = 0; m < 4; ++m)
#pragma unroll
                    for (int n = 0; n < 2; ++n) acc[a][b][m][n] = (f32x4){0.f, 0.f, 0.f, 0.f};
        cur = nxt; cA = nA; cB = nB; ++ui;
        vc00 = vn00; vc01 = vn01; vc10 = vn10; vc11 = vn11;
    }
    PG8_WAIT_V(0);
    if (wr == 0) PG8_BAR;
    PG8_BAR;
    if constexpr (FUSED) E.final(acc, cur, wr, wc, fr, fq, lds);
#undef PG8_SA
#undef PG8_SB
#undef PG8_STG
#undef PG8_STGB
#undef PG8_LDA
#undef PG8_LDB
#undef PG8_MMA
#undef PG8_WAIT_V
#undef PG8_WAIT_L
#undef PG8_BAR
#undef PG8_SCHED
}
struct DenseOrder {
    const char* A; const char* B; int lda, ldb, nM, nN, G, c, rep;
    DEVINL bool next(int i, Unit& u) const {
        const int nwg = nM * nN; const long L = (long)i * G + c; if (L >= (long)nwg * rep) return false;
        int wgid = (int)(L % nwg); { const int q = nwg / 8, r = nwg % 8, xcd = wgid % 8, off = wgid / 8; wgid = (xcd < r ? xcd * (q + 1) : r * (q + 1) + (xcd - r) * q) + off; }
        const int nig = 8 * nN, gid = wgid / nig, fm = gid * 8, gsz = (nM - fm) < 8 ? (nM - fm) : 8;
        const int pm = fm + ((wgid % nig) % gsz), pn = (wgid % nig) / gsz;
        u.A = A + (size_t)pm * 256 * lda * 2; u.B = B + (size_t)pn * 256 * ldb * 2; u.a0 = pm; u.a1 = pn; u.a2 = 0; u.a3 = 0; return true;
    }
    DEVINL unsigned arow(const Unit&, int r) const { return (unsigned)(r * lda) * 2u; }
};
}

DEVINL int drow_map(int mode, int n) {
    switch (mode) {
        case 1: {
            if (n < 256) return n;
            if (n < 384) return 256 + (n - 256);
            if (n < 416) return 384 + (n - 384);
            if (n < 928) return 512 + (n - 416);
            const int c = n - 928, gq = c >> 6, ch = c & 63;
            return 1024 + (gq >> 2) * 256 + 128 * (ch >> 5) + 32 * (gq & 3) + (ch & 31);
        }
        case 2: { const int h = n / 96, d = n - h * 96; return d < 64 ? h * 64 + d : 512 + h * 32 + (d - 64); }
        case 5: { const int h = n >> 7, d = n & 127; return d < 64 ? h * 64 + d : 512 + h * 64 + (d - 64); }
        case 3: return (n >> 4) * 32 + (n & 15);
        case 4: return (n >> 4) * 32 + 16 + (n & 15);
        default: return n;
    }
}
DEVINL void tr_tile(const float* __restrict__ src, int ld_s, int k0, int n0, int Nlim, bf16_t* __restrict__ dst, int ld_d,
                    const float* __restrict__ gain, int mode, float* smf) {
    int t = threadIdx.x; asm volatile("" : "+v"(t));
    __syncthreads();
#pragma unroll
    for (int i = 0; i < 2; ++i) {
        const int c = t + NTHR * i, r = c >> 4, c4 = (c & 15) * 4, n = n0 + c4;
        float4 v = make_float4(0.f, 0.f, 0.f, 0.f);
        if (n < Nlim) { const f32x4 t4 = __builtin_nontemporal_load((const f32x4*)(src + (size_t)(k0 + r) * ld_s + n)); v = make_float4(t4[0], t4[1], t4[2], t4[3]); }
        const float g = gain ? gain[k0 + r] : 1.f;
        smf[r * 65 + c4 + 0] = v.x * g; smf[r * 65 + c4 + 1] = v.y * g; smf[r * 65 + c4 + 2] = v.z * g; smf[r * 65 + c4 + 3] = v.w * g;
    }
    __syncthreads();
    {
        const int c = t, nn = c >> 3, kc = (c & 7) * 8, n = n0 + nn;
        if (n < Nlim) {
            float e[8];
#pragma unroll
            for (int j = 0; j < 8; ++j) e[j] = smf[(kc + j) * 65 + nn];
            uint4 o; o.x = pack2(e[0], e[1]); o.y = pack2(e[2], e[3]); o.z = pack2(e[4], e[5]); o.w = pack2(e[6], e[7]);
            *(uint4*)(dst + (size_t)drow_map(mode, n) * ld_d + k0 + kc) = o;
        }
    }
}

DEVINL void cvt8(const float* __restrict__ s, bf16_t* __restrict__ d) {
    const f32x4 a4 = __builtin_nontemporal_load((const f32x4*)s), b4 = __builtin_nontemporal_load((const f32x4*)(s + 4));
    const float4 a = make_float4(a4[0], a4[1], a4[2], a4[3]), b = make_float4(b4[0], b4[1], b4[2], b4[3]);
    uint4 o; o.x = pack2(a.x, a.y); o.y = pack2(a.z, a.w); o.z = pack2(b.x, b.y); o.w = pack2(b.z, b.w);
    *(uint4*)d = o;
}

constexpr int E_SPLIT = E_SPLIT_V;
DEVINL void conv_gateup_tile(const Params& p, const WS& s, int v, float* smf) {
    const int e = v >> 8, r = v & 255, up = r >> 7, q = r & 127, kt = q >> 3, nt = q & 7;
    tr_tile((up ? p.w_up : p.w_gate) + (size_t)e * 1024 * 512, 512, kt * 64, nt * 64, 512, s.wgu + (size_t)e * 1024 * 1024, 1024, nullptr, up ? 4 : 3, smf);
}
DEVINL void conv_down_tile(const Params& p, const WS& s, int v, float* smf) {
    const int e = v >> 7, r = v & 127, kt = r >> 4, nt = r & 15;
    tr_tile(p.w_down + (size_t)e * 512 * 1024, 1024, kt * 64, nt * 64, 1024, s.wd + (size_t)e * 1024 * 512, 512, nullptr, 0, smf);
}
DEVINL void conv_expert_tiles(const Params& p, const WS& s, int kind, int first, int last, int stride, float* smf) {
    if (first >= last) return;
    int t = threadIdx.x; asm volatile("" : "+v"(t));
    const int lr = t >> 4, lc4 = (t & 15) * 4;
    const int nn = t >> 3, kc = (t & 7) * 8;
    float4 r0, r1; const float* src; int ld_s; bf16_t* dst; int ld_d, mode, k0, n0;
#define CET_DECODE(v) do { if (kind == 0) { const int e_ = (v) >> 8, r_ = (v) & 255, up_ = r_ >> 7, q_ = r_ & 127; k0 = (q_ >> 3) * 64; n0 = (q_ & 7) * 64; \
            src = (up_ ? p.w_up : p.w_gate) + (size_t)e_ * 1024 * 512; ld_s = 512; dst = s.wgu + (size_t)e_ * 1024 * 1024; ld_d = 1024; mode = up_ ? 4 : 3; } \
        else { const int e_ = (v) >> 7, r_ = (v) & 127; k0 = (r_ >> 4) * 64; n0 = (r_ & 15) * 64; src = p.w_down + (size_t)e_ * 512 * 1024; ld_s = 1024; dst = s.wd + (size_t)e_ * 1024 * 512; ld_d = 512; mode = 0; } } while (0)
#define CET_LOAD() do { const f32x4 t0_ = __builtin_nontemporal_load((const f32x4*)(src + (size_t)(k0 + lr) * ld_s + n0 + lc4)), t1_ = __builtin_nontemporal_load((const f32x4*)(src + (size_t)(k0 + lr + 32) * ld_s + n0 + lc4)); \
        r0 = make_float4(t0_[0], t0_[1], t0_[2], t0_[3]); r1 = make_float4(t1_[0], t1_[1], t1_[2], t1_[3]); } while (0)
    CET_DECODE(first); CET_LOAD();
    __syncthreads();
    int buf = 0;
    for (int v = first; v < last; v += stride) {
        float* sm = smf + buf * (64 * 65);
        sm[lr * 65 + lc4 + 0] = r0.x; sm[lr * 65 + lc4 + 1] = r0.y; sm[lr * 65 + lc4 + 2] = r0.z; sm[lr * 65 + lc4 + 3] = r0.w;
        sm[(lr + 32) * 65 + lc4 + 0] = r1.x; sm[(lr + 32) * 65 + lc4 + 1] = r1.y; sm[(lr + 32) * 65 + lc4 + 2] = r1.z; sm[(lr + 32) * 65 + lc4 + 3] = r1.w;
        bf16_t* dcur = dst; const int ldc = ld_d, mcur = mode, kcur = k0, ncur = n0;
        if (v + stride < last) { CET_DECODE(v + stride); CET_LOAD(); }
        __syncthreads();
        float e[8];
#pragma unroll
        for (int j = 0; j < 8; ++j) e[j] = sm[(kc + j) * 65 + nn];
        uint4 o; o.x = pack2(e[0], e[1]); o.y = pack2(e[2], e[3]); o.z = pack2(e[4], e[5]); o.w = pack2(e[6], e[7]);
        __builtin_nontemporal_store((u32x4){o.x, o.y, o.z, o.w}, (u32x4*)(dcur + (size_t)drow_map(mcur, ncur + nn) * ldc + kcur + kc));
        buf ^= 1;
    }
    __syncthreads();
#undef CET_DECODE
#undef CET_LOAD
}
DEVINL void helper_slot(int U, int G, int c, int& j, int& nh) {
    const int R = (U + G - 1) / G, nidle = R * G - U;
    if (nidle >= 64) { nh = nidle; j = c - (G - nidle); } else { nh = G; j = c; }
}
__device__ void phase0(const Params& p, unsigned char* smem) {
    const WS s = make_ws(p.ws, p.out);
    const int G = gridDim.x, bid = blockIdx.x, t = threadIdx.x;
    const size_t gtid = (size_t)bid * NTHR + t, gstride = (size_t)G * NTHR;
    for (size_t i0 = gtid; i0 < (size_t)T_ * D_ / 8 * P0_REP; i0 += gstride) { const size_t i = i0 % ((size_t)T_ * D_ / 8); cvt8(p.x + i * 8, s.xb + i * 8); }
    for (size_t i = gtid; i < 8 * 128 * 128 / 8; i += gstride) {
        const int e0 = (int)i * 8, tt = (e0 >> 7) & 127, s0 = e0 & 127;
        float v[8];
#pragma unroll
        for (int j = 0; j < 8; ++j) v[j] = (s0 + j <= tt) ? p.gm_w_s[e0 + j] : 0.f;
        uint4 o; o.x = pack2(v[0], v[1]); o.y = pack2(v[2], v[3]); o.z = pack2(v[4], v[5]); o.w = pack2(v[6], v[7]);
        *(uint4*)(s.wsb + e0) = o;
    }
    for (size_t i = gtid; i < 48 * 1024; i += gstride) {
        const int n = (int)i >> 10, k = (int)i & 1023;
        s.wrt[i] = n < 4 ? p.w_rg[k * 4 + n] : (n < 36 ? p.w_re[k * 32 + (n - 4)] : 0.f);
    }
    for (size_t i = gtid; i < (size_t)T_ * 16; i += gstride) {
        const int tok = (int)(i >> 4), j = (int)i & 15;
        const float ang = (float)p.pos[tok] * p.inv_freq[j];
        float sn, cs; sincosf(ang, &sn, &cs);
        s.cs[i] = make_float2(cs, sn);
    }
    for (size_t i = gtid; i < 96 * 1024 / 8; i += gstride) *(uint4*)(s.win + 416 * 1024 + i * 8) = make_uint4(0, 0, 0, 0);
    if (bid == 0 && t < 32) s.cnt[t * 64] = 0;
    for (size_t i = gtid; i < 1024 * 16; i += gstride) *(uint4*)(s.wkv2 + (i >> 4) * 256 + 128 + (i & 15) * 8) = make_uint4(0, 0, 0, 0);
    for (size_t i = gtid; i < (size_t)T_ * 16; i += gstride) *(uint4*)(s.latkv + (i >> 4) * 256 + 128 + (i & 15) * 8) = make_uint4(0, 0, 0, 0);
    float* smf = (float*)smem;
    constexpr int J0 = 368, J1 = J0 + 48, J2 = J1 + 32, J3 = J2 + 256, J4 = J3 + 256, J5 = J4 + 64, J6 = J5;
    for (int u0 = bid; u0 < J6 * P0_REP; u0 += G) {
        const int u = u0 % J6;
        if (u < J0) { const int kt = u / 23, nt = u % 23; tr_tile(p.w_in, 1440, kt * 64, nt * 64, 1440, s.win, 1024, nullptr, 1, smf); }
        else if (u < J1) { const int v = u - J0, kt = v / 12, nt = v % 12; tr_tile(p.w_q_up, 768, kt * 64, nt * 64, 768, s.wq, 256, p.q_norm_g, 2, smf); }
        else if (u < J2) { const int v = u - J1, kt = v / 16, nt = v % 16; tr_tile(p.w_kv_up, 1024, kt * 64, nt * 64, 1024, s.wkv2, 256, p.kv_norm_g, 5, smf); }
        else if (u < J3) { const int v = u - J2, kt = v / 16, nt = v % 16; tr_tile(p.w_o, 1024, kt * 64, nt * 64, 1024, s.wo, 1024, kt < 8 ? p.mla_out_g : p.gm_out_g - 512, 0, smf); }
        else if (u < J4) { const int v = u - J3, kt = v / 16, nt = v % 16; tr_tile(p.w_pg, 1024, kt * 64, nt * 64, 1024, s.wpg, 1024, nullptr, 0, smf); }
        else if (u < J5) { const int v = u - J4, kt = v / 16, nt = v % 16; tr_tile(p.w_pp, 1024, kt * 64, nt * 64, 1024, s.wpp, 256, nullptr, 0, smf); }
    }
    conv_expert_tiles(p, s, 0, bid, E_SPLIT * 256, G, smf);
}

struct EpiP1 {
    const Params* p; WS s;
    DEVINL void mid(f32x4 (&)[2][2][4][2], const pg8::Unit&, int, int, int, int) const {}
    DEVINL void operator()(const f32x4 (&acc)[2][2][4][2], const pg8::Unit& u, int wr, int wc, int fr, int fq) const {
        const int pm = u.a0, pn = u.a1;
#pragma unroll
        for (int ai = 0; ai < 2; ++ai)
#pragma unroll
            for (int m = 0; m < 4; ++m) {
                const int row = pm * 256 + ai * 128 + wr * 64 + m * 16 + fr;
                if (pn == 0) {
                    float ss = 0.f;
#pragma unroll
                    for (int bj = 0; bj < 2; ++bj)
#pragma unroll
                        for (int n = 0; n < 2; ++n) { const f32x4 v = acc[ai][bj][m][n]; ss += v[0] * v[0] + v[1] * v[1] + v[2] * v[2] + v[3] * v[3];
                            *(uint2*)(s.latq + (size_t)row * 256 + bj * 128 + wc * 32 + n * 16 + fq * 4) = pack4v(v); }
                    ss += __shfl_xor(ss, 16); ss += __shfl_xor(ss, 32);
                    if (fq == 0) s.lat_ss[row * 8 + wc] = ss;
                } else if (pn == 1) {
                    float ss = 0.f;
#pragma unroll
                    for (int n = 0; n < 2; ++n) { const f32x4 v = acc[ai][0][m][n]; ss += v[0] * v[0] + v[1] * v[1] + v[2] * v[2] + v[3] * v[3];
                        *(uint2*)(s.latkv + (size_t)row * 256 + wc * 32 + n * 16 + fq * 4) = pack4v(v); }
                    ss += __shfl_xor(ss, 16); ss += __shfl_xor(ss, 32);
                    if (fq == 0) s.lat_ss[row * 8 + 4 + wc] = ss;
                    if (wc == 0) {
                        float o1[4], o2[4];
#pragma unroll
                        for (int r = 0; r < 4; ++r) {
                            const float2 c = s.cs[row * 16 + fq * 4 + r];
                            const float x1 = acc[ai][1][m][0][r], x2 = acc[ai][1][m][1][r];
                            o1[r] = x1 * c.x - x2 * c.y; o2[r] = x1 * c.y + x2 * c.x;
                        }
                        *(uint2*)(s.kr + (size_t)row * 32 + fq * 4) = pack4(o1[0], o1[1], o1[2], o1[3]);
                        *(uint2*)(s.kr + (size_t)row * 32 + 16 + fq * 4) = pack4(o2[0], o2[1], o2[2], o2[3]);
                    }
                } else if (pn < 4) {
#pragma unroll
                    for (int bj = 0; bj < 2; ++bj)
#pragma unroll
                        for (int n = 0; n < 2; ++n) { const f32x4 v = acc[ai][bj][m][n];
                            *(uint2*)(s.u + (size_t)row * 1024 + (pn - 2) * 256 + bj * 128 + wc * 32 + n * 16 + fq * 4) = pack4(gelu_tanh(v[0]), gelu_tanh(v[1]), gelu_tanh(v[2]), gelu_tanh(v[3])); }
                } else {
                    float gv[2][2][4]; float sum = 0.f;
#pragma unroll
                    for (int bj = 0; bj < 2; ++bj)
#pragma unroll
                        for (int n = 0; n < 2; ++n)
#pragma unroll
                            for (int r = 0; r < 4; ++r) { gv[bj][n][r] = gelu_tanh(acc[ai][bj][m][n][r]); sum += gv[bj][n][r]; }
                    sum += __shfl_xor(sum, 16); sum += __shfl_xor(sum, 32);
                    const float mean = sum * (1.f / 64.f); float sq = 0.f;
#pragma unroll
                    for (int bj = 0; bj < 2; ++bj)
#pragma unroll
                        for (int n = 0; n < 2; ++n)
#pragma unroll
                            for (int r = 0; r < 4; ++r) { const float d = gv[bj][n][r] - mean; sq += d * d; }
                    sq += __shfl_xor(sq, 16); sq += __shfl_xor(sq, 32);
                    const float rstd = rsqrtf(sq * (1.f / 64.f) + EPS_);
                    const int g = (pn - 4) * 4 + wc;
#pragma unroll
                    for (int bj = 0; bj < 2; ++bj)
#pragma unroll
                        for (int n = 0; n < 2; ++n) {
                            const int ch = g * 64 + bj * 32 + n * 16 + fq * 4;
                            const float4 gg = *(const float4*)(p->gm_ln_g + ch), bb = *(const float4*)(p->gm_ln_b + ch);
                            *(uint2*)(s.vln + (size_t)row * 512 + ch) = pack4((gv[bj][n][0] - mean) * rstd * gg.x + bb.x, (gv[bj][n][1] - mean) * rstd * gg.y + bb.y,
                                                                             (gv[bj][n][2] - mean) * rstd * gg.z + bb.z, (gv[bj][n][3] - mean) * rstd * gg.w + bb.w);
                        }
                }
            }
    }
};
__device__ void phase1(const Params& p, unsigned char* smem) {
    const WS s = make_ws(p.ws, p.out);
    pg8::DenseOrder S{(const char*)s.xb, (const char*)s.win, 1024, 1024, 64, 6, (int)gridDim.x, (int)blockIdx.x, REP_P1};
    EpiP1 E{&p, s};
    pg8::gemm_phase<0, false, (EPI2 == 1 ? 2 : 1)>((LAS unsigned char*)smem, S, E, 1024, 1024);
    int j, nh; helper_slot(64 * 6 * REP_P1, (int)gridDim.x, (int)blockIdx.x, j, nh);
    if (j >= 0) conv_expert_tiles(p, s, 0, E_SPLIT * 256 + j, 32 * 256, nh, (float*)smem);
}

constexpr float QSCALE_ = 0.10206207261596577f * 1.4426950408889634f;
struct P2Order {
    const char *latq, *latkv, *wq, *wkv2; int G, c;
    DEVINL bool next(int i, pg8::Unit& u) const {
        const int L = i * G + c; if (L >= 448) return false;
        if (L < 192) { const int pm = L / 3, pn = L - pm * 3; u.A = latq + (size_t)pm * 256 * 512; u.B = wq + (size_t)pn * 256 * 512; u.a0 = pm; u.a1 = pn; u.a2 = 0; }
        else if (L < 320) { const int v = L - 192, pm = v >> 1, pn = v & 1; u.A = latkv + (size_t)pm * 256 * 512; u.B = wkv2 + (size_t)pn * 256 * 512; u.a0 = pm; u.a1 = pn; u.a2 = 1; }
        else { const int v = L - 320, pn = v >> 1, pm = v & 1; u.A = wkv2 + (size_t)(512 + pm * 256) * 512; u.B = latkv + (size_t)pn * 256 * 512; u.a0 = pm; u.a1 = pn; u.a2 = 2; }
        u.a3 = 0; return true;
    }
    DEVINL unsigned arow(const pg8::Unit&, int r) const { return (unsigned)r * 512u; }
};
struct EpiP2 {
    WS s;
    DEVINL void mid(f32x4 (&)[2][2][4][2], const pg8::Unit&, int, int, int, int) const {}
    DEVINL void operator()(const f32x4 (&acc)[2][2][4][2], const pg8::Unit& u, int wr, int wc, int fr, int fq) const {
        if (u.a2 < 2) {
            float rstd[2][4];
#pragma unroll
            for (int ai = 0; ai < 2; ++ai)
#pragma unroll
                for (int m = 0; m < 4; ++m) {
                    const int row = u.a0 * 256 + ai * 128 + wr * 64 + m * 16 + fr;
                    const float4 ssv = *(const float4*)(s.lat_ss + row * 8 + (u.a2 ? 4 : 0));
                    rstd[ai][m] = u.a2 ? rsqrtf((ssv.x + ssv.y + ssv.z + ssv.w) * (1.f / 128.f) + EPS_)
                                       : rsqrtf((ssv.x + ssv.y + ssv.z + ssv.w) * (1.f / 256.f) + EPS_) * QSCALE_;
                }
            if (u.a2 == 1) {
#pragma unroll
                for (int ai = 0; ai < 2; ++ai)
#pragma unroll
                    for (int m = 0; m < 4; ++m) {
                        const int row = u.a0 * 256 + ai * 128 + wr * 64 + m * 16 + fr;
#pragma unroll
                        for (int bj = 0; bj < 2; ++bj)
#pragma unroll
                            for (int n = 0; n < 2; ++n) {
                                const int col = u.a1 * 256 + bj * 128 + wc * 32 + n * 16 + fq * 4;
                                *(uint2*)(s.k + ((size_t)row * 8 + (col >> 6)) * 64 + (col & 63)) = pack4v(acc[ai][bj][m][n] * rstd[ai][m]);
                            }
                    }
            } else if (u.a1 < 2) {
#pragma unroll
                for (int ai = 0; ai < 2; ++ai)
#pragma unroll
                    for (int m = 0; m < 4; ++m) {
                        const int row = u.a0 * 256 + ai * 128 + wr * 64 + m * 16 + fr;
#pragma unroll
                        for (int bj = 0; bj < 2; ++bj)
#pragma unroll
                            for (int n = 0; n < 2; ++n) {
                                const int col = u.a1 * 256 + bj * 128 + wc * 32 + n * 16 + fq * 4;
                                *(uint2*)(s.q + ((size_t)row * 8 + (col >> 6)) * 96 + (col & 63)) = pack4v(acc[ai][bj][m][n] * rstd[ai][m]);
                            }
                    }
            } else {
#pragma unroll
                for (int ai = 0; ai < 2; ++ai)
#pragma unroll
                    for (int m = 0; m < 4; ++m) {
                        const int row = u.a0 * 256 + ai * 128 + wr * 64 + m * 16 + fr;
                        const float4 c01 = *(const float4*)(s.cs + row * 16 + fq * 4), c23 = *(const float4*)(s.cs + row * 16 + fq * 4 + 2);
                        const float2 csr[4] = {make_float2(c01.x, c01.y), make_float2(c01.z, c01.w), make_float2(c23.x, c23.y), make_float2(c23.z, c23.w)};
#pragma unroll
                        for (int bj = 0; bj < 2; ++bj) {
                            const int h = bj * 4 + wc; float o1[4], o2[4];
#pragma unroll
                            for (int r = 0; r < 4; ++r) {
                                const float2 c = csr[r];
                                const float x1 = acc[ai][bj][m][0][r] * rstd[ai][m], x2 = acc[ai][bj][m][1][r] * rstd[ai][m];
                                o1[r] = x1 * c.x - x2 * c.y; o2[r] = x1 * c.y + x2 * c.x;
                            }
                            *(uint2*)(s.q + ((size_t)row * 8 + h) * 96 + 64 + fq * 4) = pack4(o1[0], o1[1], o1[2], o1[3]);
                            *(uint2*)(s.q + ((size_t)row * 8 + h) * 96 + 80 + fq * 4) = pack4(o2[0], o2[1], o2[2], o2[3]);
                        }
                    }
            }
        } else {
            f32x4 rs[2][2];
#pragma unroll
            for (int bj = 0; bj < 2; ++bj)
#pragma unroll
                for (int n = 0; n < 2; ++n) {
                    const int tok = u.a1 * 256 + bj * 128 + wc * 32 + n * 16 + fq * 4;
#pragma unroll
                    for (int j = 0; j < 4; ++j) { const float4 kv4 = *(const float4*)(s.lat_ss + (tok + j) * 8 + 4); rs[bj][n][j] = rsqrtf((kv4.x + kv4.y + kv4.z + kv4.w) * (1.f / 128.f) + EPS_); }
                }
#pragma unroll
            for (int bj = 0; bj < 2; ++bj)
#pragma unroll
                for (int n = 0; n < 2; ++n) {
                    const int tok = u.a1 * 256 + bj * 128 + wc * 32 + n * 16 + fq * 4;
                    const int b = tok >> 11, sq = tok & 2047;
#pragma unroll
                    for (int ai = 0; ai < 2; ++ai)
#pragma unroll
                        for (int m = 0; m < 4; ++m) {
                            const int ch = u.a0 * 256 + ai * 128 + wr * 64 + m * 16 + fr;
                            *(uint2*)(s.vT + ((size_t)(b * 512 + ch)) * 2048 + sq) = pack4v(acc[ai][bj][m][n] * rs[bj][n]);
                        }
                }
        }
    }
};
__device__ void gmlp_phase(const Params& p, const WS& s, bf16_t* smem) {
    constexpr int LDG = 136;
    int t = threadIdx.x; asm volatile("" : "+v"(t));
    const int lane = t & 63, w = t >> 6, r16 = lane & 15, g4 = (lane >> 4) * 4, kg = (lane >> 4) * 8;
    const int G = gridDim.x;
    int u = blockIdx.x;
    if (u >= 1024) return;
    u32x4 ra0, ra1, ra2, ra3, rb0, rb1; uint2 ru0, ru1, ru2, ru3, cu0, cu1, cu2, cu3;
#define GM_LOAD(uu) do { const int cidx_ = (uu) >> 3, g_ = (uu) & 7, tok0_ = cidx_ * 128; \
        const bf16_t* wp_ = s.wsb + ((size_t)g_ * 128 + (t >> 4)) * 128 + (t & 15) * 8; \
        ra0 = *(const u32x4*)(wp_); ra1 = *(const u32x4*)(wp_ + 32 * 128); ra2 = *(const u32x4*)(wp_ + 64 * 128); ra3 = *(const u32x4*)(wp_ + 96 * 128); \
        const bf16_t* vp_ = s.vln + (size_t)(tok0_ + 2 * lane) * 512 + g_ * 64 + w * 8; \
        rb0 = *(const u32x4*)(vp_); rb1 = *(const u32x4*)(vp_ + 512); \
        const bf16_t* up_ = s.u + (size_t)(tok0_ + w * 16 + r16) * 1024 + g_ * 64 + g4; \
        ru0 = *(const uint2*)(up_); ru1 = *(const uint2*)(up_ + 16); ru2 = *(const uint2*)(up_ + 32); ru3 = *(const uint2*)(up_ + 48); } while (0)
#define GM_STORE(buf) do { bf16_t* sA_ = smem + (buf) * (192 * LDG); bf16_t* sB_ = sA_ + 128 * LDG; \
        bf16_t* ad_ = sA_ + (t >> 4) * LDG + (t & 15) * 8; \
        *(u32x4*)(ad_) = ra0; *(u32x4*)(ad_ + 32 * LDG) = ra1; *(u32x4*)(ad_ + 64 * LDG) = ra2; *(u32x4*)(ad_ + 96 * LDG) = ra3; \
        unsigned* bd_ = (unsigned*)(sB_ + (w * 8) * LDG + 2 * lane); \
        bd_[0 * (LDG / 2)] = (rb0[0] & 0xffffu) | (rb1[0] << 16); bd_[1 * (LDG / 2)] = (rb0[0] >> 16) | (rb1[0] & 0xffff0000u); \
        bd_[2 * (LDG / 2)] = (rb0[1] & 0xffffu) | (rb1[1] << 16); bd_[3 * (LDG / 2)] = (rb0[1] >> 16) | (rb1[1] & 0xffff0000u); \
        bd_[4 * (LDG / 2)] = (rb0[2] & 0xffffu) | (rb1[2] << 16); bd_[5 * (LDG / 2)] = (rb0[2] >> 16) | (rb1[2] & 0xffff0000u); \
        bd_[6 * (LDG / 2)] = (rb0[3] & 0xffffu) | (rb1[3] << 16); bd_[7 * (LDG / 2)] = (rb0[3] >> 16) | (rb1[3] & 0xffff0000u); } while (0)
    __syncthreads();
    GM_LOAD(u);
    GM_STORE(0);
    cu0 = ru0; cu1 = ru1; cu2 = ru2; cu3 = ru3;
    __syncthreads();
    int cur = 0;
#pragma nounroll
    for (;;) {
        const int un = u + G; const bool has_next = un < 1024;
        if (has_next) GM_LOAD(un);
        const bf16_t* sA = smem + cur * (192 * LDG); const bf16_t* sB = sA + 128 * LDG;
        f32x4 acc[4];
#pragma unroll
        for (int j = 0; j < 4; ++j) acc[j] = (f32x4){0.f, 0.f, 0.f, 0.f};
#pragma unroll
        for (int ks = 0; ks < 4; ++ks) {
            const bf16x8 af = *(const bf16x8*)(sA + (w * 16 + r16) * LDG + ks * 32 + kg);
#pragma unroll
            for (int ni = 0; ni < 4; ++ni) {
                const bf16x8 bfr = *(const bf16x8*)(sB + (ni * 16 + r16) * LDG + ks * 32 + kg);
                acc[ni] = __builtin_amdgcn_mfma_f32_16x16x32_bf16(bfr, af, acc[ni], 0, 0, 0);
            }
        }
        {
            const int cidx = u >> 3, g = u & 7, tt = w * 16 + r16, tok = cidx * 128 + tt;
            const float bias = p.gm_b_s[g * 128 + tt]; float ss = 0.f;
            const uint2 uu[4] = {cu0, cu1, cu2, cu3};
#pragma unroll
            for (int ni = 0; ni < 4; ++ni) {
                const f32x4 a = acc[ni];
                const float v0 = bflo(uu[ni].x) * (a[0] + bias), v1 = bfhi(uu[ni].x) * (a[1] + bias), v2 = bflo(uu[ni].y) * (a[2] + bias), v3 = bfhi(uu[ni].y) * (a[3] + bias);
                ss += v0 * v0 + v1 * v1 + v2 * v2 + v3 * v3;
                *(uint2*)(s.go + (size_t)tok * 1024 + g * 64 + ni * 16 + g4) = pack4(v0, v1, v2, v3);
            }
            ss += __shfl_xor(ss, 16); ss += __shfl_xor(ss, 32);
            if (lane < 16) s.g_ss[tok * 8 + g] = ss;
        }
        if (!has_next) break;
        GM_STORE(cur ^ 1);
        cu0 = ru0; cu1 = ru1; cu2 = ru2; cu3 = ru3;
        __syncthreads();
        cur ^= 1; u = un;
    }
#undef GM_LOAD
#undef GM_STORE
}
__device__ void phase2(const Params& p, unsigned char* smem, bool do_gmlp = true) {
    const WS s = make_ws(p.ws, p.out);
    {
        P2Order S{(const char*)s.latq, (const char*)s.latkv, (const char*)s.wq, (const char*)s.wkv2, (int)gridDim.x, (int)blockIdx.x};
        EpiP2 E{s};
        pg8::gemm_phase<0, false>((LAS unsigned char*)smem, S, E, 256, 256);
    }
    if (do_gmlp) gmlp_phase(p, s, (bf16_t*)smem);
}

DEVINL float quad_max(float x) {
    const unsigned u = __float_as_uint(x);
    const auto r = __builtin_amdgcn_permlane16_swap(u, u, false, false);
    const float m = fmaxf(__uint_as_float(r[0]), __uint_as_float(r[1]));
    const unsigned v = __float_as_uint(m);
    const auto q = __builtin_amdgcn_permlane32_swap(v, v, false, false);
    return fmaxf(__uint_as_float(q[0]), __uint_as_float(q[1]));
}
DEVINL bf16x8 as_bf16x8(u32x4 v) { return __builtin_bit_cast(bf16x8, v); }
__device__ void attn_unit(const WS& s, int b, int h, int qb, bf16_t* smem) {
    constexpr int LK = 104, LV = 72;
    const int t = threadIdx.x, lane = t & 63, w = t >> 6, r16 = lane & 15, g = lane >> 4, kg = g * 8;
    const int q0 = qb * 256, tokb = b * 2048, qw0 = q0 + w * 32;
    bf16x8 qf[2][3];
#pragma unroll
    for (int ni = 0; ni < 2; ++ni)
#pragma unroll
        for (int ks = 0; ks < 3; ++ks)
            qf[ni][ks] = *(const bf16x8*)(s.q + ((size_t)(tokb + qw0 + ni * 16 + r16) * 8 + h) * 96 + ks * 32 + kg);
    f32x4 accO[4][2];
#pragma unroll
    for (int i = 0; i < 4; ++i)
#pragma unroll
        for (int j = 0; j < 2; ++j) accO[i][j] = (f32x4){0.f, 0.f, 0.f, 0.f};
    float mrow[2] = {-1e30f, -1e30f};
    f32x4 accL[2] = {(f32x4){0.f, 0.f, 0.f, 0.f}, (f32x4){0.f, 0.f, 0.f, 0.f}};
    const unsigned one2 = (r16 == 0) ? 0x3f803f80u : 0u;
    const bf16x8 vones = as_bf16x8((u32x4){one2, one2, one2, one2});
    const int nt = 4 * (qb + 1);
    const bf16_t* kp0; const bf16_t* kp1; int ks0, ks1, kd0, kd1;
    const bool k2 = t < 256;
    {
        int c = t, row = c / 12, part = c - row * 12;
        kp0 = part < 8 ? s.k + ((size_t)(tokb + row) * 8 + h) * 64 + part * 8 : s.kr + (size_t)(tokb + row) * 32 + (part - 8) * 8; ks0 = part < 8 ? 512 : 32; kd0 = row * LK + part * 8;
        c = k2 ? t + 512 : t; row = c / 12; part = c - row * 12;
        kp1 = part < 8 ? s.k + ((size_t)(tokb + row) * 8 + h) * 64 + part * 8 : s.kr + (size_t)(tokb + row) * 32 + (part - 8) * 8; ks1 = part < 8 ? 512 : 32; kd1 = row * LK + part * 8;
    }
    const int vrow = t >> 3, vkc = (t & 7) * 8;
    const bf16_t* vp0 = s.vT + ((size_t)((b * 8 + h) * 64 + vrow)) * 2048 + vkc;
    u32x4 rk0, rk1, rv0;
    rk0 = *(const u32x4*)kp0; rk1 = *(const u32x4*)kp1; rv0 = *(const u32x4*)vp0;
    constexpr int STG = 64 * LK + 64 * LV;
    __syncthreads();
    *(u32x4*)(smem + kd0) = rk0; if (k2) *(u32x4*)(smem + kd1) = rk1;
    *(u32x4*)(smem + 64 * LK + vrow * LV + vkc) = rv0;
    __syncthreads();
#pragma nounroll
    for (int kt = 0; kt < nt; ++kt) {
        const bf16_t* sK = smem + (kt & 1) * STG; const bf16_t* sV = sK + 64 * LK;
        if (kt + 1 < nt) {
            const int kn = (kt + 1) * 64;
            rk0 = *(const u32x4*)(kp0 + (size_t)kn * ks0); rk1 = *(const u32x4*)(kp1 + (size_t)kn * ks1);
            rv0 = *(const u32x4*)(vp0 + kn);
        }
        const int key0 = kt * 64;
        if (key0 <= qw0 + 31) {
            f32x4 sacc[4][2];
#pragma unroll
            for (int i = 0; i < 4; ++i)
#pragma unroll
                for (int j = 0; j < 2; ++j) sacc[i][j] = (f32x4){0.f, 0.f, 0.f, 0.f};
#pragma unroll
            for (int ks = 0; ks < 3; ++ks) {
                bf16x8 a[4];
#pragma unroll
                for (int mi = 0; mi < 4; ++mi) a[mi] = *(const bf16x8*)(sK + (mi * 16 + r16) * LK + ks * 32 + kg);
#pragma unroll
                for (int mi = 0; mi < 4; ++mi)
#pragma unroll
                    for (int ni = 0; ni < 2; ++ni) sacc[mi][ni] = __builtin_amdgcn_mfma_f32_16x16x32_bf16(a[mi], qf[ni][ks], sacc[mi][ni], 0, 0, 0);
            }
            if (key0 + 63 > qw0) {
#pragma unroll
                for (int mi = 0; mi < 4; ++mi)
#pragma unroll
                    for (int ni = 0; ni < 2; ++ni)
#pragma unroll
                        for (int r = 0; r < 4; ++r)
                            if (key0 + mi * 16 + g * 4 + r > qw0 + ni * 16 + r16) sacc[mi][ni][r] = -1e30f;
            }
#pragma unroll
            for (int ni = 0; ni < 2; ++ni) {
                float mx = -1e30f;
#pragma unroll
                for (int mi = 0; mi < 4; ++mi)
#pragma unroll
                    for (int r = 0; r < 4; ++r) mx = fmaxf(mx, sacc[mi][ni][r]);
                mx = quad_max(mx);
                const float mn = fmaxf(mrow[ni], mx);
                const bool grow = __any(mx > mrow[ni]);
#pragma unroll
                for (int mi = 0; mi < 4; ++mi)
#pragma unroll
                    for (int r = 0; r < 4; ++r) sacc[mi][ni][r] = __builtin_amdgcn_exp2f(sacc[mi][ni][r] - mn);
                if (grow) {
                    const float al = __builtin_amdgcn_exp2f(mrow[ni] - mn);
                    accL[ni] = accL[ni] * al;
#pragma unroll
                    for (int mo = 0; mo < 4; ++mo) accO[mo][ni] = accO[mo][ni] * al;
                }
                mrow[ni] = mn;
            }
#pragma unroll
            for (int kb = 0; kb < 2; ++kb) {
                bf16x8 pf[2];
#pragma unroll
                for (int ni = 0; ni < 2; ++ni) {
                    const f32x4 s0 = sacc[2 * kb][ni], s1 = sacc[2 * kb + 1][ni];
                    u32x4 pk; pk[0] = pack2(s0[0], s0[1]); pk[1] = pack2(s0[2], s0[3]); pk[2] = pack2(s1[0], s1[1]); pk[3] = pack2(s1[2], s1[3]);
                    pf[ni] = as_bf16x8(pk);
                    accL[ni] = __builtin_amdgcn_mfma_f32_16x16x32_bf16(vones, pf[ni], accL[ni], 0, 0, 0);
                }
#pragma unroll
                for (int mo = 0; mo < 4; ++mo) {
                    const bf16_t* vsrc = sV + (mo * 16 + r16) * LV + 32 * kb + 4 * g;
                    const uint2 lo = *(const uint2*)vsrc, hi = *(const uint2*)(vsrc + 16);
                    u32x4 vv; vv[0] = lo.x; vv[1] = lo.y; vv[2] = hi.x; vv[3] = hi.y;
                    const bf16x8 vf = as_bf16x8(vv);
#pragma unroll
                    for (int ni = 0; ni < 2; ++ni) accO[mo][ni] = __builtin_amdgcn_mfma_f32_16x16x32_bf16(vf, pf[ni], accO[mo][ni], 0, 0, 0);
                }
            }
        }
        if (kt + 1 < nt) {
            bf16_t* dK = smem + ((kt + 1) & 1) * STG;
            *(u32x4*)(dK + kd0) = rk0; if (k2) *(u32x4*)(dK + kd1) = rk1;
            *(u32x4*)(dK + 64 * LK + vrow * LV + vkc) = rv0;
        }
        __syncthreads();
    }
#pragma unroll
    for (int ni = 0; ni < 2; ++ni) {
        float l = accL[ni][0]; l += __shfl_xor(l, 16); l += __shfl_xor(l, 32);
        const float inv = 1.f / l;
        const int tok = tokb + qw0 + ni * 16 + r16; float ss = 0.f;
#pragma unroll
        for (int mo = 0; mo < 4; ++mo) {
            const f32x4 v = accO[mo][ni] * inv;
            ss += v[0] * v[0] + v[1] * v[1] + v[2] * v[2] + v[3] * v[3];
            *(uint2*)(s.ao + (size_t)tok * 1024 + h * 64 + mo * 16 + 4 * g) = pack4v(v);
        }
        ss += __shfl_xor(ss, 16); ss += __shfl_xor(ss, 32);
        if (lane < 16) s.a_ss[tok * 8 + h] = ss;
    }
}
__device__ void phase3(const Params& p, unsigned char* smem) {
    const WS s = make_ws(p.ws, p.out);
    for (int u = blockIdx.x; u < 512; u += gridDim.x) {
        const int half = u >> 8, v = u & 255, x = v >> 6, bh = v & 63;
        attn_unit(s, bh >> 3, bh & 7, half ? x : 7 - x, (bf16_t*)smem);
    }
}

DEVINL void router_superunit(const Params& p, const WS& s, unsigned char* smem, const int u) {
    int t = threadIdx.x; asm volatile("" : "+v"(t));
    const int lane = t & 63, w = t >> 6, i16 = lane & 15, g = lane >> 4;
    f32x4* racc = (f32x4*)smem;
    float* slog = (float*)(smem + 98304);
    int* hist = (int*)(smem + 98304 + 12288);
    {
        const int kb = 128 * w + 8 * g;
        f32x4 acc[4][3];
#pragma unroll
        for (int tl = 0; tl < 4; ++tl)
#pragma unroll
            for (int nt = 0; nt < 3; ++nt) acc[tl][nt] = (f32x4){0.f, 0.f, 0.f, 0.f};
#pragma unroll
        for (int q = 0; q < 4; ++q) {
            const int k = kb + 32 * q;
            f32x4 w0[3], w1[3];
#pragma unroll
            for (int nt = 0; nt < 3; ++nt) { w0[nt] = *(const f32x4*)(s.wrt + (size_t)(nt * 16 + i16) * 1024 + k); w1[nt] = *(const f32x4*)(s.wrt + (size_t)(nt * 16 + i16) * 1024 + k + 4); }
#pragma unroll
            for (int tl = 0; tl < 4; ++tl) {
                const u32x4 xr = *(const u32x4*)(s.x1b + (size_t)(u * 64 + tl * 16 + i16) * 1024 + k);
                const float x0[4] = {bflo(xr[0]), bfhi(xr[0]), bflo(xr[1]), bfhi(xr[1])};
                const float x1[4] = {bflo(xr[2]), bfhi(xr[2]), bflo(xr[3]), bfhi(xr[3])};
#pragma unroll
                for (int nt = 0; nt < 3; ++nt) {
#pragma unroll
                    for (int c = 0; c < 4; ++c) acc[tl][nt] = __builtin_amdgcn_mfma_f32_16x16x4f32(x0[c], w0[nt][c], acc[tl][nt], 0, 0, 0);
#pragma unroll
                    for (int c = 0; c < 4; ++c) acc[tl][nt] = __builtin_amdgcn_mfma_f32_16x16x4f32(x1[c], w1[nt][c], acc[tl][nt], 0, 0, 0);
                }
            }
        }
        __syncthreads();
#pragma unroll
        for (int tl = 0; tl < 4; ++tl)
#pragma unroll
            for (int nt = 0; nt < 3; ++nt) racc[(w * 12 + tl * 3 + nt) * 64 + lane] = acc[tl][nt];
        if (t < 32) hist[t] = 0;
        __syncthreads();
        for (int item = t; item < 12 * 64; item += NTHR) {
            const int tn = item >> 6, ln = item & 63, tl = tn / 3, nt = tn - tl * 3;
            f32x4 v = racc[tn * 64 + ln];
#pragma unroll
            for (int ww = 1; ww < 8; ++ww) v = v + racc[(ww * 12 + tn) * 64 + ln];
            const int n = nt * 16 + (ln & 15), gq = ln >> 4;
#pragma unroll
            for (int r = 0; r < 4; ++r) slog[(tl * 16 + 4 * gq + r) * 48 + n] = v[r];
        }
        __syncthreads();
        int e0 = 0, e1 = 0, rk0 = 0, rk1 = 0; float gate0 = 0.f, gate1 = 0.f;
        if (t < 64) {
            const float* lg = slog + t * 48;
            const float l0 = lg[0] + p.b_rg[0], l1 = lg[1] + p.b_rg[1], l2 = lg[2] + p.b_rg[2], l3 = lg[3] + p.b_rg[3];
            int gi = 0; float gm = l0;
            if (l1 > gm) { gm = l1; gi = 1; }
            if (l2 > gm) { gm = l2; gi = 2; }
            if (l3 > gm) { gm = l3; gi = 3; }
            const float gp = 1.f / (expf(l0 - gm) + expf(l1 - gm) + expf(l2 - gm) + expf(l3 - gm));
            float le[8];
#pragma unroll
            for (int j = 0; j < 8; ++j) le[j] = lg[4 + gi * 8 + j] + p.b_re[gi * 8 + j];
            int i0 = 0; float m0v = le[0];
#pragma unroll
            for (int j = 1; j < 8; ++j) if (le[j] > m0v) { m0v = le[j]; i0 = j; }
            int i1 = -1; float m1v = -3.0e38f;
#pragma unroll
            for (int j = 0; j < 8; ++j) if (j != i0 && le[j] > m1v) { m1v = le[j]; i1 = j; }
            const float pe1 = expf(m1v - m0v);
            gate0 = gp / (1.f + pe1); gate1 = gp * pe1 / (1.f + pe1);
            e0 = gi * 8 + i0; e1 = gi * 8 + i1;
            rk0 = atomicAdd(&hist[e0], 1); rk1 = atomicAdd(&hist[e1], 1);
        }
        __syncthreads();
        if (t < 32) { const int c = hist[t]; hist[32 + t] = c ? atomicAdd(&s.cnt[t * 64], c) : 0; }
        __syncthreads();
        if (t < 64) {
            const int tk = u * 64 + t;
            const int pos0 = hist[32 + e0] + rk0, pos1 = hist[32 + e1] + rk1;
            s.list[e0 * 16384 + pos0] = tk * 2; s.gatew[tk * 2] = gate0; s.asgep[tk * 2] = (e0 << 16) | pos0;
            s.list[e1 * 16384 + pos1] = tk * 2 + 1; s.gatew[tk * 2 + 1] = gate1; s.asgep[tk * 2 + 1] = (e1 << 16) | pos1;
        }
    }
}

__device__ void phase5(const Params& p, unsigned char* smem) {
    const WS s = make_ws(p.ws, p.out);
    for (int u = blockIdx.x; u < T_ / 64; u += gridDim.x) router_superunit(p, s, smem, u);
}

struct EpiP4 {
    const Params* p; WS s; unsigned* gcnt;
    DEVINL void mid(f32x4 (&acc)[2][2][4][2], const pg8::Unit& u, int wr, int wc, int fr, int fq) const {
#pragma unroll
        for (int ai = 0; ai < 2; ++ai)
#pragma unroll
            for (int m = 0; m < 4; ++m) {
                const float sc = s.rowsc[u.a0 * 256 + ai * 128 + wr * 64 + m * 16 + fr].x;
#pragma unroll
                for (int bj = 0; bj < 2; ++bj)
#pragma unroll
                    for (int n = 0; n < 2; ++n) acc[ai][bj][m][n] = acc[ai][bj][m][n] * sc;
            }
    }
    DEVINL void operator()(const f32x4 (&)[2][2][4][2], const pg8::Unit&, int, int, int, int) const {}
    DEVINL void final(f32x4 (&acc)[2][2][4][2], const pg8::Unit& u, int wr_, int wc_, int fr_, int fq_, LAS unsigned char* lds) const {
        float2* red = (float2*)lds;
        int t2 = threadIdx.x; asm volatile("" : "+v"(t2));
        const int wid2 = t2 >> 6, wr = wid2 >> 2, wc = wid2 & 3, fr = t2 & 15, fq = (t2 >> 4) & 3;
        const int row0 = u.a0 * 256 + wr * 64 + fr, col0 = u.a1 * 256 + wc * 32 + fq * 4;
        float rgv[2][4];
#pragma unroll
        for (int ai = 0; ai < 2; ++ai)
#pragma unroll
            for (int m = 0; m < 4; ++m) rgv[ai][m] = s.rowsc[row0 + ai * 128 + m * 16].y;
        uint2 xn[2][2];
#pragma unroll
        for (int bj = 0; bj < 2; ++bj)
#pragma unroll
            for (int n = 0; n < 2; ++n) xn[bj][n] = *(const uint2*)(s.xb + (size_t)row0 * 1024 + col0 + bj * 128 + n * 16);
#pragma unroll
        for (int it = 0; it < 8; ++it) {
            const int ai = it >> 2, m = it & 3, rl = ai * 128 + wr * 64 + m * 16 + fr;
            uint2 xc[2][2];
#pragma unroll
            for (int bj = 0; bj < 2; ++bj)
#pragma unroll
                for (int n = 0; n < 2; ++n) xc[bj][n] = xn[bj][n];
            asm volatile("" ::: "memory");
            if (it < 7) {
                const int ai2 = (it + 1) >> 2, m2 = (it + 1) & 3;
#pragma unroll
                for (int bj = 0; bj < 2; ++bj)
#pragma unroll
                    for (int n = 0; n < 2; ++n) xn[bj][n] = *(const uint2*)(s.xb + (size_t)(row0 + ai2 * 128 + m2 * 16) * 1024 + col0 + bj * 128 + n * 16);
            }
            float sum = 0.f, sq = 0.f;
#pragma unroll
            for (int bj = 0; bj < 2; ++bj)
#pragma unroll
                for (int n = 0; n < 2; ++n) {
                    const f32x4 xf = {bflo(xc[bj][n].x), bfhi(xc[bj][n].x), bflo(xc[bj][n].y), bfhi(xc[bj][n].y)};
                    const f32x4 a = acc[ai][bj][m][n] * rgv[ai][m] + xf * ALPHA_;
                    acc[ai][bj][m][n] = a;
                    sum += (a[0] + a[1]) + (a[2] + a[3]); sq += (a[0] * a[0] + a[1] * a[1]) + (a[2] * a[2] + a[3] * a[3]);
                }
            sum += __shfl_xor(sum, 16); sum += __shfl_xor(sum, 32); sq += __shfl_xor(sq, 16); sq += __shfl_xor(sq, 32);
            if (fq == 0) red[rl * 4 + wc] = make_float2(sum, sq);
        }
        __syncthreads();
        int tl = threadIdx.x; asm volatile("" : "+v"(tl));
        if (tl < 256) {
            const float2 r0 = red[tl * 4 + 0], r1 = red[tl * 4 + 1], r2 = red[tl * 4 + 2], r3 = red[tl * 4 + 3];
            st_wt8(&s.part[(size_t)(u.a0 * 256 + tl) * 4 + u.a1], make_uint2(__float_as_uint((r0.x + r1.x) + (r2.x + r3.x)), __float_as_uint((r0.y + r1.y) + (r2.y + r3.y))));
        }
        group_sync(gcnt + (u.a0 * 4 + 0) * 64, 4u);
        float mean[2][4], rstd[2][4];
#pragma unroll
        for (int ai = 0; ai < 2; ++ai)
#pragma unroll
            for (int m = 0; m < 4; ++m) {
                const int row = row0 + ai * 128 + m * 16;
                const float4 p01 = *(const float4*)(s.part + (size_t)row * 4), p23 = *(const float4*)(s.part + (size_t)row * 4 + 2);
                const float mu = ((p01.x + p01.z) + (p23.x + p23.z)) * (1.f / 1024.f);
                const float var = ((p01.y + p01.w) + (p23.y + p23.w)) * (1.f / 1024.f) - mu * mu;
                mean[ai][m] = mu; rstd[ai][m] = rsqrtf(fmaxf(var, 0.f) + EPS_);
            }
        f32x4 gg[2][2], bb[2][2];
#pragma unroll
        for (int bj = 0; bj < 2; ++bj)
#pragma unroll
            for (int n = 0; n < 2; ++n) { gg[bj][n] = *(const f32x4*)(p->ln1_g + col0 + bj * 128 + n * 16); bb[bj][n] = *(const f32x4*)(p->ln1_b + col0 + bj * 128 + n * 16); }
#pragma unroll
        for (int ai = 0; ai < 2; ++ai)
#pragma unroll
            for (int m = 0; m < 4; ++m) {
                const int row = row0 + ai * 128 + m * 16;
#pragma unroll
                for (int bj = 0; bj < 2; ++bj)
#pragma unroll
                    for (int n = 0; n < 2; ++n) {
                        const f32x4 o = (acc[ai][bj][m][n] - mean[ai][m]) * rstd[ai][m] * gg[bj][n] + bb[bj][n];
                        st_wt8(s.x1b + (size_t)row * 1024 + col0 + bj * 128 + n * 16, pack4v(o));
                    }
            }
        group_sync(gcnt + (u.a0 * 4 + 1) * 64, 4u);
        router_superunit(*p, s, (unsigned char*)lds, u.a0 * 4 + u.a1);
    }
};
__device__ void phase4(const Params& p, unsigned char* smem) {
    const WS s = make_ws(p.ws, p.out);
    pg8::DenseOrder S{(const char*)s.ao, (const char*)s.wo, 1024, 1024, 64, 4, (int)gridDim.x, (int)blockIdx.x, REP_P4};
    { pg8::Unit u;
      for (int i = 0; S.next(i, u); ++i)
          if (threadIdx.x < 256) {
              const int row = u.a0 * 256 + threadIdx.x;
              const float4 a0 = *(const float4*)(s.a_ss + row * 8), a1 = *(const float4*)(s.a_ss + row * 8 + 4);
              const float4 g0 = *(const float4*)(s.g_ss + row * 8), g1 = *(const float4*)(s.g_ss + row * 8 + 4);
              const float ra = rsqrtf((a0.x + a0.y + a0.z + a0.w + a1.x + a1.y + a1.z + a1.w) * (1.f / 512.f) + EPS_);
              const float rg = rsqrtf((g0.x + g0.y + g0.z + g0.w + g1.x + g1.y + g1.z + g1.w) * (1.f / 512.f) + EPS_);
              s.rowsc[row] = make_float2(ra / rg, rg);
          }
      asm volatile("s_waitcnt vmcnt(0)" ::: "memory");
      __syncthreads(); }
    EpiP4 E{&p, s, (unsigned*)(p.ws + WS_GCNT)};
    pg8::gemm_phase<8, true>((LAS unsigned char*)smem, S, E, 1024, 1024);
}

struct MoeMeta { int cnt[32]; int tstart[33]; int hbase[33]; };
DEVINL void moe_meta(const WS& s, MoeMeta* mm) {
    __syncthreads();
    if (threadIdx.x == 0) {
        int ts = 0, hb = 0;
        for (int e = 0; e < 32; ++e) { const int c = s.cnt[e * 64]; mm->cnt[e] = c; mm->tstart[e] = ts; mm->hbase[e] = hb; ts += (c + 255) >> 8; hb += c; }
        mm->tstart[32] = ts; mm->hbase[32] = hb;
    }
    __syncthreads();
}
struct MoeOrder {
    const MoeMeta* mm; const int* list; const char* Abase; const char* Bbase; size_t bstride_e, bstride_pn; int mode, G, c, rep;
    DEVINL bool next(int i, pg8::Unit& u) const {
        const int nwg = mm->tstart[32] * 4; const long L = (long)i * G + c; if (L >= (long)nwg * rep) return false;
        int wgid = (int)(L % nwg); { const int q = nwg / 8, r = nwg % 8, xcd = wgid % 8, off = wgid / 8; wgid = (xcd < r ? xcd * (q + 1) : r * (q + 1) + (xcd - r) * q) + off; }
        const int ti = wgid >> 2, pn = wgid & 3;
        int e = 0; while (mm->tstart[e + 1] <= ti) ++e;
        const int it = ti - mm->tstart[e];
        u.A = Abase; u.B = Bbase + (size_t)e * bstride_e + (size_t)pn * bstride_pn;
        u.a0 = e * 16384 + it * 256; u.a1 = mm->hbase[e] + it * 256; u.a2 = pn; u.a3 = min(256, mm->cnt[e] - it * 256);
        return true;
    }
    DEVINL unsigned arow(const pg8::Unit& u, int r) const {
        const int rr = min(r, u.a3 - 1);
        if (mode == 0) return (unsigned)(list[u.a0 + rr] >> 1) * 2048u;
        return (unsigned)(u.a1 + rr) * 1024u;
    }
};
struct EpiP6 {
    WS s;
    DEVINL void mid(f32x4 (&)[2][2][4][2], const pg8::Unit&, int, int, int, int) const {}
    DEVINL void operator()(const f32x4 (&acc)[2][2][4][2], const pg8::Unit& u, int wr, int wc, int fr, int fq) const {
#pragma unroll
        for (int ai = 0; ai < 2; ++ai)
#pragma unroll
            for (int m = 0; m < 4; ++m) {
                const int r = ai * 128 + wr * 64 + m * 16 + fr;
                if (r < u.a3) {
#pragma unroll
                    for (int bj = 0; bj < 2; ++bj) {
                        const f32x4 gt = acc[ai][bj][m][0], up = acc[ai][bj][m][1];
                        float hv[4];
#pragma unroll
                        for (int q = 0; q < 4; ++q) hv[q] = gt[q] * fast_sigmoid(gt[q]) * up[q];
                        *(uint2*)(s.H + (size_t)(u.a1 + r) * 512 + u.a2 * 128 + bj * 64 + wc * 16 + fq * 4) = pack4(hv[0], hv[1], hv[2], hv[3]);
                    }
                }
            }
    }
};
struct EpiP7 {
    WS s;
    DEVINL void mid(f32x4 (&)[2][2][4][2], const pg8::Unit&, int, int, int, int) const {}
    DEVINL void operator()(const f32x4 (&acc)[2][2][4][2], const pg8::Unit& u, int wr, int wc, int fr, int fq) const {
#pragma unroll
        for (int ai = 0; ai < 2; ++ai)
#pragma unroll
            for (int m = 0; m < 4; ++m) {
                const int r = ai * 128 + wr * 64 + m * 16 + fr;
                if (r < u.a3) {
#pragma unroll
                    for (int bj = 0; bj < 2; ++bj)
#pragma unroll
                        for (int n = 0; n < 2; ++n)
                            *(uint2*)(s.ymoe + (size_t)(u.a1 + r) * 1024 + u.a2 * 256 + bj * 128 + wc * 32 + n * 16 + fq * 4) = pack4v(acc[ai][bj][m][n]);
                }
            }
    }
};
DEVINL size_t pp_off(int row, int col) { return (size_t)(row >> 8) * 524288 + 262144 + (size_t)(row & 255) * 1024 + col; }
struct EpiP9a {
    bf16_t* pp;
    DEVINL void mid(f32x4 (&)[2][2][4][2], const pg8::Unit&, int, int, int, int) const {}
    DEVINL void operator()(const f32x4 (&acc)[2][2][4][2], const pg8::Unit& u, int wr, int wc, int fr, int fq) const {
#pragma unroll
        for (int ai = 0; ai < 2; ++ai)
#pragma unroll
            for (int m = 0; m < 4; ++m) {
                const int row = u.a0 * 256 + ai * 128 + wr * 64 + m * 16 + fr;
#pragma unroll
                for (int bj = 0; bj < 2; ++bj)
#pragma unroll
                    for (int n = 0; n < 2; ++n)
                        *(uint2*)(pp + pp_off(row, u.a1 * 256 + bj * 128 + wc * 32 + n * 16 + fq * 4)) = pack4v(acc[ai][bj][m][n]);
            }
    }
};
DEVINL void ln2_rows64(const Params& p, const WS& s, const MoeMeta* mm, const int tok0) {
    int t = threadIdx.x; asm volatile("" : "+v"(t));
    const int lane = t & 63, w = t >> 6;
#pragma unroll 1
    for (int half = 0; half < 2; ++half) {
        float v[4][16];
#pragma unroll
        for (int r = 0; r < 4; ++r) {
            const int tok = tok0 + w + 8 * (half * 4 + r);
            const int ep0 = s.asgep[tok * 2], ep1 = s.asgep[tok * 2 + 1];
            const float g0 = s.gatew[tok * 2], g1 = s.gatew[tok * 2 + 1];
            const size_t r0 = (size_t)(mm->hbase[ep0 >> 16] + (ep0 & 0xffff)) * 1024, r1 = (size_t)(mm->hbase[ep1 >> 16] + (ep1 & 0xffff)) * 1024;
#pragma unroll
            for (int i = 0; i < 4; ++i) {
                const int c = i * 256 + lane * 4;
                const uint2 a = *(const uint2*)(s.x1b + (size_t)tok * 1024 + c);
                const uint2 y0 = *(const uint2*)(s.ymoe + r0 + c), y1 = *(const uint2*)(s.ymoe + r1 + c);
                v[r][i * 4 + 0] = ALPHA_ * bflo(a.x) + (g0 * bflo(y0.x) + g1 * bflo(y1.x)); v[r][i * 4 + 1] = ALPHA_ * bfhi(a.x) + (g0 * bfhi(y0.x) + g1 * bfhi(y1.x));
                v[r][i * 4 + 2] = ALPHA_ * bflo(a.y) + (g0 * bflo(y0.y) + g1 * bflo(y1.y)); v[r][i * 4 + 3] = ALPHA_ * bfhi(a.y) + (g0 * bfhi(y0.y) + g1 * bfhi(y1.y));
            }
        }
#pragma unroll
        for (int r = 0; r < 4; ++r) {
            const int tok = tok0 + w + 8 * (half * 4 + r);
            float sum = 0.f;
#pragma unroll
            for (int i = 0; i < 16; ++i) sum += v[r][i];
            const float mean = wave_sum(sum) * (1.f / 1024.f); float sq = 0.f;
#pragma unroll
            for (int i = 0; i < 16; ++i) { const float d = v[r][i] - mean; sq += d * d; }
            const float rstd = rsqrtf(wave_sum(sq) * (1.f / 1024.f) + EPS_);
#pragma unroll
            for (int i = 0; i < 4; ++i) {
                const int c = i * 256 + lane * 4;
                const float4 gg = *(const float4*)(p.ln2_g + c), bb = *(const float4*)(p.ln2_b + c);
                st_wt8(s.x2b + (size_t)tok * 1024 + c, pack4((v[r][i * 4 + 0] - mean) * rstd * gg.x + bb.x, (v[r][i * 4 + 1] - mean) * rstd * gg.y + bb.y,
                                                              (v[r][i * 4 + 2] - mean) * rstd * gg.z + bb.z, (v[r][i * 4 + 3] - mean) * rstd * gg.w + bb.w));
            }
        }
    }
}

__device__ void phase6(const Params& p, unsigned char* smem, MoeMeta* mm) {
    const WS s = make_ws(p.ws, p.out);
    moe_meta(s, mm);
    MoeOrder S{mm, s.list, (const char*)s.x1b, (const char*)s.wgu, (size_t)1024 * 1024 * 2, (size_t)256 * 1024 * 2, 0, (int)gridDim.x, (int)blockIdx.x, REP_P6};
    EpiP6 E{s};
    pg8::gemm_phase<0, false, (EPI2 == 6 ? 2 : 1)>((LAS unsigned char*)smem, S, E, 1024, 1024);
    int j, nh; helper_slot(mm->tstart[32] * 4 * REP_P6, (int)gridDim.x, (int)blockIdx.x, j, nh);
    if (j >= 0) {
        conv_expert_tiles(p, s, 1, j, 32 * 128, nh, (float*)smem);
        for (size_t i = (size_t)j * NTHR + threadIdx.x; i < (size_t)T_ * 256 / 8; i += (size_t)nh * NTHR) cvt8(p.p + i * 8, s.pb + i * 8);
    }
}
__device__ void phase7(const Params& p, unsigned char* smem, MoeMeta* mm) {
    const WS s = make_ws(p.ws, p.out);
    moe_meta(s, mm);
    MoeOrder S{mm, s.list, (const char*)s.H, (const char*)s.wd, (size_t)1024 * 512 * 2, (size_t)256 * 512 * 2, 1, (int)gridDim.x, (int)blockIdx.x, REP_P7};
    EpiP7 E{s};
    pg8::gemm_phase<0, false, (EPI2 == 7 ? 2 : 1)>((LAS unsigned char*)smem, S, E, 512, 512);
    int j, nh; helper_slot(mm->tstart[32] * 4 * REP_P7, (int)gridDim.x, (int)blockIdx.x, j, nh);
    if (j >= 0) {
        pg8::DenseOrder Sa{(const char*)s.pb, (const char*)s.wpp, 256, 256, 64, 4, nh, j, 1};
        EpiP9a Ea{(bf16_t*)p.out};
        pg8::gemm_phase<0, false, (EPI2 == 9 ? 2 : 1)>((LAS unsigned char*)smem, Sa, Ea, 256, 256);
    }
}

struct EpiP9b {
    const Params* p; WS s; const bf16_t* pp; unsigned* gcnt;
    DEVINL void mid(f32x4 (&)[2][2][4][2], const pg8::Unit&, int, int, int, int) const {}
    DEVINL void operator()(const f32x4 (&)[2][2][4][2], const pg8::Unit&, int, int, int, int) const {}
    DEVINL void final(f32x4 (&acc)[2][2][4][2], const pg8::Unit& u, int wr_, int wc_, int fr_, int fq_, LAS unsigned char* lds) const {
        float2* red = (float2*)lds;
        int t2 = threadIdx.x; asm volatile("" : "+v"(t2));
        const int wid2 = t2 >> 6, wr = wid2 >> 2, wc = wid2 & 3, fr = t2 & 15, fq = (t2 >> 4) & 3;
        const int row0 = u.a0 * 256 + wr * 64 + fr, col0 = u.a1 * 256 + wc * 32 + fq * 4;
        uint2 xn[2][2], pn_[2][2];
#pragma unroll
        for (int bj = 0; bj < 2; ++bj)
#pragma unroll
            for (int n = 0; n < 2; ++n) { xn[bj][n] = *(const uint2*)(s.x2b + (size_t)row0 * 1024 + col0 + bj * 128 + n * 16); pn_[bj][n] = *(const uint2*)(pp + pp_off(row0, col0 + bj * 128 + n * 16)); }
#pragma unroll
        for (int it = 0; it < 8; ++it) {
            const int ai = it >> 2, m = it & 3, rl = ai * 128 + wr * 64 + m * 16 + fr;
            float sum = 0.f, sq = 0.f;
#pragma unroll
            for (int bj = 0; bj < 2; ++bj)
#pragma unroll
                for (int n = 0; n < 2; ++n) {
                    const f32x4 a = acc[ai][bj][m][n] + *(const f32x4*)(p->b_pg + col0 + bj * 128 + n * 16);
                    const uint2 xr = xn[bj][n], pr = pn_[bj][n];
                    f32x4 o;
                    o[0] = ALPHA_ * bflo(xr.x) + bflo(pr.x) * fast_sigmoid(a[0]);
                    o[1] = ALPHA_ * bfhi(xr.x) + bfhi(pr.x) * fast_sigmoid(a[1]);
                    o[2] = ALPHA_ * bflo(xr.y) + bflo(pr.y) * fast_sigmoid(a[2]);
                    o[3] = ALPHA_ * bfhi(xr.y) + bfhi(pr.y) * fast_sigmoid(a[3]);
                    acc[ai][bj][m][n] = o;
                    sum += (o[0] + o[1]) + (o[2] + o[3]); sq += (o[0] * o[0] + o[1] * o[1]) + (o[2] * o[2] + o[3] * o[3]);
                }
            asm volatile("" ::: "memory");
            if (it < 7) {
                const int rn = row0 + ((it + 1) >> 2) * 128 + ((it + 1) & 3) * 16; const size_t ro = (size_t)rn * 1024 + col0;
#pragma unroll
                for (int bj = 0; bj < 2; ++bj)
#pragma unroll
                    for (int n = 0; n < 2; ++n) { xn[bj][n] = *(const uint2*)(s.x2b + ro + bj * 128 + n * 16); pn_[bj][n] = *(const uint2*)(pp + pp_off(rn, col0 + bj * 128 + n * 16)); }
            }
            sum += __shfl_xor(sum, 16); sum += __shfl_xor(sum, 32); sq += __shfl_xor(sq, 16); sq += __shfl_xor(sq, 32);
            if (fq == 0) red[rl * 4 + wc] = make_float2(sum, sq);
        }
        __syncthreads();
        int tl = threadIdx.x; asm volatile("" : "+v"(tl));
        if (tl < 256) {
            const float2 r0 = red[tl * 4 + 0], r1 = red[tl * 4 + 1], r2 = red[tl * 4 + 2], r3 = red[tl * 4 + 3];
            st_wt8(&s.part[(size_t)(u.a0 * 256 + tl) * 4 + u.a1], make_uint2(__float_as_uint((r0.x + r1.x) + (r2.x + r3.x)), __float_as_uint((r0.y + r1.y) + (r2.y + r3.y))));
        }
        group_sync(gcnt + (u.a0 * 4 + 2) * 64, 4u);
        float mean[2][4], rstd[2][4];
#pragma unroll
        for (int ai = 0; ai < 2; ++ai)
#pragma unroll
            for (int m = 0; m < 4; ++m) {
                const int row = row0 + ai * 128 + m * 16;
                const float4 p01 = *(const float4*)(s.part + (size_t)row * 4), p23 = *(const float4*)(s.part + (size_t)row * 4 + 2);
                const float mu = ((p01.x + p01.z) + (p23.x + p23.z)) * (1.f / 1024.f);
                const float var = ((p01.y + p01.w) + (p23.y + p23.w)) * (1.f / 1024.f) - mu * mu;
                mean[ai][m] = mu; rstd[ai][m] = rsqrtf(fmaxf(var, 0.f) + EPS_);
            }
#pragma unroll
        for (int ai = 0; ai < 2; ++ai)
#pragma unroll
            for (int m = 0; m < 4; ++m) {
                const int row = row0 + ai * 128 + m * 16;
#pragma unroll
                for (int bj = 0; bj < 2; ++bj)
#pragma unroll
                    for (int n = 0; n < 2; ++n) {
                        const f32x4 gg = *(const f32x4*)(p->ln3_g + col0 + bj * 128 + n * 16), bb = *(const f32x4*)(p->ln3_b + col0 + bj * 128 + n * 16);
                        __builtin_nontemporal_store((acc[ai][bj][m][n] - mean[ai][m]) * rstd[ai][m] * gg + bb, (f32x4*)(p->out + (size_t)row * 1024 + col0 + bj * 128 + n * 16));
                    }
                asm volatile("" ::: "memory");
            }
    }
};
__device__ void phase9(const Params& p, unsigned char* smem, MoeMeta* mm) {
    const WS s = make_ws(p.ws, p.out);
    moe_meta(s, mm);
    unsigned* gcnt = (unsigned*)(p.ws + WS_GCNT);
    pg8::DenseOrder S{(const char*)s.x2b, (const char*)s.wpg, 1024, 1024, 64, 4, (int)gridDim.x, (int)blockIdx.x, 1};
    pg8::Unit u0;
    if (!S.next(0, u0)) return;
    ln2_rows64(p, s, mm, u0.a0 * 256 + u0.a1 * 64);
    group_sync(gcnt + (u0.a0 * 4 + 3) * 64, 4u);
    const bf16_t* pp = (const bf16_t*)p.out;
    {
        EpiP9b E{&p, s, pp, gcnt};
        pg8::gemm_phase<0, true>((LAS unsigned char*)smem, S, E, 1024, 1024);
    }
}

constexpr int NPHASE = 11;
template <int LO, int HI>
__global__ void __launch_bounds__(NTHR, 2) fwd_kernel(Params p) {
    extern __shared__ __attribute__((aligned(16))) unsigned char smem[];
    MoeMeta& mm = *(MoeMeta*)(smem + LDS_META);
    XcdBarrier bar;
    if (HI - LO > 1) {
        if (threadIdx.x < 4) ((unsigned*)(smem + LDS_XB))[threadIdx.x] = 0u;
        __syncthreads();
        bar = xcd_barrier_post((unsigned*)(p.ws + WS_BAR), (volatile LAS unsigned*)(smem + LDS_XB));
#if USE_COOP
        if (p.use_cg_sync) cg::this_grid().sync();
#endif
    }
#ifndef REP_PHASE
#define REP_PHASE -1
#endif
#define PH(k) _Pragma("nounroll") for (int rep_ = 0; rep_ < ((REP_PHASE == (k)) ? 2 + p.use_cg_sync : 1); ++rep_) if (LO <= (k) && (k) < HI)
#define SYNC(k) if (LO <= (k) && (k) + 1 < HI) { if ((k) == LO) xcd_barrier<true>(bar); else xcd_barrier<false>(bar); }
    PH(0) { phase0(p, smem); if (REP_PHASE == 0 && rep_ == 0) xcd_barrier<true>(bar); } SYNC(0)
    PH(1) { phase1(p, smem); if (REP_PHASE == 1 && rep_ == 0) xcd_barrier(bar); } SYNC(1)
    PH(2) { phase2(p, smem, REP_PHASE != 2 || rep_ == 1); if (REP_PHASE == 2 && rep_ == 0) xcd_barrier(bar); } SYNC(2)
    PH(3) { phase3(p, smem); if (REP_PHASE == 3 && rep_ == 0) xcd_barrier(bar); } SYNC(3)
    PH(4) { phase4(p, smem); } SYNC(4)
    PH(6) { phase6(p, smem, &mm); if (REP_PHASE == 6 && rep_ == 0) xcd_barrier(bar); } SYNC(6)
    PH(7) { phase7(p, smem, &mm); if (REP_PHASE == 7 && rep_ == 0) xcd_barrier(bar); } SYNC(7)
    PH(9) { phase9(p, smem, &mm); }
#undef PH
#undef SYNC
}

template <int K> static void launch_one(const Params& prm, int grid, hipStream_t stream) {
    hipFuncSetAttribute((const void*)fwd_kernel<K, K + 1>, hipFuncAttributeMaxDynamicSharedMemorySize, LDS_BYTES);
    hipLaunchKernelGGL((fwd_kernel<K, K + 1>), dim3(grid), dim3(NTHR), LDS_BYTES, stream, prm);
}

extern "C" void kernel_launch(void* const* d_in, const int* in_sizes, int n_in, void* d_out, int out_size, void* d_ws, size_t ws_size,
                              hipStream_t stream) {
    if (n_in != 31 || ws_size < WS_END) { fprintf(stderr, "kernel_launch: unexpected n_in %d / ws_size %zu\n", n_in, ws_size); return; }
    Params prm{};
    prm.x = (const float*)d_in[0]; prm.p = (const float*)d_in[1]; prm.pos = (const int*)d_in[2];
    prm.w_in = (const float*)d_in[3]; prm.q_norm_g = (const float*)d_in[4]; prm.w_q_up = (const float*)d_in[5];
    prm.kv_norm_g = (const float*)d_in[6]; prm.w_kv_up = (const float*)d_in[7]; prm.gm_ln_g = (const float*)d_in[8];
    prm.gm_ln_b = (const float*)d_in[9]; prm.gm_w_s = (const float*)d_in[10]; prm.gm_b_s = (const float*)d_in[11];
    prm.mla_out_g = (const float*)d_in[12]; prm.gm_out_g = (const float*)d_in[13]; prm.w_o = (const float*)d_in[14];
    prm.ln1_g = (const float*)d_in[15]; prm.ln1_b = (const float*)d_in[16]; prm.w_rg = (const float*)d_in[17];
    prm.b_rg = (const float*)d_in[18]; prm.w_re = (const float*)d_in[19]; prm.b_re = (const float*)d_in[20];
    prm.w_gate = (const float*)d_in[21]; prm.w_up = (const float*)d_in[22]; prm.w_down = (const float*)d_in[23];
    prm.ln2_g = (const float*)d_in[24]; prm.ln2_b = (const float*)d_in[25]; prm.w_pg = (const float*)d_in[26];
    prm.b_pg = (const float*)d_in[27]; prm.w_pp = (const float*)d_in[28]; prm.ln3_g = (const float*)d_in[29];
    prm.ln3_b = (const float*)d_in[30];
    prm.out = (float*)d_out; prm.ws = (unsigned char*)d_ws;
    for (int j = 0; j < 16; ++j) prm.inv_freq[j] = (float)pow(10000.0, -(double)j / 16.0);
#if N_LAUNCH_MODE == 0
    const int grid = 1024;
    launch_one<0>(prm, grid, stream); launch_one<1>(prm, grid, stream); launch_one<2>(prm, grid, stream);
    launch_one<3>(prm, grid, stream); launch_one<4>(prm, grid, stream); launch_one<5>(prm, grid, stream);
    launch_one<6>(prm, grid, stream); launch_one<7>(prm, grid, stream); launch_one<8>(prm, grid, stream);
    launch_one<9>(prm, grid, stream); launch_one<10>(prm, grid, stream);
#else
    static int grid_blocks = 0;
    if (!grid_blocks) {
        int dev = 0, cus = 0, per_cu = 0;
        hipGetDevice(&dev);
        hipDeviceGetAttribute(&cus, hipDeviceAttributeMultiprocessorCount, dev);
        if (hipFuncSetAttribute((const void*)fwd_kernel<0, NPHASE>, hipFuncAttributeMaxDynamicSharedMemorySize, LDS_BYTES) != hipSuccess)
            fprintf(stderr, "kernel_launch: hipFuncSetAttribute(%d B dynamic LDS) failed\n", LDS_BYTES);
        hipOccupancyMaxActiveBlocksPerMultiprocessor(&per_cu, (const void*)fwd_kernel<0, NPHASE>, NTHR, LDS_BYTES);
        if (per_cu < 1) fprintf(stderr, "kernel_launch: occupancy query reports %d blocks per CU\n", per_cu);
        (void)hipGetLastError();
        grid_blocks = cus;
    }
    hipMemsetAsync((unsigned char*)d_ws + WS_BAR, 0, XCD_BAR_WORDS * 4, stream);
    hipMemsetAsync((unsigned char*)d_ws + WS_GCNT, 0, 64 * 4 * 256, stream);
#if USE_COOP
    void* args[] = {&prm};
    hipError_t e = hipLaunchCooperativeKernel((const void*)fwd_kernel<0, NPHASE>, dim3(grid_blocks), dim3(NTHR), args, LDS_BYTES, stream);
    if (e != hipSuccess) fprintf(stderr, "cooperative launch failed: %s (grid %d)\n", hipGetErrorString(e), grid_blocks);
#else
    hipLaunchKernelGGL((fwd_kernel<0, NPHASE>), dim3(grid_blocks), dim3(NTHR), LDS_BYTES, stream, prm);
#endif
#endif
}
```

```cpp
#include <hip/hip_runtime.h>
#include <hip/hip_cooperative_groups.h>
#include <stdint.h>
#include <math.h>
#include <stdio.h>
namespace cg = cooperative_groups;

#ifndef USE_COOP
#define USE_COOP 0
#endif
#ifndef N_LAUNCH_MODE
#define N_LAUNCH_MODE 1
#endif

#define DEVINL __device__ __forceinline__
typedef unsigned short bf16_t;
typedef short bf16x8 __attribute__((ext_vector_type(8)));
typedef float f32x4 __attribute__((ext_vector_type(4)));
typedef unsigned u32x4 __attribute__((ext_vector_type(4)));

constexpr int T_ = 16384, D_ = 1024, SEQ_ = 2048;
constexpr float ALPHA_ = 1.189207115002721f;
constexpr float EPS_ = 1e-6f;
constexpr int LDK = 72;
constexpr int NTHR = 512;
constexpr int LDS_STAGE = 131072;
constexpr int LDS_META = LDS_STAGE;
constexpr int LDS_XB = LDS_STAGE + 1024;
constexpr int LDS_BYTES = LDS_STAGE + 2048;

constexpr size_t MiB = 1ull << 20;
constexpr size_t WS_WGU = 0;
constexpr size_t WS_WD = 64 * MiB;
constexpr size_t WS_WPG = 96 * MiB;
constexpr size_t WS_WPP = 98 * MiB;
constexpr size_t WS_WIN = 98 * MiB + 512 * 1024;
constexpr size_t WS_WO = WS_WIN + 3 * MiB;
constexpr size_t WS_WQ = WS_WO + 2 * MiB;
constexpr size_t WS_WKV = WS_WQ + 512 * 1024;
constexpr size_t WS_WS = WS_WKV + 256 * 1024;
constexpr size_t WS_WRT = WS_WS + 256 * 1024;
constexpr size_t WS_CS = WS_WRT + 256 * 1024;
constexpr size_t WS_PB = WS_CS + 2 * MiB;
constexpr size_t WS_CNT = WS_PB + 8 * MiB;
constexpr size_t WS_LIST = WS_CNT + 8192;
constexpr size_t WS_GATEW = WS_LIST + 2 * MiB;
constexpr size_t WS_ASGEP = WS_GATEW + 128 * 1024;
constexpr size_t WS_LATSS = WS_ASGEP + 128 * 1024;
constexpr size_t WS_ASS = WS_LATSS + 512 * 1024;
constexpr size_t WS_GSS = WS_ASS + 512 * 1024;
constexpr size_t WS_BAR = 247 * MiB;
constexpr size_t WS_ROWSC = WS_BAR + 64 * 1024;
constexpr size_t WS_PART = WS_ROWSC + 128 * 1024;
constexpr size_t WS_RA = 119 * MiB;
constexpr size_t WS_RB = 151 * MiB;
constexpr size_t WS_RC = 183 * MiB;
constexpr size_t WS_WKV2 = 248 * MiB;
constexpr size_t WS_GCNT = 248 * MiB + 512 * 1024;
constexpr size_t WS_END = 249 * MiB;
static_assert(WS_GSS + 512 * 1024 <= 119 * MiB && WS_PART + 512 * 1024 <= WS_END, "ws overlap");

struct Params {
    const float* x; const float* p; const int* pos;
    const float* w_in; const float* q_norm_g; const float* w_q_up; const float* kv_norm_g; const float* w_kv_up;
    const float* gm_ln_g; const float* gm_ln_b; const float* gm_w_s; const float* gm_b_s;
    const float* mla_out_g; const float* gm_out_g; const float* w_o; const float* ln1_g; const float* ln1_b;
    const float* w_rg; const float* b_rg; const float* w_re; const float* b_re;
    const float* w_gate; const float* w_up; const float* w_down; const float* ln2_g; const float* ln2_b;
    const float* w_pg; const float* b_pg; const float* w_pp; const float* ln3_g; const float* ln3_b;
    float* out; unsigned char* ws;
    float inv_freq[16];
    int use_cg_sync; int pad_;
};

typedef __bf16 bf16x2_t __attribute__((ext_vector_type(2)));
typedef float f32x2_t __attribute__((ext_vector_type(2)));
DEVINL unsigned pack2(float lo, float hi) { const f32x2_t v = {lo, hi}; return __builtin_bit_cast(unsigned, __builtin_convertvector(v, bf16x2_t)); }
DEVINL uint2 pack4(float a, float b, float c, float d) { return make_uint2(pack2(a, b), pack2(c, d)); }
DEVINL uint2 pack4v(f32x4 v) { return make_uint2(pack2(v[0], v[1]), pack2(v[2], v[3])); }
DEVINL float bf2f(unsigned short b) { return __uint_as_float(((unsigned)b) << 16); }
DEVINL float bflo(unsigned u) { return __uint_as_float(u << 16); }
DEVINL float bfhi(unsigned u) { return __uint_as_float(u & 0xffff0000u); }
DEVINL float wave_sum(float v) {
#pragma unroll
    for (int o = 32; o >= 1; o >>= 1) v += __shfl_xor(v, o);
    return v;
}
DEVINL float fast_sigmoid(float x) { return __builtin_amdgcn_rcpf(1.f + __builtin_amdgcn_exp2f(-1.4426950408889634f * x)); }
DEVINL float gelu_tanh(float x) {
    const float z2 = 1.5957691216057308f * (x + 0.044715f * x * x * x);
    return x * fast_sigmoid(z2);
}

template <int MI, int NI, bool TRANS>
DEVINL void mma_ktile(f32x4 (&acc)[MI][NI], const bf16_t* sA, const bf16_t* sB, int lane) {
    const int r16 = lane & 15, kg = (lane >> 4) * 8;
#pragma unroll
    for (int ks = 0; ks < 2; ++ks) {
        bf16x8 a[MI], b[NI];
#pragma unroll
        for (int mi = 0; mi < MI; ++mi) a[mi] = *(const bf16x8*)(sA + (mi * 16 + r16) * LDK + ks * 32 + kg);
#pragma unroll
        for (int ni = 0; ni < NI; ++ni) b[ni] = *(const bf16x8*)(sB + (ni * 16 + r16) * LDK + ks * 32 + kg);
#pragma unroll
        for (int mi = 0; mi < MI; ++mi)
#pragma unroll
            for (int ni = 0; ni < NI; ++ni) {
                if (TRANS) acc[mi][ni] = __builtin_amdgcn_mfma_f32_16x16x32_bf16(a[mi], b[ni], acc[mi][ni], 0, 0, 0);
                else acc[mi][ni] = __builtin_amdgcn_mfma_f32_16x16x32_bf16(b[ni], a[mi], acc[mi][ni], 0, 0, 0);
            }
    }
}

template <bool TRANS, int NI, class ARowF>
DEVINL void gemm_core(f32x4 (&acc)[4][NI], ARowF arow, const bf16_t* __restrict__ Bt, int ldb, int K, bf16_t* smem) {
    bf16_t* sA = smem; bf16_t* sB = smem + 256 * LDK;
    const int t = threadIdx.x, lane = t & 63, w = t >> 6, wr = w >> 1, wc = w & 1;
    const int lrow = t >> 3, lkc = (t & 7) * 8;
    const bf16_t* ap[4]; const bf16_t* bp[2];
#pragma unroll
    for (int i = 0; i < 4; ++i) ap[i] = arow(lrow + 64 * i) + lkc;
    bp[0] = Bt + (size_t)lrow * ldb + lkc;
    bp[1] = Bt + (size_t)(lrow + (NI == 4 ? 64 : 0)) * ldb + lkc;
    u32x4 ra0, ra1, ra2, ra3, rb0, rb1;
    ra0 = *(const u32x4*)(ap[0]); ra1 = *(const u32x4*)(ap[1]); ra2 = *(const u32x4*)(ap[2]); ra3 = *(const u32x4*)(ap[3]);
    rb0 = *(const u32x4*)(bp[0]);
    if (NI == 4) rb1 = *(const u32x4*)(bp[1]);
#pragma nounroll
    for (int k0 = 0; k0 < K; k0 += 64) {
        __syncthreads();
        *(u32x4*)(sA + (lrow + 0) * LDK + lkc) = ra0; *(u32x4*)(sA + (lrow + 64) * LDK + lkc) = ra1;
        *(u32x4*)(sA + (lrow + 128) * LDK + lkc) = ra2; *(u32x4*)(sA + (lrow + 192) * LDK + lkc) = ra3;
        *(u32x4*)(sB + (lrow + 0) * LDK + lkc) = rb0;
        if (NI == 4) *(u32x4*)(sB + (lrow + 64) * LDK + lkc) = rb1;
        __syncthreads();
        if (k0 + 64 < K) {
            const int kn = k0 + 64;
            ra0 = *(const u32x4*)(ap[0] + kn); ra1 = *(const u32x4*)(ap[1] + kn); ra2 = *(const u32x4*)(ap[2] + kn); ra3 = *(const u32x4*)(ap[3] + kn);
            rb0 = *(const u32x4*)(bp[0] + kn);
            if (NI == 4) rb1 = *(const u32x4*)(bp[1] + kn);
        }
        mma_ktile<4, NI, TRANS>(acc, sA + wr * 64 * LDK, sB + wc * 16 * NI * LDK, lane);
    }
}

template <int NI>
DEVINL void zero_acc(f32x4 (&acc)[4][NI]) {
#pragma unroll
    for (int i = 0; i < 4; ++i)
#pragma unroll
        for (int j = 0; j < NI; ++j) acc[i][j] = (f32x4){0.f, 0.f, 0.f, 0.f};
}

struct WS {
    bf16_t *wgu, *wd, *wpg, *wpp, *win, *wo, *wq, *wkv, *wsb, *pb;
    float2* rowsc; float2* part; float* wrt; float2* cs; int* cnt; int* list; float* gatew; int* asgep; float *lat_ss, *a_ss, *g_ss;
    bf16_t *xb, *q, *x1b; bf16_t *u, *vln, *ao, *H, *x2b; bf16_t *latq, *latkv, *wkv2, *kr, *k, *vT, *go, *ymoe;
};
DEVINL WS make_ws(unsigned char* ws, float* out = nullptr) {
    WS s;
    s.vln = (bf16_t*)out;
    s.q = (bf16_t*)((unsigned char*)out + 16 * MiB);
    s.wgu = (bf16_t*)(ws + WS_WGU); s.wd = (bf16_t*)(ws + WS_WD); s.wpg = (bf16_t*)(ws + WS_WPG); s.wpp = (bf16_t*)(ws + WS_WPP);
    s.win = (bf16_t*)(ws + WS_WIN); s.wo = (bf16_t*)(ws + WS_WO); s.wq = (bf16_t*)(ws + WS_WQ); s.wkv = (bf16_t*)(ws + WS_WKV);
    s.wsb = (bf16_t*)(ws + WS_WS); s.wrt = (float*)(ws + WS_WRT); s.cs = (float2*)(ws + WS_CS); s.pb = (bf16_t*)(ws + WS_PB);
    s.rowsc = (float2*)(ws + WS_ROWSC); s.part = (float2*)(ws + WS_PART); s.cnt = (int*)(ws + WS_CNT); s.list = (int*)(ws + WS_LIST); s.gatew = (float*)(ws + WS_GATEW); s.asgep = (int*)(ws + WS_ASGEP);
    s.lat_ss = (float*)(ws + WS_LATSS); s.a_ss = (float*)(ws + WS_ASS); s.g_ss = (float*)(ws + WS_GSS);
    s.xb = (bf16_t*)(ws + WS_RA); s.x1b = s.xb;
    s.ao = (bf16_t*)(ws + WS_RB); s.u = s.ao + 512; s.go = s.u; s.H = s.ao; s.x2b = s.ao;
    s.latq = (bf16_t*)(ws + WS_RC); s.latkv = (bf16_t*)(ws + WS_RC + 8 * MiB); s.kr = (bf16_t*)(ws + WS_RC + 16 * MiB); s.k = (bf16_t*)(ws + WS_RC + 17 * MiB); s.wkv2 = (bf16_t*)(ws + WS_WKV2);
    s.vT = (bf16_t*)(ws + WS_RC + 33 * MiB); s.ymoe = s.latq;
    return s;
}

#define XB_TMO      128
#define XB_XCNT(j)  (256  + 64 * (j))
#define XB_XSUB(j)  (1280 + 64 * (j))
#define XB_XGEN(j)  (2304 + 64 * (j))
#define XB_TOP      3328
#define XB_TOPGEN   3392
#define XCD_BAR_WORDS 3456
#define XB_SPIN_CAP (1u << 24)
#ifndef LAS
#define LAS __attribute__((address_space(3)))
#endif
DEVINL unsigned xb_ld(unsigned* p) { return __hip_atomic_load(p, __ATOMIC_RELAXED, __HIP_MEMORY_SCOPE_AGENT); }
DEVINL unsigned xb_add(unsigned* p, unsigned v) { return __hip_atomic_fetch_add(p, v, __ATOMIC_RELAXED, __HIP_MEMORY_SCOPE_AGENT); }
DEVINL unsigned xb_xcc_id() { return (unsigned)__builtin_amdgcn_s_getreg((3 << 11) | 20) & 0xFu; }
#define XB_SPIN(cond, bar) do { unsigned _sp = 0; while (cond) { __builtin_amdgcn_s_sleep(1); \
    if ((++_sp & 255u) == 0u) { if (xb_ld(&(bar)[XB_TMO])) break; if (_sp > XB_SPIN_CAP) { atomicAdd(&(bar)[XB_TMO], 1u); break; } } } } while (0)
struct XcdBarrier { unsigned* bar; unsigned x; volatile LAS unsigned* st; };
DEVINL XcdBarrier xcd_barrier_post(unsigned* bar, volatile LAS unsigned* st) {
    XcdBarrier b; b.bar = bar; b.x = xb_xcc_id(); b.st = st;
    if (threadIdx.x == 0) (void)xb_add(&bar[XB_XCNT(b.x)], 1u);
    return b;
}
DEVINL void xcd_barrier_complete(unsigned* bar, unsigned x, unsigned& nloc, unsigned& nx) {
    const unsigned G = gridDim.x * gridDim.y * gridDim.z;
    unsigned sum, cnt, mine, sp = 0u;
    for (;;) {
        sum = 0u; cnt = 0u; mine = 0u;
#pragma unroll
        for (unsigned j = 0; j < 16; ++j) { const unsigned c = xb_ld(&bar[XB_XCNT(j)]); sum += c; cnt += (c > 0u) ? 1u : 0u; mine = (j == x) ? c : mine; }
        if (sum == G) break;
        __builtin_amdgcn_s_sleep(1);
        if ((++sp & 255u) == 0u) { if (xb_ld(&bar[XB_TMO])) break; if (sp > XB_SPIN_CAP) { atomicAdd(&bar[XB_TMO], 1u); break; } }
    }
    nloc = mine > 0u ? mine : 1u; nx = cnt > 0u ? cnt : 1u;
}
template <bool FIRST = false>
DEVINL void xcd_barrier(const XcdBarrier& b) {
    asm volatile("s_waitcnt vmcnt(0)" ::: "memory");
    __syncthreads();
    if (threadIdx.x == 0) {
        unsigned* bar = b.bar;
        const unsigned bx = xb_xcc_id();
        __builtin_amdgcn_s_waitcnt(0);
        unsigned nloc = b.st[0], nx = b.st[1];
        if (FIRST) { xcd_barrier_complete(bar, bx, nloc, nx); b.st[0] = nloc; b.st[1] = nx; }
        const unsigned old = xb_add(&bar[XB_XSUB(bx)], 1u);
        const unsigned gen = old / nloc;
        if (old + 1u == (gen + 1u) * nloc) {
            __builtin_amdgcn_fence(__ATOMIC_RELEASE, "agent");
            asm volatile("s_waitcnt vmcnt(0)" ::: "memory");
            const unsigned og = xb_add(&bar[XB_TOP], 1u);
            const unsigned tg = og / nx;
            if (og + 1u == (tg + 1u) * nx) xb_add(&bar[XB_TOPGEN], 1u);
            else XB_SPIN(xb_ld(&bar[XB_TOPGEN]) == tg, bar);
            __builtin_amdgcn_fence(__ATOMIC_ACQUIRE, "agent");
            xb_add(&bar[XB_XGEN(bx)], 1u);
            asm volatile("s_waitcnt vmcnt(0)" ::: "memory");
        } else {
            XB_SPIN(xb_ld(&bar[XB_XGEN(bx)]) == gen, bar);
            __builtin_amdgcn_fence(__ATOMIC_ACQUIRE, "agent");
            asm volatile("s_waitcnt vmcnt(0)" ::: "memory");
        }
    }
    __syncthreads();
}

DEVINL void st_wt8(void* p, uint2 v) { __hip_atomic_store((unsigned long long*)p, ((unsigned long long)v.y << 32) | v.x, __ATOMIC_RELAXED, __HIP_MEMORY_SCOPE_AGENT); }
DEVINL void group_sync(unsigned* cnt, unsigned target) {
    asm volatile("s_waitcnt vmcnt(0)" ::: "memory");
    __syncthreads();
    if (threadIdx.x == 0) {
        xb_add(cnt, 1u);
        unsigned sp = 0;
        while (xb_ld(cnt) < target) { __builtin_amdgcn_s_sleep(1); if (++sp > XB_SPIN_CAP) break; }
        __builtin_amdgcn_fence(__ATOMIC_ACQUIRE, "agent");
        asm volatile("s_waitcnt vmcnt(0)" ::: "memory");
    }
    __syncthreads();
}

#define LAS __attribute__((address_space(3)))
#ifndef E_SPLIT_V
#define E_SPLIT_V 12
#endif
#ifndef EPI2
#define EPI2 0
#endif
#ifndef P0_REP
#define P0_REP 1
#endif
#ifndef REP_P1
#define REP_P1 1
#endif
#ifndef REP_P4
#define REP_P4 1
#endif
#ifndef REP_P6
#define REP_P6 1
#endif
#ifndef REP_P7
#define REP_P7 1
#endif
#ifndef REP_P9
#define REP_P9 1
#endif
namespace pg8 {
constexpr int BK = 64, HALF = 128, HTB = HALF * BK * 2, STAGE_BYTES = 8 * HTB;
DEVINL int lds_byte(int r, int c) { const int st = (r >> 4) * 2 + (c >> 5), rr = r & 15, cc = c & 31, ob = rr * 64 + cc * 2; return st * 1024 + (ob ^ (((ob >> 9) & 1) << 5)); }
DEVINL void stage_rc(int b, int& R, int& C) { const int st = b / 1024, sb = b % 1024, swz = sb ^ (((sb >> 9) & 1) << 5); R = (st >> 1) * 16 + swz / 64; C = (st & 1) * 32 + (swz % 64) / 2; }
struct Unit { const char* A; const char* B; int a0, a1, a2, a3; };
template <int MIDT, bool FUSED, int EPIREP = 1, class Epi, class Sched>
DEVINL void gemm_phase(LAS unsigned char* lds, const Sched& S, const Epi& E, const int K, const int ldb) {
    int tid_ = threadIdx.x; asm volatile("" : "+v"(tid_));
    const int tid = tid_, wid = __builtin_amdgcn_readfirstlane(tid >> 6), lane = tid & 63, wr = wid >> 2, wc = wid & 3, fr = lane & 15, fq = lane >> 4;
    const int nt = K / BK;
    int RA[2], CA[2]; unsigned voffB[2];
#pragma unroll
    for (int i = 0; i < 2; ++i) { stage_rc(tid * 16 + i * 8192, RA[i], CA[i]); voffB[i] = (unsigned)(RA[i] * ldb + CA[i]) * 2u; }
    const size_t kstep = (size_t)(BK * 2);
    const size_t hstepB = (size_t)HALF * ldb * 2;
    const unsigned ldsw = (unsigned)wid * 1024u;
    const int aoff = lds_byte(wr * 64 + fr, fq * 8), boff = lds_byte(wc * 32 + fr, fq * 8);
#define PG8_SA(b, h) (((b) * 2 + (h)) * HTB)
#define PG8_SB(b, h) ((4 + (b) * 2 + (h)) * HTB)
#define PG8_STG(bufoff, gbase, v0, v1) do { \
        __builtin_amdgcn_global_load_lds((const unsigned*)((const char*)(gbase) + (v0)), (LAS unsigned*)(lds + (bufoff) + ldsw), 16, 0, 0); \
        __builtin_amdgcn_global_load_lds((const unsigned*)((const char*)(gbase) + (v1)), (LAS unsigned*)(lds + (bufoff) + ldsw + 8192), 16, 0, 0); } while (0)
#define PG8_STGB(bufoff, gbase) PG8_STG(bufoff, gbase, voffB[0], voffB[1])
#define PG8_LDA(dst, b, h) do { _Pragma("unroll") for (int m = 0; m < 4; ++m) _Pragma("unroll") for (int k = 0; k < 2; ++k) dst[m][k] = *(const LAS bf16x8*)(lds + PG8_SA(b, h) + aoff + m * 2048 + k * 1024); } while (0)
#define PG8_LDB(dst, b, h) do { _Pragma("unroll") for (int n = 0; n < 2; ++n) _Pragma("unroll") for (int k = 0; k < 2; ++k) dst[n][k] = *(const LAS bf16x8*)(lds + PG8_SB(b, h) + boff + n * 2048 + k * 1024); } while (0)
#define PG8_MMA(ai, bj, At, Bt) do { __builtin_amdgcn_s_setprio(1); _Pragma("unroll") for (int m = 0; m < 4; ++m) _Pragma("unroll") for (int n = 0; n < 2; ++n) _Pragma("unroll") for (int k = 0; k < 2; ++k) \
        acc[ai][bj][m][n] = __builtin_amdgcn_mfma_f32_16x16x32_bf16(Bt[n][k], At[m][k], acc[ai][bj][m][n], 0, 0, 0); __builtin_amdgcn_s_setprio(0); } while (0)
#define PG8_WAIT_V(n) asm volatile("s_waitcnt vmcnt(" #n ")" ::: "memory")
#define PG8_WAIT_L(n) asm volatile("s_waitcnt lgkmcnt(" #n ")" ::: "memory")
#define PG8_BAR __builtin_amdgcn_s_barrier()
#define PG8_SCHED __builtin_amdgcn_sched_barrier(0)
    Unit cur, nxt; int ui = 0;
    if (!S.next(0, cur)) return;
    f32x4 acc[2][2][4][2];
#pragma unroll
    for (int a = 0; a < 2; ++a)
#pragma unroll
        for (int b = 0; b < 2; ++b)
#pragma unroll
            for (int m = 0; m < 4; ++m)
#pragma unroll
                for (int n = 0; n < 2; ++n) acc[a][b][m][n] = (f32x4){0.f, 0.f, 0.f, 0.f};
    bf16x8 At[4][2], B0[2][2], B1[2][2];
    unsigned vc00, vc01, vc10, vc11, vn00, vn01, vn10, vn11;
    vc00 = S.arow(cur, RA[0]) + CA[0] * 2; vc01 = S.arow(cur, RA[1]) + CA[1] * 2;
    vc10 = S.arow(cur, 128 + RA[0]) + CA[0] * 2; vc11 = S.arow(cur, 128 + RA[1]) + CA[1] * 2;
    const char* cA = cur.A; const char* cB = cur.B;
    PG8_STGB(PG8_SB(0, 0), cB); PG8_STG(PG8_SA(0, 0), cA, vc00, vc01); PG8_STGB(PG8_SB(0, 1), cB + hstepB); PG8_STG(PG8_SA(0, 1), cA, vc10, vc11);
    if (wr == 1) PG8_BAR;
    PG8_WAIT_V(4); PG8_BAR;
    PG8_STGB(PG8_SB(1, 0), cB + kstep); PG8_STG(PG8_SA(1, 0), cA + kstep, vc00, vc01); PG8_STGB(PG8_SB(1, 1), cB + hstepB + kstep);
    PG8_WAIT_V(6); PG8_BAR;
    for (;;) {
        const bool has_next = S.next(ui + 1, nxt);
        const char* nA = has_next ? nxt.A : cA; const char* nB = has_next ? nxt.B : cB;
        if (has_next) {
            vn00 = S.arow(nxt, RA[0]) + CA[0] * 2; vn01 = S.arow(nxt, RA[1]) + CA[1] * 2;
            vn10 = S.arow(nxt, 128 + RA[0]) + CA[0] * 2; vn11 = S.arow(nxt, 128 + RA[1]) + CA[1] * 2;
        } else { vn00 = vc00; vn01 = vc01; vn10 = vc10; vn11 = vc11; }
#pragma nounroll
        for (int t = 0; t < nt; t += 2) {
            const bool last = (t == nt - 2);
            if (MIDT > 0 && t == MIDT) E.mid(acc, cur, wr, wc, fr, fq);
            const char* a1 = cA + (size_t)(t + 1) * kstep;
            const char* a2 = last ? nA : cA + (size_t)(t + 2) * kstep; const char* b2 = last ? nB : cB + (size_t)(t + 2) * kstep;
            const char* a3 = a2 + kstep; const char* b3 = b2 + kstep;
            const unsigned w00 = last ? vn00 : vc00, w01 = last ? vn01 : vc01, w10 = last ? vn10 : vc10, w11 = last ? vn11 : vc11;
            PG8_LDB(B0, 0, 0); PG8_SCHED; PG8_LDA(At, 0, 0); PG8_STG(PG8_SA(1, 1), a1, vc10, vc11);
            PG8_WAIT_L(8); PG8_BAR; PG8_WAIT_L(0); PG8_MMA(0, 0, At, B0); PG8_BAR; PG8_SCHED;
            PG8_LDB(B1, 0, 1); PG8_STGB(PG8_SB(0, 0), b2);
            PG8_BAR; PG8_WAIT_L(0); PG8_MMA(0, 1, At, B1); PG8_BAR;
            PG8_LDA(At, 0, 1); PG8_STG(PG8_SA(0, 0), a2, w00, w01);
            PG8_BAR; PG8_WAIT_L(0); PG8_MMA(1, 0, At, B0); PG8_BAR; PG8_SCHED;
            PG8_STGB(PG8_SB(0, 1), b2 + hstepB);
            PG8_WAIT_V(6); PG8_BAR; PG8_MMA(1, 1, At, B1); PG8_BAR;
            PG8_LDB(B0, 1, 0); PG8_SCHED; PG8_LDA(At, 1, 0); PG8_STG(PG8_SA(0, 1), a2, w10, w11);
            PG8_WAIT_L(8); PG8_BAR; PG8_WAIT_L(0); PG8_MMA(0, 0, At, B0); PG8_BAR; PG8_SCHED;
            PG8_LDB(B1, 1, 1); PG8_STGB(PG8_SB(1, 0), b3);
            PG8_BAR; PG8_WAIT_L(0); PG8_MMA(0, 1, At, B1); PG8_BAR;
            PG8_LDA(At, 1, 1); PG8_STG(PG8_SA(1, 0), a3, w00, w01);
            PG8_BAR; PG8_WAIT_L(0); PG8_MMA(1, 0, At, B0); PG8_BAR; PG8_SCHED;
            PG8_STGB(PG8_SB(1, 1), b3 + hstepB);
            PG8_WAIT_V(6); PG8_BAR; PG8_MMA(1, 1, At, B1); PG8_BAR;
        }
        if (!FUSED) { E(acc, cur, wr, wc, fr, fq); if (EPIREP > 1) { asm volatile("s_waitcnt vmcnt(0)" ::: "memory"); E(acc, cur, wr, wc, fr, fq); } }
        if (!has_next) break;
#pragma unroll
        for (int a = 0; a < 2; ++a)
#pragma unroll
            for (int b = 0; b < 2; ++b)
#pragma unroll
                for (int m = 0; m < 4; ++m)
#pragma unroll
                    for (int n = 0; n < 2; ++n) acc[a][b][m][n] = (f32x4){0.f, 0.f, 0.f, 0.f};
        cur = nxt; cA = nA; cB = nB; ++ui;
        vc00 = vn00; vc01 = vn01; vc10 = vn10; vc11 = vn11;
    }
    PG8_WAIT_V(0);
    if (wr == 0) PG8_BAR;
    PG8_BAR;
    if constexpr (FUSED) E.final(acc, cur, wr, wc, fr, fq, lds);
#undef PG8_SA
#undef PG8_SB
#undef PG8_STG
#undef PG8_STGB
#undef PG8_LDA
#undef PG8_LDB
#undef PG8_MMA
#undef PG8_WAIT_V
#undef PG8_WAIT_L
#undef PG8_BAR
#undef PG8_SCHED
}
struct DenseOrder {
    const char* A; const char* B; int lda, ldb, nM, nN, G, c, rep;
    DEVINL bool next(int i, Unit& u) const {
        const int nwg = nM * nN; const long L = (long)i * G + c; if (L >= (long)nwg * rep) return false;
        int wgid = (int)(L % nwg); { const int q = nwg / 8, r = nwg % 8, xcd = wgid % 8, off = wgid / 8; wgid = (xcd < r ? xcd * (q + 1) : r * (q + 1) + (xcd - r) * q) + off; }
        const int nig = 8 * nN, gid = wgid / nig, fm = gid * 8, gsz = (nM - fm) < 8 ? (nM - fm) : 8;
        const int pm = fm + ((wgid % nig) % gsz), pn = (wgid % nig) / gsz;
        u.A = A + (size_t)pm * 256 * lda * 2; u.B = B + (size_t)pn * 256 * ldb * 2; u.a0 = pm; u.a1 = pn; u.a2 = 0; u.a3 = 0; return true;
    }
    DEVINL unsigned arow(const Unit&, int r) const { return (unsigned)(r * lda) * 2u; }
};
}

DEVINL int drow_map(int mode, int n) {
    switch (mode) {
        case 1: {
            if (n < 256) return n;
            if (n < 384) return 256 + (n - 256);
            if (n < 416) return 384 + (n - 384);
            if (n < 928) return 512 + (n - 416);
            const int c = n - 928, gq = c >> 6, ch = c & 63;
            return 1024 + (gq >> 2) * 256 + 128 * (ch >> 5) + 32 * (gq & 3) + (ch & 31);
        }
        case 2: { const int h = n / 96, d = n - h * 96; return d < 64 ? h * 64 + d : 512 + h * 32 + (d - 64); }
        case 5: { const int h = n >> 7, d = n & 127; return d < 64 ? h * 64 + d : 512 + h * 64 + (d - 64); }
        case 3: return (n >> 4) * 32 + (n & 15);
        case 4: return (n >> 4) * 32 + 16 + (n & 15);
        default: return n;
    }
}
DEVINL void tr_tile(const float* __restrict__ src, int ld_s, int k0, int n0, int Nlim, bf16_t* __restrict__ dst, int ld_d,
                    const float* __restrict__ gain, int mode, float* smf) {
    int t = threadIdx.x; asm volatile("" : "+v"(t));
    __syncthreads();
#pragma unroll
    for (int i = 0; i < 2; ++i) {
        const int c = t + NTHR * i, r = c >> 4, c4 = (c & 15) * 4, n = n0 + c4;
        float4 v = make_float4(0.f, 0.f, 0.f, 0.f);
        if (n < Nlim) { const f32x4 t4 = __builtin_nontemporal_load((const f32x4*)(src + (size_t)(k0 + r) * ld_s + n)); v = make_float4(t4[0], t4[1], t4[2], t4[3]); }
        const float g = gain ? gain[k0 + r] : 1.f;
        smf[r * 65 + c4 + 0] = v.x * g; smf[r * 65 + c4 + 1] = v.y * g; smf[r * 65 + c4 + 2] = v.z * g; smf[r * 65 + c4 + 3] = v.w * g;
    }
    __syncthreads();
    {
        const int c = t, nn = c >> 3, kc = (c & 7) * 8, n = n0 + nn;
        if (n < Nlim) {
            float e[8];
#pragma unroll
            for (int j = 0; j < 8; ++j) e[j] = smf[(kc + j) * 65 + nn];
            uint4 o; o.x = pack2(e[0], e[1]); o.y = pack2(e[2], e[3]); o.z = pack2(e[4], e[5]); o.w = pack2(e[6], e[7]);
            *(uint4*)(dst + (size_t)drow_map(mode, n) * ld_d + k0 + kc) = o;
        }
    }
}

DEVINL void cvt8(const float* __restrict__ s, bf16_t* __restrict__ d) {
    const f32x4 a4 = __builtin_nontemporal_load((const f32x4*)s), b4 = __builtin_nontemporal_load((const f32x4*)(s + 4));
    const float4 a = make_float4(a4[0], a4[1], a4[2], a4[3]), b = make_float4(b4[0], b4[1], b4[2], b4[3]);
    uint4 o; o.x = pack2(a.x, a.y); o.y = pack2(a.z, a.w); o.z = pack2(b.x, b.y); o.w = pack2(b.z, b.w);
    *(uint4*)d = o;
}

constexpr int E_SPLIT = E_SPLIT_V;
DEVINL void conv_gateup_tile(const Params& p, const WS& s, int v, float* smf) {
    const int e = v >> 8, r = v & 255, up = r >> 7, q = r & 127, kt = q >> 3, nt = q & 7;
    tr_tile((up ? p.w_up : p.w_gate) + (size_t)e * 1024 * 512, 512, kt * 64, nt * 64, 512, s.wgu + (size_t)e * 1024 * 1024, 1024, nullptr, up ? 4 : 3, smf);
}
DEVINL void conv_down_tile(const Params& p, const WS& s, int v, float* smf) {
    const int e = v >> 7, r = v & 127, kt = r >> 4, nt = r & 15;
    tr_tile(p.w_down + (size_t)e * 512 * 1024, 1024, kt * 64, nt * 64, 1024, s.wd + (size_t)e * 1024 * 512, 512, nullptr, 0, smf);
}
DEVINL void conv_expert_tiles(const Params& p, const WS& s, int kind, int first, int last, int stride, float* smf) {
    if (first >= last) return;
    int t = threadIdx.x; asm volatile("" : "+v"(t));
    const int lr = t >> 4, lc4 = (t & 15) * 4;
    const int nn = t >> 3, kc = (t & 7) * 8;
    float4 r0, r1; const float* src; int ld_s; bf16_t* dst; int ld_d, mode, k0, n0;
#define CET_DECODE(v) do { if (kind == 0) { const int e_ = (v) >> 8, r_ = (v) & 255, up_ = r_ >> 7, q_ = r_ & 127; k0 = (q_ >> 3) * 64; n0 = (q_ & 7) * 64; \
            src = (up_ ? p.w_up : p.w_gate) + (size_t)e_ * 1024 * 512; ld_s = 512; dst = s.wgu + (size_t)e_ * 1024 * 1024; ld_d = 1024; mode = up_ ? 4 : 3; } \
        else { const int e_ = (v) >> 7, r_ = (v) & 127; k0 = (r_ >> 4) * 64; n0 = (r_ & 15) * 64; src = p.w_down + (size_t)e_ * 512 * 1024; ld_s = 1024; dst = s.wd + (size_t)e_ * 1024 * 512; ld_d = 512; mode = 0; } } while (0)
#define CET_LOAD() do { const f32x4 t0_ = __builtin_nontemporal_load((const f32x4*)(src + (size_t)(k0 + lr) * ld_s + n0 + lc4)), t1_ = __builtin_nontemporal_load((const f32x4*)(src + (size_t)(k0 + lr + 32) * ld_s + n0 + lc4)); \
        r0 = make_float4(t0_[0], t0_[1], t0_[2], t0_[3]); r1 = make_float4(t1_[0], t1_[1], t1_[2], t1_[3]); } while (0)
    CET_DECODE(first); CET_LOAD();
    __syncthreads();
    int buf = 0;
    for (int v = first; v < last; v += stride) {
        float* sm = smf + buf * (64 * 65);
        sm[lr * 65 + lc4 + 0] = r0.x; sm[lr * 65 + lc4 + 1] = r0.y; sm[lr * 65 + lc4 + 2] = r0.z; sm[lr * 65 + lc4 + 3] = r0.w;
        sm[(lr + 32) * 65 + lc4 + 0] = r1.x; sm[(lr + 32) * 65 + lc4 + 1] = r1.y; sm[(lr + 32) * 65 + lc4 + 2] = r1.z; sm[(lr + 32) * 65 + lc4 + 3] = r1.w;
        bf16_t* dcur = dst; const int ldc = ld_d, mcur = mode, kcur = k0, ncur = n0;
        if (v + stride < last) { CET_DECODE(v + stride); CET_LOAD(); }
        __syncthreads();
        float e[8];
#pragma unroll
        for (int j = 0; j < 8; ++j) e[j] = sm[(kc + j) * 65 + nn];
        uint4 o; o.x = pack2(e[0], e[1]); o.y = pack2(e[2], e[3]); o.z = pack2(e[4], e[5]); o.w = pack2(e[6], e[7]);
        __builtin_nontemporal_store((u32x4){o.x, o.y, o.z, o.w}, (u32x4*)(dcur + (size_t)drow_map(mcur, ncur + nn) * ldc + kcur + kc));
        buf ^= 1;
    }
    __syncthreads();
#undef CET_DECODE
#undef CET_LOAD
}
DEVINL void helper_slot(int U, int G, int c, int& j, int& nh) {
    const int R = (U + G - 1) / G, nidle = R * G - U;
    if (nidle >= 64) { nh = nidle; j = c - (G - nidle); } else { nh = G; j = c; }
}
__device__ void phase0(const Params& p, unsigned char* smem) {
    const WS s = make_ws(p.ws, p.out);
    const int G = gridDim.x, bid = blockIdx.x, t = threadIdx.x;
    const size_t gtid = (size_t)bid * NTHR + t, gstride = (size_t)G * NTHR;
    for (size_t i0 = gtid; i0 < (size_t)T_ * D_ / 8 * P0_REP; i0 += gstride) { const size_t i = i0 % ((size_t)T_ * D_ / 8); cvt8(p.x + i * 8, s.xb + i * 8); }
    for (size_t i = gtid; i < 8 * 128 * 128 / 8; i += gstride) {
        const int e0 = (int)i * 8, tt = (e0 >> 7) & 127, s0 = e0 & 127;
        float v[8];
#pragma unroll
        for (int j = 0; j < 8; ++j) v[j] = (s0 + j <= tt) ? p.gm_w_s[e0 + j] : 0.f;
        uint4 o; o.x = pack2(v[0], v[1]); o.y = pack2(v[2], v[3]); o.z = pack2(v[4], v[5]); o.w = pack2(v[6], v[7]);
        *(uint4*)(s.wsb + e0) = o;
    }
    for (size_t i = gtid; i < 48 * 1024; i += gstride) {
        const int n = (int)i >> 10, k = (int)i & 1023;
        s.wrt[i] = n < 4 ? p.w_rg[k * 4 + n] : (n < 36 ? p.w_re[k * 32 + (n - 4)] : 0.f);
    }
    for (size_t i = gtid; i < (size_t)T_ * 16; i += gstride) {
        const int tok = (int)(i >> 4), j = (int)i & 15;
        const float ang = (float)p.pos[tok] * p.inv_freq[j];
        float sn, cs; sincosf(ang, &sn, &cs);
        s.cs[i] = make_float2(cs, sn);
    }
    for (size_t i = gtid; i < 96 * 1024 / 8; i += gstride) *(uint4*)(s.win + 416 * 1024 + i * 8) = make_uint4(0, 0, 0, 0);
    if (bid == 0 && t < 32) s.cnt[t * 64] = 0;
    for (size_t i = gtid; i < 1024 * 16; i += gstride) *(uint4*)(s.wkv2 + (i >> 4) * 256 + 128 + (i & 15) * 8) = make_uint4(0, 0, 0, 0);
    for (size_t i = gtid; i < (size_t)T_ * 16; i += gstride) *(uint4*)(s.latkv + (i >> 4) * 256 + 128 + (i & 15) * 8) = make_uint4(0, 0, 0, 0);
    float* smf = (float*)smem;
    constexpr int J0 = 368, J1 = J0 + 48, J2 = J1 + 32, J3 = J2 + 256, J4 = J3 + 256, J5 = J4 + 64, J6 = J5;
    for (int u0 = bid; u0 < J6 * P0_REP; u0 += G) {
        const int u = u0 % J6;
        if (u < J0) { const int kt = u / 23, nt = u % 23; tr_tile(p.w_in, 1440, kt * 64, nt * 64, 1440, s.win, 1024, nullptr, 1, smf); }
        else if (u < J1) { const int v = u - J0, kt = v / 12, nt = v % 12; tr_tile(p.w_q_up, 768, kt * 64, nt * 64, 768, s.wq, 256, p.q_norm_g, 2, smf); }
        else if (u < J2) { const int v = u - J1, kt = v / 16, nt = v % 16; tr_tile(p.w_kv_up, 1024, kt * 64, nt * 64, 1024, s.wkv2, 256, p.kv_norm_g, 5, smf); }
        else if (u < J3) { const int v = u - J2, kt = v / 16, nt = v % 16; tr_tile(p.w_o, 1024, kt * 64, nt * 64, 1024, s.wo, 1024, kt < 8 ? p.mla_out_g : p.gm_out_g - 512, 0, smf); }
        else if (u < J4) { const int v = u - J3, kt = v / 16, nt = v % 16; tr_tile(p.w_pg, 1024, kt * 64, nt * 64, 1024, s.wpg, 1024, nullptr, 0, smf); }
        else if (u < J5) { const int v = u - J4, kt = v / 16, nt = v % 16; tr_tile(p.w_pp, 1024, kt * 64, nt * 64, 1024, s.wpp, 256, nullptr, 0, smf); }
    }
    conv_expert_tiles(p, s, 0, bid, E_SPLIT * 256, G, smf);
}

struct EpiP1 {
    const Params* p; WS s;
    DEVINL void mid(f32x4 (&)[2][2][4][2], const pg8::Unit&, int, int, int, int) const {}
    DEVINL void operator()(const f32x4 (&acc)[2][2][4][2], const pg8::Unit& u, int wr, int wc, int fr, int fq) const {
        const int pm = u.a0, pn = u.a1;
#pragma unroll
        for (int ai = 0; ai < 2; ++ai)
#pragma unroll
            for (int m = 0; m < 4; ++m) {
                const int row = pm * 256 + ai * 128 + wr * 64 + m * 16 + fr;
                if (pn == 0) {
                    float ss = 0.f;
#pragma unroll
                    for (int bj = 0; bj < 2; ++bj)
#pragma unroll
                        for (int n = 0; n < 2; ++n) { const f32x4 v = acc[ai][bj][m][n]; ss += v[0] * v[0] + v[1] * v[1] + v[2] * v[2] + v[3] * v[3];
                            *(uint2*)(s.latq + (size_t)row * 256 + bj * 128 + wc * 32 + n * 16 + fq * 4) = pack4v(v); }
                    ss += __shfl_xor(ss, 16); ss += __shfl_xor(ss, 32);
                    if (fq == 0) s.lat_ss[row * 8 + wc] = ss;
                } else if (pn == 1) {
                    float ss = 0.f;
#pragma unroll
                    for (int n = 0; n < 2; ++n) { const f32x4 v = acc[ai][0][m][n]; ss += v[0] * v[0] + v[1] * v[1] + v[2] * v[2] + v[3] * v[3];
                        *(uint2*)(s.latkv + (size_t)row * 256 + wc * 32 + n * 16 + fq * 4) = pack4v(v); }
                    ss += __shfl_xor(ss, 16); ss += __shfl_xor(ss, 32);
                    if (fq == 0) s.lat_ss[row * 8 + 4 + wc] = ss;
                    if (wc == 0) {
                        float o1[4], o2[4];
#pragma unroll
                        for (int r = 0; r < 4; ++r) {
                            const float2 c = s.cs[row * 16 + fq * 4 + r];
                            const float x1 = acc[ai][1][m][0][r], x2 = acc[ai][1][m][1][r];
                            o1[r] = x1 * c.x - x2 * c.y; o2[r] = x1 * c.y + x2 * c.x;
                        }
                        *(uint2*)(s.kr + (size_t)row * 32 + fq * 4) = pack4(o1[0], o1[1], o1[2], o1[3]);
                        *(uint2*)(s.kr + (size_t)row * 32 + 16 + fq * 4) = pack4(o2[0], o2[1], o2[2], o2[3]);
                    }
                } else if (pn < 4) {
#pragma unroll
                    for (int bj = 0; bj < 2; ++bj)
#pragma unroll
                        for (int n = 0; n < 2; ++n) { const f32x4 v = acc[ai][bj][m][n];
                            *(uint2*)(s.u + (size_t)row * 1024 + (pn - 2) * 256 + bj * 128 + wc * 32 + n * 16 + fq * 4) = pack4(gelu_tanh(v[0]), gelu_tanh(v[1]), gelu_tanh(v[2]), gelu_tanh(v[3])); }
                } else {
                    float gv[2][2][4]; float sum = 0.f;
#pragma unroll
                    for (int bj = 0; bj < 2; ++bj)
#pragma unroll
                        for (int n = 0; n < 2; ++n)
#pragma unroll
                            for (int r = 0; r < 4; ++r) { gv[bj][n][r] = gelu_tanh(acc[ai][bj][m][n][r]); sum += gv[bj][n][r]; }
                    sum += __shfl_xor(sum, 16); sum += __shfl_xor(sum, 32);
                    const float mean = sum * (1.f / 64.f); float sq = 0.f;
#pragma unroll
                    for (int bj = 0; bj < 2; ++bj)
#pragma unroll
                        for (int n = 0; n < 2; ++n)
#pragma unroll
                            for (int r = 0; r < 4; ++r) { const float d = gv[bj][n][r] - mean; sq += d * d; }
                    sq += __shfl_xor(sq, 16); sq += __shfl_xor(sq, 32);
                    const float rstd = rsqrtf(sq * (1.f / 64.f) + EPS_);
                    const int g = (pn - 4) * 4 + wc;
#pragma unroll
                    for (int bj = 0; bj < 2; ++bj)
#pragma unroll
                        for (int n = 0; n < 2; ++n) {
                            const int ch = g * 64 + bj * 32 + n * 16 + fq * 4;
                            const float4 gg = *(const float4*)(p->gm_ln_g + ch), bb = *(const float4*)(p->gm_ln_b + ch);
                            *(uint2*)(s.vln + (size_t)row * 512 + ch) = pack4((gv[bj][n][0] - mean) * rstd * gg.x + bb.x, (gv[bj][n][1] - mean) * rstd * gg.y + bb.y,
                                                                             (gv[bj][n][2] - mean) * rstd * gg.z + bb.z, (gv[bj][n][3] - mean) * rstd * gg.w + bb.w);
                        }
                }
            }
    }
};
__device__ void phase1(const Params& p, unsigned char* smem) {
    const WS s = make_ws(p.ws, p.out);
    pg8::DenseOrder S{(const char*)s.xb, (const char*)s.win, 1024, 1024, 64, 6, (int)gridDim.x, (int)blockIdx.x, REP_P1};
    EpiP1 E{&p, s};
    pg8::gemm_phase<0, false, (EPI2 == 1 ? 2 : 1)>((LAS unsigned char*)smem, S, E, 1024, 1024);
    int j, nh; helper_slot(64 * 6 * REP_P1, (int)gridDim.x, (int)blockIdx.x, j, nh);
    if (j >= 0) conv_expert_tiles(p, s, 0, E_SPLIT * 256 + j, 32 * 256, nh, (float*)smem);
}

constexpr float QSCALE_ = 0.10206207261596577f * 1.4426950408889634f;
struct P2Order {
    const char *latq, *latkv, *wq, *wkv2; int G, c;
    DEVINL bool next(int i, pg8::Unit& u) const {
        const int L = i * G + c; if (L >= 448) return false;
        if (L < 192) { const int pm = L / 3, pn = L - pm * 3; u.A = latq + (size_t)pm * 256 * 512; u.B = wq + (size_t)pn * 256 * 512; u.a0 = pm; u.a1 = pn; u.a2 = 0; }
        else if (L < 320) { const int v = L - 192, pm = v >> 1, pn = v & 1; u.A = latkv + (size_t)pm * 256 * 512; u.B = wkv2 + (size_t)pn * 256 * 512; u.a0 = pm; u.a1 = pn; u.a2 = 1; }
        else { const int v = L - 320, pn = v >> 1, pm = v & 1; u.A = wkv2 + (size_t)(512 + pm * 256) * 512; u.B = latkv + (size_t)pn * 256 * 512; u.a0 = pm; u.a1 = pn; u.a2 = 2; }
        u.a3 = 0; return true;
    }
    DEVINL unsigned arow(const pg8::Unit&, int r) const { return (unsigned)r * 512u; }
};
struct EpiP2 {
    WS s;
    DEVINL void mid(f32x4 (&)[2][2][4][2], const pg8::Unit&, int, int, int, int) const {}
    DEVINL void operator()(const f32x4 (&acc)[2][2][4][2], const pg8::Unit& u, int wr, int wc, int fr, int fq) const {
        if (u.a2 < 2) {
            float rstd[2][4];
#pragma unroll
            for (int ai = 0; ai < 2; ++ai)
#pragma unroll
                for (int m = 0; m < 4; ++m) {
                    const int row = u.a0 * 256 + ai * 128 + wr * 64 + m * 16 + fr;
                    const float4 ssv = *(const float4*)(s.lat_ss + row * 8 + (u.a2 ? 4 : 0));
                    rstd[ai][m] = u.a2 ? rsqrtf((ssv.x + ssv.y + ssv.z + ssv.w) * (1.f / 128.f) + EPS_)
                                       : rsqrtf((ssv.x + ssv.y + ssv.z + ssv.w) * (1.f / 256.f) + EPS_) * QSCALE_;
                }
            if (u.a2 == 1) {
#pragma unroll
                for (int ai = 0; ai < 2; ++ai)
#pragma unroll
                    for (int m = 0; m < 4; ++m) {
                        const int row = u.a0 * 256 + ai * 128 + wr * 64 + m * 16 + fr;
#pragma unroll
                        for (int bj = 0; bj < 2; ++bj)
#pragma unroll
                            for (int n = 0; n < 2; ++n) {
                                const int col = u.a1 * 256 + bj * 128 + wc * 32 + n * 16 + fq * 4;
                                *(uint2*)(s.k + ((size_t)row * 8 + (col >> 6)) * 64 + (col & 63)) = pack4v(acc[ai][bj][m][n] * rstd[ai][m]);
                            }
                    }
            } else if (u.a1 < 2) {
#pragma unroll
                for (int ai = 0; ai < 2; ++ai)
#pragma unroll
                    for (int m = 0; m < 4; ++m) {
                        const int row = u.a0 * 256 + ai * 128 + wr * 64 + m * 16 + fr;
#pragma unroll
                        for (int bj = 0; bj < 2; ++bj)
#pragma unroll
                            for (int n = 0; n < 2; ++n) {
                                const int col = u.a1 * 256 + bj * 128 + wc * 32 + n * 16 + fq * 4;
                                *(uint2*)(s.q + ((size_t)row * 8 + (col >> 6)) * 96 + (col & 63)) = pack4v(acc[ai][bj][m][n] * rstd[ai][m]);
                            }
                    }
            } else {
#pragma unroll
                for (int ai = 0; ai < 2; ++ai)
#pragma unroll
                    for (int m = 0; m < 4; ++m) {
                        const int row = u.a0 * 256 + ai * 128 + wr * 64 + m * 16 + fr;
                        const float4 c01 = *(const float4*)(s.cs + row * 16 + fq * 4), c23 = *(const float4*)(s.cs + row * 16 + fq * 4 + 2);
                        const float2 csr[4] = {make_float2(c01.x, c01.y), make_float2(c01.z, c01.w), make_float2(c23.x, c23.y), make_float2(c23.z, c23.w)};
#pragma unroll
                        for (int bj = 0; bj < 2; ++bj) {
                            const int h = bj * 4 + wc; float o1[4], o2[4];
#pragma unroll
                            for (int r = 0; r < 4; ++r) {
                                const float2 c = csr[r];
                                const float x1 = acc[ai][bj][m][0][r] * rstd[ai][m], x2 = acc[ai][bj][m][1][r] * rstd[ai][m];
                                o1[r] = x1 * c.x - x2 * c.y; o2[r] = x1 * c.y + x2 * c.x;
                            }
                            *(uint2*)(s.q + ((size_t)row * 8 + h) * 96 + 64 + fq * 4) = pack4(o1[0], o1[1], o1[2], o1[3]);
                            *(uint2*)(s.q + ((size_t)row * 8 + h) * 96 + 80 + fq * 4) = pack4(o2[0], o2[1], o2[2], o2[3]);
                        }
                    }
            }
        } else {
            f32x4 rs[2][2];
#pragma unroll
            for (int bj = 0; bj < 2; ++bj)
#pragma unroll
                for (int n = 0; n < 2; ++n) {
                    const int tok = u.a1 * 256 + bj * 128 + wc * 32 + n * 16 + fq * 4;
#pragma unroll
                    for (int j = 0; j < 4; ++j) { const float4 kv4 = *(const float4*)(s.lat_ss + (tok + j) * 8 + 4); rs[bj][n][j] = rsqrtf((kv4.x + kv4.y + kv4.z + kv4.w) * (1.f / 128.f) + EPS_); }
                }
#pragma unroll
            for (int bj = 0; bj < 2; ++bj)
#pragma unroll
                for (int n = 0; n < 2; ++n) {
                    const int tok = u.a1 * 256 + bj * 128 + wc * 32 + n * 16 + fq * 4;
                    const int b = tok >> 11, sq = tok & 2047;
#pragma unroll
                    for (int ai = 0; ai < 2; ++ai)
#pragma unroll
                        for (int m = 0; m < 4; ++m) {
                            const int ch = u.a0 * 256 + ai * 128 + wr * 64 + m * 16 + fr;
                            *(uint2*)(s.vT + ((size_t)(b * 512 + ch)) * 2048 + sq) = pack4v(acc[ai][bj][m][n] * rs[bj][n]);
                        }
                }
        }
    }
};
__device__ void gmlp_phase(const Params& p, const WS& s, bf16_t* smem) {
    constexpr int LDG = 136;
    int t = threadIdx.x; asm volatile("" : "+v"(t));
    const int lane = t & 63, w = t >> 6, r16 = lane & 15, g4 = (lane >> 4) * 4, kg = (lane >> 4) * 8;
    const int G = gridDim.x;
    int u = blockIdx.x;
    if (u >= 1024) return;
    u32x4 ra0, ra1, ra2, ra3, rb0, rb1; uint2 ru0, ru1, ru2, ru3, cu0, cu1, cu2, cu3;
#define GM_LOAD(uu) do { const int cidx_ = (uu) >> 3, g_ = (uu) & 7, tok0_ = cidx_ * 128; \
        const bf16_t* wp_ = s.wsb + ((size_t)g_ * 128 + (t >> 4)) * 128 + (t & 15) * 8; \
        ra0 = *(const u32x4*)(wp_); ra1 = *(const u32x4*)(wp_ + 32 * 128); ra2 = *(const u32x4*)(wp_ + 64 * 128); ra3 = *(const u32x4*)(wp_ + 96 * 128); \
        const bf16_t* vp_ = s.vln + (size_t)(tok0_ + 2 * lane) * 512 + g_ * 64 + w * 8; \
        rb0 = *(const u32x4*)(vp_); rb1 = *(const u32x4*)(vp_ + 512); \
        const bf16_t* up_ = s.u + (size_t)(tok0_ + w * 16 + r16) * 1024 + g_ * 64 + g4; \
        ru0 = *(const uint2*)(up_); ru1 = *(const uint2*)(up_ + 16); ru2 = *(const uint2*)(up_ + 32); ru3 = *(const uint2*)(up_ + 48); } while (0)
#define GM_STORE(buf) do { bf16_t* sA_ = smem + (buf) * (192 * LDG); bf16_t* sB_ = sA_ + 128 * LDG; \
        bf16_t* ad_ = sA_ + (t >> 4) * LDG + (t & 15) * 8; \
        *(u32x4*)(ad_) = ra0; *(u32x4*)(ad_ + 32 * LDG) = ra1; *(u32x4*)(ad_ + 64 * LDG) = ra2; *(u32x4*)(ad_ + 96 * LDG) = ra3; \
        unsigned* bd_ = (unsigned*)(sB_ + (w * 8) * LDG + 2 * lane); \
        bd_[0 * (LDG / 2)] = (rb0[0] & 0xffffu) | (rb1[0] << 16); bd_[1 * (LDG / 2)] = (rb0[0] >> 16) | (rb1[0] & 0xffff0000u); \
        bd_[2 * (LDG / 2)] = (rb0[1] & 0xffffu) | (rb1[1] << 16); bd_[3 * (LDG / 2)] = (rb0[1] >> 16) | (rb1[1] & 0xffff0000u); \
        bd_[4 * (LDG / 2)] = (rb0[2] & 0xffffu) | (rb1[2] << 16); bd_[5 * (LDG / 2)] = (rb0[2] >> 16) | (rb1[2] & 0xffff0000u); \
        bd_[6 * (LDG / 2)] = (rb0[3] & 0xffffu) | (rb1[3] << 16); bd_[7 * (LDG / 2)] = (rb0[3] >> 16) | (rb1[3] & 0xffff0000u); } while (0)
    __syncthreads();
    GM_LOAD(u);
    GM_STORE(0);
    cu0 = ru0; cu1 = ru1; cu2 = ru2; cu3 = ru3;
    __syncthreads();
    int cur = 0;
#pragma nounroll
    for (;;) {
        const int un = u + G; const bool has_next = un < 1024;
        if (has_next) GM_LOAD(un);
        const bf16_t* sA = smem + cur * (192 * LDG); const bf16_t* sB = sA + 128 * LDG;
        f32x4 acc[4];
#pragma unroll
        for (int j = 0; j < 4; ++j) acc[j] = (f32x4){0.f, 0.f, 0.f, 0.f};
#pragma unroll
        for (int ks = 0; ks < 4; ++ks) {
            const bf16x8 af = *(const bf16x8*)(sA + (w * 16 + r16) * LDG + ks * 32 + kg);
#pragma unroll
            for (int ni = 0; ni < 4; ++ni) {
                const bf16x8 bfr = *(const bf16x8*)(sB + (ni * 16 + r16) * LDG + ks * 32 + kg);
                acc[ni] = __builtin_amdgcn_mfma_f32_16x16x32_bf16(bfr, af, acc[ni], 0, 0, 0);
            }
        }
        {
            const int cidx = u >> 3, g = u & 7, tt = w * 16 + r16, tok = cidx * 128 + tt;
            const float bias = p.gm_b_s[g * 128 + tt]; float ss = 0.f;
            const uint2 uu[4] = {cu0, cu1, cu2, cu3};
#pragma unroll
            for (int ni = 0; ni < 4; ++ni) {
                const f32x4 a = acc[ni];
                const float v0 = bflo(uu[ni].x) * (a[0] + bias), v1 = bfhi(uu[ni].x) * (a[1] + bias), v2 = bflo(uu[ni].y) * (a[2] + bias), v3 = bfhi(uu[ni].y) * (a[3] + bias);
                ss += v0 * v0 + v1 * v1 + v2 * v2 + v3 * v3;
                *(uint2*)(s.go + (size_t)tok * 1024 + g * 64 + ni * 16 + g4) = pack4(v0, v1, v2, v3);
            }
            ss += __shfl_xor(ss, 16); ss += __shfl_xor(ss, 32);
            if (lane < 16) s.g_ss[tok * 8 + g] = ss;
        }
        if (!has_next) break;
        GM_STORE(cur ^ 1);
        cu0 = ru0; cu1 = ru1; cu2 = ru2; cu3 = ru3;
        __syncthreads();
        cur ^= 1; u = un;
    }
#undef GM_LOAD
#undef GM_STORE
}
__device__ void phase2(const Params& p, unsigned char* smem, bool do_gmlp = true) {
    const WS s = make_ws(p.ws, p.out);
    {
        P2Order S{(const char*)s.latq, (const char*)s.latkv, (const char*)s.wq, (const char*)s.wkv2, (int)gridDim.x, (int)blockIdx.x};
        EpiP2 E{s};
        pg8::gemm_phase<0, false>((LAS unsigned char*)smem, S, E, 256, 256);
    }
    if (do_gmlp) gmlp_phase(p, s, (bf16_t*)smem);
}

DEVINL float quad_max(float x) {
    const unsigned u = __float_as_uint(x);
    const auto r = __builtin_amdgcn_permlane16_swap(u, u, false, false);
    const float m = fmaxf(__uint_as_float(r[0]), __uint_as_float(r[1]));
    const unsigned v = __float_as_uint(m);
    const auto q = __builtin_amdgcn_permlane32_swap(v, v, false, false);
    return fmaxf(__uint_as_float(q[0]), __uint_as_float(q[1]));
}
DEVINL bf16x8 as_bf16x8(u32x4 v) { return __builtin_bit_cast(bf16x8, v); }
__device__ void attn_unit(const WS& s, int b, int h, int qb, bf16_t* smem) {
    constexpr int LK = 104, LV = 72;
    const int t = threadIdx.x, lane = t & 63, w = t >> 6, r16 = lane & 15, g = lane >> 4, kg = g * 8;
    const int q0 = qb * 256, tokb = b * 2048, qw0 = q0 + w * 32;
    bf16x8 qf[2][3];
#pragma unroll
    for (int ni = 0; ni < 2; ++ni)
#pragma unroll
        for (int ks = 0; ks < 3; ++ks)
            qf[ni][ks] = *(const bf16x8*)(s.q + ((size_t)(tokb + qw0 + ni * 16 + r16) * 8 + h) * 96 + ks * 32 + kg);
    f32x4 accO[4][2];
#pragma unroll
    for (int i = 0; i < 4; ++i)
#pragma unroll
        for (int j = 0; j < 2; ++j) accO[i][j] = (f32x4){0.f, 0.f, 0.f, 0.f};
    float mrow[2] = {-1e30f, -1e30f};
    f32x4 accL[2] = {(f32x4){0.f, 0.f, 0.f, 0.f}, (f32x4){0.f, 0.f, 0.f, 0.f}};
    const unsigned one2 = (r16 == 0) ? 0x3f803f80u : 0u;
    const bf16x8 vones = as_bf16x8((u32x4){one2, one2, one2, one2});
    const int nt = 4 * (qb + 1);
    const bf16_t* kp0; const bf16_t* kp1; int ks0, ks1, kd0, kd1;
    const bool k2 = t < 256;
    {
        int c = t, row = c / 12, part = c - row * 12;
        kp0 = part < 8 ? s.k + ((size_t)(tokb + row) * 8 + h) * 64 + part * 8 : s.kr + (size_t)(tokb + row) * 32 + (part - 8) * 8; ks0 = part < 8 ? 512 : 32; kd0 = row * LK + part * 8;
        c = k2 ? t + 512 : t; row = c / 12; part = c - row * 12;
        kp1 = part < 8 ? s.k + ((size_t)(tokb + row) * 8 + h) * 64 + part * 8 : s.kr + (size_t)(tokb + row) * 32 + (part - 8) * 8; ks1 = part < 8 ? 512 : 32; kd1 = row * LK + part * 8;
    }
    const int vrow = t >> 3, vkc = (t & 7) * 8;
    const bf16_t* vp0 = s.vT + ((size_t)((b * 8 + h) * 64 + vrow)) * 2048 + vkc;
    u32x4 rk0, rk1, rv0;
    rk0 = *(const u32x4*)kp0; rk1 = *(const u32x4*)kp1; rv0 = *(const u32x4*)vp0;
    constexpr int STG = 64 * LK + 64 * LV;
    __syncthreads();
    *(u32x4*)(smem + kd0) = rk0; if (k2) *(u32x4*)(smem + kd1) = rk1;
    *(u32x4*)(smem + 64 * LK + vrow * LV + vkc) = rv0;
    __syncthreads();
#pragma nounroll
    for (int kt = 0; kt < nt; ++kt) {
        const bf16_t* sK = smem + (kt & 1) * STG; const bf16_t* sV = sK + 64 * LK;
        if (kt + 1 < nt) {
            const int kn = (kt + 1) * 64;
            rk0 = *(const u32x4*)(kp0 + (size_t)kn * ks0); rk1 = *(const u32x4*)(kp1 + (size_t)kn * ks1);
            rv0 = *(const u32x4*)(vp0 + kn);
        }
        const int key0 = kt * 64;
        if (key0 <= qw0 + 31) {
            f32x4 sacc[4][2];
#pragma unroll
            for (int i = 0; i < 4; ++i)
#pragma unroll
                for (int j = 0; j < 2; ++j) sacc[i][j] = (f32x4){0.f, 0.f, 0.f, 0.f};
#pragma unroll
            for (int ks = 0; ks < 3; ++ks) {
                bf16x8 a[4];
#pragma unroll
                for (int mi = 0; mi < 4; ++mi) a[mi] = *(const bf16x8*)(sK + (mi * 16 + r16) * LK + ks * 32 + kg);
#pragma unroll
                for (int mi = 0; mi < 4; ++mi)
#pragma unroll
                    for (int ni = 0; ni < 2; ++ni) sacc[mi][ni] = __builtin_amdgcn_mfma_f32_16x16x32_bf16(a[mi], qf[ni][ks], sacc[mi][ni], 0, 0, 0);
            }
            if (key0 + 63 > qw0) {
#pragma unroll
                for (int mi = 0; mi < 4; ++mi)
#pragma unroll
                    for (int ni = 0; ni < 2; ++ni)
#pragma unroll
                        for (int r = 0; r < 4; ++r)
                            if (key0 + mi * 16 + g * 4 + r > qw0 + ni * 16 + r16) sacc[mi][ni][r] = -1e30f;
            }
#pragma unroll
            for (int ni = 0; ni < 2; ++ni) {
                float mx = -1e30f;
#pragma unroll
                for (int mi = 0; mi < 4; ++mi)
#pragma unroll
                    for (int r = 0; r < 4; ++r) mx = fmaxf(mx, sacc[mi][ni][r]);
                mx = quad_max(mx);
                const float mn = fmaxf(mrow[ni], mx);
                const bool grow = __any(mx > mrow[ni]);
#pragma unroll
                for (int mi = 0; mi < 4; ++mi)
#pragma unroll
                    for (int r = 0; r < 4; ++r) sacc[mi][ni][r] = __builtin_amdgcn_exp2f(sacc[mi][ni][r] - mn);
                if (grow) {
                    const float al = __builtin_amdgcn_exp2f(mrow[ni] - mn);
                    accL[ni] = accL[ni] * al;
#pragma unroll
                    for (int mo = 0; mo < 4; ++mo) accO[mo][ni] = accO[mo][ni] * al;
                }
                mrow[ni] = mn;
            }
#pragma unroll
            for (int kb = 0; kb < 2; ++kb) {
                bf16x8 pf[2];
#pragma unroll
                for (int ni = 0; ni < 2; ++ni) {
                    const f32x4 s0 = sacc[2 * kb][ni], s1 = sacc[2 * kb + 1][ni];
                    u32x4 pk; pk[0] = pack2(s0[0], s0[1]); pk[1] = pack2(s0[2], s0[3]); pk[2] = pack2(s1[0], s1[1]); pk[3] = pack2(s1[2], s1[3]);
                    pf[ni] = as_bf16x8(pk);
                    accL[ni] = __builtin_amdgcn_mfma_f32_16x16x32_bf16(vones, pf[ni], accL[ni], 0, 0, 0);
                }
#pragma unroll
                for (int mo = 0; mo < 4; ++mo) {
                    const bf16_t* vsrc = sV + (mo * 16 + r16) * LV + 32 * kb + 4 * g;
                    const uint2 lo = *(const uint2*)vsrc, hi = *(const uint2*)(vsrc + 16);
                    u32x4 vv; vv[0] = lo.x; vv[1] = lo.y; vv[2] = hi.x; vv[3] = hi.y;
                    const bf16x8 vf = as_bf16x8(vv);
#pragma unroll
                    for (int ni = 0; ni < 2; ++ni) accO[mo][ni] = __builtin_amdgcn_mfma_f32_16x16x32_bf16(vf, pf[ni], accO[mo][ni], 0, 0, 0);
                }
            }
        }
        if (kt + 1 < nt) {
            bf16_t* dK = smem + ((kt + 1) & 1) * STG;
            *(u32x4*)(dK + kd0) = rk0; if (k2) *(u32x4*)(dK + kd1) = rk1;
            *(u32x4*)(dK + 64 * LK + vrow * LV + vkc) = rv0;
        }
        __syncthreads();
    }
#pragma unroll
    for (int ni = 0; ni < 2; ++ni) {
        float l = accL[ni][0]; l += __shfl_xor(l, 16); l += __shfl_xor(l, 32);
        const float inv = 1.f / l;
        const int tok = tokb + qw0 + ni * 16 + r16; float ss = 0.f;
#pragma unroll
        for (int mo = 0; mo < 4; ++mo) {
            const f32x4 v = accO[mo][ni] * inv;
            ss += v[0] * v[0] + v[1] * v[1] + v[2] * v[2] + v[3] * v[3];
            *(uint2*)(s.ao + (size_t)tok * 1024 + h * 64 + mo * 16 + 4 * g) = pack4v(v);
        }
        ss += __shfl_xor(ss, 16); ss += __shfl_xor(ss, 32);
        if (lane < 16) s.a_ss[tok * 8 + h] = ss;
    }
}
__device__ void phase3(const Params& p, unsigned char* smem) {
    const WS s = make_ws(p.ws, p.out);
    for (int u = blockIdx.x; u < 512; u += gridDim.x) {
        const int half = u >> 8, v = u & 255, x = v >> 6, bh = v & 63;
        attn_unit(s, bh >> 3, bh & 7, half ? x : 7 - x, (bf16_t*)smem);
    }
}

DEVINL void router_superunit(const Params& p, const WS& s, unsigned char* smem, const int u) {
    int t = threadIdx.x; asm volatile("" : "+v"(t));
    const int lane = t & 63, w = t >> 6, i16 = lane & 15, g = lane >> 4;
    f32x4* racc = (f32x4*)smem;
    float* slog = (float*)(smem + 98304);
    int* hist = (int*)(smem + 98304 + 12288);
    {
        const int kb = 128 * w + 8 * g;
        f32x4 acc[4][3];
#pragma unroll
        for (int tl = 0; tl < 4; ++tl)
#pragma unroll
            for (int nt = 0; nt < 3; ++nt) acc[tl][nt] = (f32x4){0.f, 0.f, 0.f, 0.f};
#pragma unroll
        for (int q = 0; q < 4; ++q) {
            const int k = kb + 32 * q;
            f32x4 w0[3], w1[3];
#pragma unroll
            for (int nt = 0; nt < 3; ++nt) { w0[nt] = *(const f32x4*)(s.wrt + (size_t)(nt * 16 + i16) * 1024 + k); w1[nt] = *(const f32x4*)(s.wrt + (size_t)(nt * 16 + i16) * 1024 + k + 4); }
#pragma unroll
            for (int tl = 0; tl < 4; ++tl) {
                const u32x4 xr = *(const u32x4*)(s.x1b + (size_t)(u * 64 + tl * 16 + i16) * 1024 + k);
                const float x0[4] = {bflo(xr[0]), bfhi(xr[0]), bflo(xr[1]), bfhi(xr[1])};
                const float x1[4] = {bflo(xr[2]), bfhi(xr[2]), bflo(xr[3]), bfhi(xr[3])};
#pragma unroll
                for (int nt = 0; nt < 3; ++nt) {
#pragma unroll
                    for (int c = 0; c < 4; ++c) acc[tl][nt] = __builtin_amdgcn_mfma_f32_16x16x4f32(x0[c], w0[nt][c], acc[tl][nt], 0, 0, 0);
#pragma unroll
                    for (int c = 0; c < 4; ++c) acc[tl][nt] = __builtin_amdgcn_mfma_f32_16x16x4f32(x1[c], w1[nt][c], acc[tl][nt], 0, 0, 0);
                }
            }
        }
        __syncthreads();
#pragma unroll
        for (int tl = 0; tl < 4; ++tl)
#pragma unroll
            for (int nt = 0; nt < 3; ++nt) racc[(w * 12 + tl * 3 + nt) * 64 + lane] = acc[tl][nt];
        if (t < 32) hist[t] = 0;
        __syncthreads();
        for (int item = t; item < 12 * 64; item += NTHR) {
            const int tn = item >> 6, ln = item & 63, tl = tn / 3, nt = tn - tl * 3;
            f32x4 v = racc[tn * 64 + ln];
#pragma unroll
            for (int ww = 1; ww < 8; ++ww) v = v + racc[(ww * 12 + tn) * 64 + ln];
            const int n = nt * 16 + (ln & 15), gq = ln >> 4;
#pragma unroll
            for (int r = 0; r < 4; ++r) slog[(tl * 16 + 4 * gq + r) * 48 + n] = v[r];
        }
        __syncthreads();
        int e0 = 0, e1 = 0, rk0 = 0, rk1 = 0; float gate0 = 0.f, gate1 = 0.f;
        if (t < 64) {
            const float* lg = slog + t * 48;
            const float l0 = lg[0] + p.b_rg[0], l1 = lg[1] + p.b_rg[1], l2 = lg[2] + p.b_rg[2], l3 = lg[3] + p.b_rg[3];
            int gi = 0; float gm = l0;
            if (l1 > gm) { gm = l1; gi = 1; }
            if (l2 > gm) { gm = l2; gi = 2; }
            if (l3 > gm) { gm = l3; gi = 3; }
            const float gp = 1.f / (expf(l0 - gm) + expf(l1 - gm) + expf(l2 - gm) + expf(l3 - gm));
            float le[8];
#pragma unroll
            for (int j = 0; j < 8; ++j) le[j] = lg[4 + gi * 8 + j] + p.b_re[gi * 8 + j];
            int i0 = 0; float m0v = le[0];
#pragma unroll
            for (int j = 1; j < 8; ++j) if (le[j] > m0v) { m0v = le[j]; i0 = j; }
            int i1 = -1; float m1v = -3.0e38f;
#pragma unroll
            for (int j = 0; j < 8; ++j) if (j != i0 && le[j] > m1v) { m1v = le[j]; i1 = j; }
            const float pe1 = expf(m1v - m0v);
            gate0 = gp / (1.f + pe1); gate1 = gp * pe1 / (1.f + pe1);
            e0 = gi * 8 + i0; e1 = gi * 8 + i1;
            rk0 = atomicAdd(&hist[e0], 1); rk1 = atomicAdd(&hist[e1], 1);
        }
        __syncthreads();
        if (t < 32) { const int c = hist[t]; hist[32 + t] = c ? atomicAdd(&s.cnt[t * 64], c) : 0; }
        __syncthreads();
        if (t < 64) {
            const int tk = u * 64 + t;
            const int pos0 = hist[32 + e0] + rk0, pos1 = hist[32 + e1] + rk1;
            s.list[e0 * 16384 + pos0] = tk * 2; s.gatew[tk * 2] = gate0; s.asgep[tk * 2] = (e0 << 16) | pos0;
            s.list[e1 * 16384 + pos1] = tk * 2 + 1; s.gatew[tk * 2 + 1] = gate1; s.asgep[tk * 2 + 1] = (e1 << 16) | pos1;
        }
    }
}

__device__ void phase5(const Params& p, unsigned char* smem) {
    const WS s = make_ws(p.ws, p.out);
    for (int u = blockIdx.x; u < T_ / 64; u += gridDim.x) router_superunit(p, s, smem, u);
}

struct EpiP4 {
    const Params* p; WS s; unsigned* gcnt;
    DEVINL void mid(f32x4 (&acc)[2][2][4][2], const pg8::Unit& u, int wr, int wc, int fr, int fq) const {
#pragma unroll
        for (int ai = 0; ai < 2; ++ai)
#pragma unroll
            for (int m = 0; m < 4; ++m) {
                const float sc = s.rowsc[u.a0 * 256 + ai * 128 + wr * 64 + m * 16 + fr].x;
#pragma unroll
                for (int bj = 0; bj < 2; ++bj)
#pragma unroll
                    for (int n = 0; n < 2; ++n) acc[ai][bj][m][n] = acc[ai][bj][m][n] * sc;
            }
    }
    DEVINL void operator()(const f32x4 (&)[2][2][4][2], const pg8::Unit&, int, int, int, int) const {}
    DEVINL void final(f32x4 (&acc)[2][2][4][2], const pg8::Unit& u, int wr_, int wc_, int fr_, int fq_, LAS unsigned char* lds) const {
        float2* red = (float2*)lds;
        int t2 = threadIdx.x; asm volatile("" : "+v"(t2));
        const int wid2 = t2 >> 6, wr = wid2 >> 2, wc = wid2 & 3, fr = t2 & 15, fq = (t2 >> 4) & 3;
        const int row0 = u.a0 * 256 + wr * 64 + fr, col0 = u.a1 * 256 + wc * 32 + fq * 4;
        float rgv[2][4];
#pragma unroll
        for (int ai = 0; ai < 2; ++ai)
#pragma unroll
            for (int m = 0; m < 4; ++m) rgv[ai][m] = s.rowsc[row0 + ai * 128 + m * 16].y;
        uint2 xn[2][2];
#pragma unroll
        for (int bj = 0; bj < 2; ++bj)
#pragma unroll
            for (int n = 0; n < 2; ++n) xn[bj][n] = *(const uint2*)(s.xb + (size_t)row0 * 1024 + col0 + bj * 128 + n * 16);
#pragma unroll
        for (int it = 0; it < 8; ++it) {
            const int ai = it >> 2, m = it & 3, rl = ai * 128 + wr * 64 + m * 16 + fr;
            uint2 xc[2][2];
#pragma unroll
            for (int bj = 0; bj < 2; ++bj)
#pragma unroll
                for (int n = 0; n < 2; ++n) xc[bj][n] = xn[bj][n];
            asm volatile("" ::: "memory");
            if (it < 7) {
                const int ai2 = (it + 1) >> 2, m2 = (it + 1) & 3;
#pragma unroll
                for (int bj = 0; bj < 2; ++bj)
#pragma unroll
                    for (int n = 0; n < 2; ++n) xn[bj][n] = *(const uint2*)(s.xb + (size_t)(row0 + ai2 * 128 + m2 * 16) * 1024 + col0 + bj * 128 + n * 16);
            }
            float sum = 0.f, sq = 0.f;
#pragma unroll
            for (int bj = 0; bj < 2; ++bj)
#pragma unroll
                for (int n = 0; n < 2; ++n) {
                    const f32x4 xf = {bflo(xc[bj][n].x), bfhi(xc[bj][n].x), bflo(xc[bj][n].y), bfhi(xc[bj][n].y)};
                    const f32x4 a = acc[ai][bj][m][n] * rgv[ai][m] + xf * ALPHA_;
                    acc[ai][bj][m][n] = a;
                    sum += (a[0] + a[1]) + (a[2] + a[3]); sq += (a[0] * a[0] + a[1] * a[1]) + (a[2] * a[2] + a[3] * a[3]);
                }
            sum += __shfl_xor(sum, 16); sum += __shfl_xor(sum, 32); sq += __shfl_xor(sq, 16); sq += __shfl_xor(sq, 32);
            if (fq == 0) red[rl * 4 + wc] = make_float2(sum, sq);
        }
        __syncthreads();
        int tl = threadIdx.x; asm volatile("" : "+v"(tl));
        if (tl < 256) {
            const float2 r0 = red[tl * 4 + 0], r1 = red[tl * 4 + 1], r2 = red[tl * 4 + 2], r3 = red[tl * 4 + 3];
            st_wt8(&s.part[(size_t)(u.a0 * 256 + tl) * 4 + u.a1], make_uint2(__float_as_uint((r0.x + r1.x) + (r2.x + r3.x)), __float_as_uint((r0.y + r1.y) + (r2.y + r3.y))));
        }
        group_sync(gcnt + (u.a0 * 4 + 0) * 64, 4u);
        float mean[2][4], rstd[2][4];
#pragma unroll
        for (int ai = 0; ai < 2; ++ai)
#pragma unroll
            for (int m = 0; m < 4; ++m) {
                const int row = row0 + ai * 128 + m * 16;
                const float4 p01 = *(const float4*)(s.part + (size_t)row * 4), p23 = *(const float4*)(s.part + (size_t)row * 4 + 2);
                const float mu = ((p01.x + p01.z) + (p23.x + p23.z)) * (1.f / 1024.f);
                const float var = ((p01.y + p01.w) + (p23.y + p23.w)) * (1.f / 1024.f) - mu * mu;
                mean[ai][m] = mu; rstd[ai][m] = rsqrtf(fmaxf(var, 0.f) + EPS_);
            }
        f32x4 gg[2][2], bb[2][2];
#pragma unroll
        for (int bj = 0; bj < 2; ++bj)
#pragma unroll
            for (int n = 0; n < 2; ++n) { gg[bj][n] = *(const f32x4*)(p->ln1_g + col0 + bj * 128 + n * 16); bb[bj][n] = *(const f32x4*)(p->ln1_b + col0 + bj * 128 + n * 16); }
#pragma unroll
        for (int ai = 0; ai < 2; ++ai)
#pragma unroll
            for (int m = 0; m < 4; ++m) {
                const int row = row0 + ai * 128 + m * 16;
#pragma unroll
                for (int bj = 0; bj < 2; ++bj)
#pragma unroll
                    for (int n = 0; n < 2; ++n) {
                        const f32x4 o = (acc[ai][bj][m][n] - mean[ai][m]) * rstd[ai][m] * gg[bj][n] + bb[bj][n];
                        st_wt8(s.x1b + (size_t)row * 1024 + col0 + bj * 128 + n * 16, pack4v(o));
                    }
            }
        group_sync(gcnt + (u.a0 * 4 + 1) * 64, 4u);
        router_superunit(*p, s, (unsigned char*)lds, u.a0 * 4 + u.a1);
    }
};
__device__ void phase4(const Params& p, unsigned char* smem) {
    const WS s = make_ws(p.ws, p.out);
    pg8::DenseOrder S{(const char*)s.ao, (const char*)s.wo, 1024, 1024, 64, 4, (int)gridDim.x, (int)blockIdx.x, REP_P4};
    { pg8::Unit u;
      for (int i = 0; S.next(i, u); ++i)
          if (threadIdx.x < 256) {
              const int row = u.a0 * 256 + threadIdx.x;
              const float4 a0 = *(const float4*)(s.a_ss + row * 8), a1 = *(const float4*)(s.a_ss + row * 8 + 4);
              const float4 g0 = *(const float4*)(s.g_ss + row * 8), g1 = *(const float4*)(s.g_ss + row * 8 + 4);
              const float ra = rsqrtf((a0.x + a0.y + a0.z + a0.w + a1.x + a1.y + a1.z + a1.w) * (1.f / 512.f) + EPS_);
              const float rg = rsqrtf((g0.x + g0.y + g0.z + g0.w + g1.x + g1.y + g1.z + g1.w) * (1.f / 512.f) + EPS_);
              s.rowsc[row] = make_float2(ra / rg, rg);
          }
      asm volatile("s_waitcnt vmcnt(0)" ::: "memory");
      __syncthreads(); }
    EpiP4 E{&p, s, (unsigned*)(p.ws + WS_GCNT)};
    pg8::gemm_phase<8, true>((LAS unsigned char*)smem, S, E, 1024, 1024);
}

struct MoeMeta { int cnt[32]; int tstart[33]; int hbase[33]; };
DEVINL void moe_meta(const WS& s, MoeMeta* mm) {
    __syncthreads();
    if (threadIdx.x < 32) mm->cnt[threadIdx.x] = s.cnt[threadIdx.x * 64];
    __syncthreads();
    if (threadIdx.x == 0) {
        int ts = 0, hb = 0;
        for (int e = 0; e < 32; ++e) { const int c = mm->cnt[e]; mm->tstart[e] = ts; mm->hbase[e] = hb; ts += (c + 255) >> 8; hb += c; }
        mm->tstart[32] = ts; mm->hbase[32] = hb;
    }
    __syncthreads();
}
struct MoeOrder {
    const MoeMeta* mm; const int* list; const char* Abase; const char* Bbase; size_t bstride_e, bstride_pn; int mode, G, c, rep;
    DEVINL bool next(int i, pg8::Unit& u) const {
        const int nwg = mm->tstart[32] * 4; const long L = (long)i * G + c; if (L >= (long)nwg * rep) return false;
        int wgid = (int)(L % nwg); { const int q = nwg / 8, r = nwg % 8, xcd = wgid % 8, off = wgid / 8; wgid = (xcd < r ? xcd * (q + 1) : r * (q + 1) + (xcd - r) * q) + off; }
        const int ti = wgid >> 2, pn = wgid & 3;
        int e = 0; while (mm->tstart[e + 1] <= ti) ++e;
        const int it = ti - mm->tstart[e];
        u.A = Abase; u.B = Bbase + (size_t)e * bstride_e + (size_t)pn * bstride_pn;
        u.a0 = e * 16384 + it * 256; u.a1 = mm->hbase[e] + it * 256; u.a2 = pn; u.a3 = min(256, mm->cnt[e] - it * 256);
        return true;
    }
    DEVINL unsigned arow(const pg8::Unit& u, int r) const {
        const int rr = min(r, u.a3 - 1);
        if (mode == 0) return (unsigned)(list[u.a0 + rr] >> 1) * 2048u;
        return (unsigned)(u.a1 + rr) * 1024u;
    }
};
struct EpiP6 {
    WS s;
    DEVINL void mid(f32x4 (&)[2][2][4][2], const pg8::Unit&, int, int, int, int) const {}
    DEVINL void operator()(const f32x4 (&acc)[2][2][4][2], const pg8::Unit& u, int wr, int wc, int fr, int fq) const {
#pragma unroll
        for (int ai = 0; ai < 2; ++ai)
#pragma unroll
            for (int m = 0; m < 4; ++m) {
                const int r = ai * 128 + wr * 64 + m * 16 + fr;
                if (r < u.a3) {
#pragma unroll
                    for (int bj = 0; bj < 2; ++bj) {
                        const f32x4 gt = acc[ai][bj][m][0], up = acc[ai][bj][m][1];
                        float hv[4];
#pragma unroll
                        for (int q = 0; q < 4; ++q) hv[q] = gt[q] * fast_sigmoid(gt[q]) * up[q];
                        *(uint2*)(s.H + (size_t)(u.a1 + r) * 512 + u.a2 * 128 + bj * 64 + wc * 16 + fq * 4) = pack4(hv[0], hv[1], hv[2], hv[3]);
                    }
                }
            }
    }
};
struct EpiP7 {
    WS s;
    DEVINL void mid(f32x4 (&)[2][2][4][2], const pg8::Unit&, int, int, int, int) const {}
    DEVINL void operator()(const f32x4 (&acc)[2][2][4][2], const pg8::Unit& u, int wr, int wc, int fr, int fq) const {
#pragma unroll
        for (int ai = 0; ai < 2; ++ai)
#pragma unroll
            for (int m = 0; m < 4; ++m) {
                const int r = ai * 128 + wr * 64 + m * 16 + fr;
                if (r < u.a3) {
#pragma unroll
                    for (int bj = 0; bj < 2; ++bj)
#pragma unroll
                        for (int n = 0; n < 2; ++n)
                            *(uint2*)(s.ymoe + (size_t)(u.a1 + r) * 1024 + u.a2 * 256 + bj * 128 + wc * 32 + n * 16 + fq * 4) = pack4v(acc[ai][bj][m][n]);
                }
            }
    }
};
DEVINL size_t pp_off(int row, int col) { return (size_t)(row >> 8) * 524288 + 262144 + (size_t)(row & 255) * 1024 + col; }
struct EpiP9a {
    bf16_t* pp;
    DEVINL void mid(f32x4 (&)[2][2][4][2], const pg8::Unit&, int, int, int, int) const {}
    DEVINL void operator()(const f32x4 (&acc)[2][2][4][2], const pg8::Unit& u, int wr, int wc, int fr, int fq) const {
#pragma unroll
        for (int ai = 0; ai < 2; ++ai)
#pragma unroll
            for (int m = 0; m < 4; ++m) {
                const int row = u.a0 * 256 + ai * 128 + wr * 64 + m * 16 + fr;
#pragma unroll
                for (int bj = 0; bj < 2; ++bj)
#pragma unroll
                    for (int n = 0; n < 2; ++n)
                        *(uint2*)(pp + pp_off(row, u.a1 * 256 + bj * 128 + wc * 32 + n * 16 + fq * 4)) = pack4v(acc[ai][bj][m][n]);
            }
    }
};
DEVINL void ln2_rows64(const Params& p, const WS& s, const MoeMeta* mm, const int tok0) {
    int t = threadIdx.x; asm volatile("" : "+v"(t));
    const int lane = t & 63, w = t >> 6;
#pragma unroll 1
    for (int half = 0; half < 2; ++half) {
        float v[4][16];
#pragma unroll
        for (int r = 0; r < 4; ++r) {
            const int tok = tok0 + w + 8 * (half * 4 + r);
            const int ep0 = s.asgep[tok * 2], ep1 = s.asgep[tok * 2 + 1];
            const float g0 = s.gatew[tok * 2], g1 = s.gatew[tok * 2 + 1];
            const size_t r0 = (size_t)(mm->hbase[ep0 >> 16] + (ep0 & 0xffff)) * 1024, r1 = (size_t)(mm->hbase[ep1 >> 16] + (ep1 & 0xffff)) * 1024;
#pragma unroll
            for (int i = 0; i < 4; ++i) {
                const int c = i * 256 + lane * 4;
                const uint2 a = *(const uint2*)(s.x1b + (size_t)tok * 1024 + c);
                const uint2 y0 = *(const uint2*)(s.ymoe + r0 + c), y1 = *(const uint2*)(s.ymoe + r1 + c);
                v[r][i * 4 + 0] = ALPHA_ * bflo(a.x) + (g0 * bflo(y0.x) + g1 * bflo(y1.x)); v[r][i * 4 + 1] = ALPHA_ * bfhi(a.x) + (g0 * bfhi(y0.x) + g1 * bfhi(y1.x));
                v[r][i * 4 + 2] = ALPHA_ * bflo(a.y) + (g0 * bflo(y0.y) + g1 * bflo(y1.y)); v[r][i * 4 + 3] = ALPHA_ * bfhi(a.y) + (g0 * bfhi(y0.y) + g1 * bfhi(y1.y));
            }
        }
#pragma unroll
        for (int r = 0; r < 4; ++r) {
            const int tok = tok0 + w + 8 * (half * 4 + r);
            float sum = 0.f;
#pragma unroll
            for (int i = 0; i < 16; ++i) sum += v[r][i];
            const float mean = wave_sum(sum) * (1.f / 1024.f); float sq = 0.f;
#pragma unroll
            for (int i = 0; i < 16; ++i) { const float d = v[r][i] - mean; sq += d * d; }
            const float rstd = rsqrtf(wave_sum(sq) * (1.f / 1024.f) + EPS_);
#pragma unroll
            for (int i = 0; i < 4; ++i) {
                const int c = i * 256 + lane * 4;
                const float4 gg = *(const float4*)(p.ln2_g + c), bb = *(const float4*)(p.ln2_b + c);
                st_wt8(s.x2b + (size_t)tok * 1024 + c, pack4((v[r][i * 4 + 0] - mean) * rstd * gg.x + bb.x, (v[r][i * 4 + 1] - mean) * rstd * gg.y + bb.y,
                                                              (v[r][i * 4 + 2] - mean) * rstd * gg.z + bb.z, (v[r][i * 4 + 3] - mean) * rstd * gg.w + bb.w));
            }
        }
    }
}

__device__ void phase6(const Params& p, unsigned char* smem, MoeMeta* mm) {
    const WS s = make_ws(p.ws, p.out);
    moe_meta(s, mm);
    MoeOrder S{mm, s.list, (const char*)s.x1b, (const char*)s.wgu, (size_t)1024 * 1024 * 2, (size_t)256 * 1024 * 2, 0, (int)gridDim.x, (int)blockIdx.x, REP_P6};
    EpiP6 E{s};
    pg8::gemm_phase<0, false, (EPI2 == 6 ? 2 : 1)>((LAS unsigned char*)smem, S, E, 1024, 1024);
    int j, nh; helper_slot(mm->tstart[32] * 4 * REP_P6, (int)gridDim.x, (int)blockIdx.x, j, nh);
    if (j >= 0) {
        conv_expert_tiles(p, s, 1, j, 32 * 128, nh, (float*)smem);
        for (size_t i = (size_t)j * NTHR + threadIdx.x; i < (size_t)T_ * 256 / 8; i += (size_t)nh * NTHR) cvt8(p.p + i * 8, s.pb + i * 8);
    }
}
__device__ void phase7(const Params& p, unsigned char* smem, MoeMeta* mm) {
    const WS s = make_ws(p.ws, p.out);
    moe_meta(s, mm);
    MoeOrder S{mm, s.list, (const char*)s.H, (const char*)s.wd, (size_t)1024 * 512 * 2, (size_t)256 * 512 * 2, 1, (int)gridDim.x, (int)blockIdx.x, REP_P7};
    EpiP7 E{s};
    pg8::gemm_phase<0, false, (EPI2 == 7 ? 2 : 1)>((LAS unsigned char*)smem, S, E, 512, 512);
    int j, nh; helper_slot(mm->tstart[32] * 4 * REP_P7, (int)gridDim.x, (int)blockIdx.x, j, nh);
    if (j >= 0) {
        pg8::DenseOrder Sa{(const char*)s.pb, (const char*)s.wpp, 256, 256, 64, 4, nh, j, 1};
        EpiP9a Ea{(bf16_t*)p.out};
        pg8::gemm_phase<0, false, (EPI2 == 9 ? 2 : 1)>((LAS unsigned char*)smem, Sa, Ea, 256, 256);
    }
}

struct EpiP9b {
    const Params* p; WS s; const bf16_t* pp; unsigned* gcnt;
    DEVINL void mid(f32x4 (&)[2][2][4][2], const pg8::Unit&, int, int, int, int) const {}
    DEVINL void operator()(const f32x4 (&)[2][2][4][2], const pg8::Unit&, int, int, int, int) const {}
    DEVINL void final(f32x4 (&acc)[2][2][4][2], const pg8::Unit& u, int wr_, int wc_, int fr_, int fq_, LAS unsigned char* lds) const {
        float2* red = (float2*)lds;
        int t2 = threadIdx.x; asm volatile("" : "+v"(t2));
        const int wid2 = t2 >> 6, wr = wid2 >> 2, wc = wid2 & 3, fr = t2 & 15, fq = (t2 >> 4) & 3;
        const int row0 = u.a0 * 256 + wr * 64 + fr, col0 = u.a1 * 256 + wc * 32 + fq * 4;
        uint2 xn[2][2], pn_[2][2];
#pragma unroll
        for (int bj = 0; bj < 2; ++bj)
#pragma unroll
            for (int n = 0; n < 2; ++n) { xn[bj][n] = *(const uint2*)(s.x2b + (size_t)row0 * 1024 + col0 + bj * 128 + n * 16); pn_[bj][n] = *(const uint2*)(pp + pp_off(row0, col0 + bj * 128 + n * 16)); }
#pragma unroll
        for (int it = 0; it < 8; ++it) {
            const int ai = it >> 2, m = it & 3, rl = ai * 128 + wr * 64 + m * 16 + fr;
            float sum = 0.f, sq = 0.f;
#pragma unroll
            for (int bj = 0; bj < 2; ++bj)
#pragma unroll
                for (int n = 0; n < 2; ++n) {
                    const f32x4 a = acc[ai][bj][m][n] + *(const f32x4*)(p->b_pg + col0 + bj * 128 + n * 16);
                    const uint2 xr = xn[bj][n], pr = pn_[bj][n];
                    f32x4 o;
                    o[0] = ALPHA_ * bflo(xr.x) + bflo(pr.x) * fast_sigmoid(a[0]);
                    o[1] = ALPHA_ * bfhi(xr.x) + bfhi(pr.x) * fast_sigmoid(a[1]);
                    o[2] = ALPHA_ * bflo(xr.y) + bflo(pr.y) * fast_sigmoid(a[2]);
                    o[3] = ALPHA_ * bfhi(xr.y) + bfhi(pr.y) * fast_sigmoid(a[3]);
                    acc[ai][bj][m][n] = o;
                    sum += (o[0] + o[1]) + (o[2] + o[3]); sq += (o[0] * o[0] + o[1] * o[1]) + (o[2] * o[2] + o[3] * o[3]);
                }
            asm volatile("" ::: "memory");
            if (it < 7) {
                const int rn = row0 + ((it + 1) >> 2) * 128 + ((it + 1) & 3) * 16; const size_t ro = (size_t)rn * 1024 + col0;
#pragma unroll
                for (int bj = 0; bj < 2; ++bj)
#pragma unroll
                    for (int n = 0; n < 2; ++n) { xn[bj][n] = *(const uint2*)(s.x2b + ro + bj * 128 + n * 16); pn_[bj][n] = *(const uint2*)(pp + pp_off(rn, col0 + bj * 128 + n * 16)); }
            }
            sum += __shfl_xor(sum, 16); sum += __shfl_xor(sum, 32); sq += __shfl_xor(sq, 16); sq += __shfl_xor(sq, 32);
            if (fq == 0) red[rl * 4 + wc] = make_float2(sum, sq);
        }
        __syncthreads();
        int tl = threadIdx.x; asm volatile("" : "+v"(tl));
        if (tl < 256) {
            const float2 r0 = red[tl * 4 + 0], r1 = red[tl * 4 + 1], r2 = red[tl * 4 + 2], r3 = red[tl * 4 + 3];
            st_wt8(&s.part[(size_t)(u.a0 * 256 + tl) * 4 + u.a1], make_uint2(__float_as_uint((r0.x + r1.x) + (r2.x + r3.x)), __float_as_uint((r0.y + r1.y) + (r2.y + r3.y))));
        }
        group_sync(gcnt + (u.a0 * 4 + 2) * 64, 4u);
        float mean[2][4], rstd[2][4];
#pragma unroll
        for (int ai = 0; ai < 2; ++ai)
#pragma unroll
            for (int m = 0; m < 4; ++m) {
                const int row = row0 + ai * 128 + m * 16;
                const float4 p01 = *(const float4*)(s.part + (size_t)row * 4), p23 = *(const float4*)(s.part + (size_t)row * 4 + 2);
                const float mu = ((p01.x + p01.z) + (p23.x + p23.z)) * (1.f / 1024.f);
                const float var = ((p01.y + p01.w) + (p23.y + p23.w)) * (1.f / 1024.f) - mu * mu;
                mean[ai][m] = mu; rstd[ai][m] = rsqrtf(fmaxf(var, 0.f) + EPS_);
            }
#pragma unroll
        for (int ai = 0; ai < 2; ++ai)
#pragma unroll
            for (int m = 0; m < 4; ++m) {
                const int row = row0 + ai * 128 + m * 16;
#pragma unroll
                for (int bj = 0; bj < 2; ++bj)
#pragma unroll
                    for (int n = 0; n < 2; ++n) {
                        const f32x4 gg = *(const f32x4*)(p->ln3_g + col0 + bj * 128 + n * 16), bb = *(const f32x4*)(p->ln3_b + col0 + bj * 128 + n * 16);
                        __builtin_nontemporal_store((acc[ai][bj][m][n] - mean[ai][m]) * rstd[ai][m] * gg + bb, (f32x4*)(p->out + (size_t)row * 1024 + col0 + bj * 128 + n * 16));
                    }
                asm volatile("" ::: "memory");
            }
    }
};
__device__ void phase9(const Params& p, unsigned char* smem, MoeMeta* mm) {
    const WS s = make_ws(p.ws, p.out);
    moe_meta(s, mm);
    unsigned* gcnt = (unsigned*)(p.ws + WS_GCNT);
    pg8::DenseOrder S{(const char*)s.x2b, (const char*)s.wpg, 1024, 1024, 64, 4, (int)gridDim.x, (int)blockIdx.x, 1};
    pg8::Unit u0;
    if (!S.next(0, u0)) return;
    ln2_rows64(p, s, mm, u0.a0 * 256 + u0.a1 * 64);
    group_sync(gcnt + (u0.a0 * 4 + 3) * 64, 4u);
    const bf16_t* pp = (const bf16_t*)p.out;
    {
        EpiP9b E{&p, s, pp, gcnt};
        pg8::gemm_phase<0, true>((LAS unsigned char*)smem, S, E, 1024, 1024);
    }
}

constexpr int NPHASE = 11;
template <int LO, int HI>
__global__ void __launch_bounds__(NTHR, 2) fwd_kernel(Params p) {
    extern __shared__ __attribute__((aligned(16))) unsigned char smem[];
    MoeMeta& mm = *(MoeMeta*)(smem + LDS_META);
    XcdBarrier bar;
    if (HI - LO > 1) {
        if (threadIdx.x < 4) ((unsigned*)(smem + LDS_XB))[threadIdx.x] = 0u;
        __syncthreads();
        bar = xcd_barrier_post((unsigned*)(p.ws + WS_BAR), (volatile LAS unsigned*)(smem + LDS_XB));
#if USE_COOP
        if (p.use_cg_sync) cg::this_grid().sync();
#endif
    }
#ifndef REP_PHASE
#define REP_PHASE -1
#endif
#define PH(k) _Pragma("nounroll") for (int rep_ = 0; rep_ < ((REP_PHASE == (k)) ? 2 + p.use_cg_sync : 1); ++rep_) if (LO <= (k) && (k) < HI)
#define SYNC(k) if (LO <= (k) && (k) + 1 < HI) { if ((k) == LO) xcd_barrier<true>(bar); else xcd_barrier<false>(bar); }
    PH(0) { phase0(p, smem); if (REP_PHASE == 0 && rep_ == 0) xcd_barrier<true>(bar); } SYNC(0)
    PH(1) { phase1(p, smem); if (REP_PHASE == 1 && rep_ == 0) xcd_barrier(bar); } SYNC(1)
    PH(2) { phase2(p, smem, REP_PHASE != 2 || rep_ == 1); if (REP_PHASE == 2 && rep_ == 0) xcd_barrier(bar); } SYNC(2)
    PH(3) { phase3(p, smem); if (REP_PHASE == 3 && rep_ == 0) xcd_barrier(bar); } SYNC(3)
    PH(4) { phase4(p, smem); } SYNC(4)
    PH(6) { phase6(p, smem, &mm); if (REP_PHASE == 6 && rep_ == 0) xcd_barrier(bar); } SYNC(6)
    PH(7) { phase7(p, smem, &mm); if (REP_PHASE == 7 && rep_ == 0) xcd_barrier(bar); } SYNC(7)
    PH(9) { phase9(p, smem, &mm); }
#undef PH
#undef SYNC
}

template <int K> static void launch_one(const Params& prm, int grid, hipStream_t stream) {
    hipFuncSetAttribute((const void*)fwd_kernel<K, K + 1>, hipFuncAttributeMaxDynamicSharedMemorySize, LDS_BYTES);
    hipLaunchKernelGGL((fwd_kernel<K, K + 1>), dim3(grid), dim3(NTHR), LDS_BYTES, stream, prm);
}

extern "C" void kernel_launch(void* const* d_in, const int* in_sizes, int n_in, void* d_out, int out_size, void* d_ws, size_t ws_size,
                              hipStream_t stream) {
    if (n_in != 31 || ws_size < WS_END) { fprintf(stderr, "kernel_launch: unexpected n_in %d / ws_size %zu\n", n_in, ws_size); return; }
    Params prm{};
    prm.x = (const float*)d_in[0]; prm.p = (const float*)d_in[1]; prm.pos = (const int*)d_in[2];
    prm.w_in = (const float*)d_in[3]; prm.q_norm_g = (const float*)d_in[4]; prm.w_q_up = (const float*)d_in[5];
    prm.kv_norm_g = (const float*)d_in[6]; prm.w_kv_up = (const float*)d_in[7]; prm.gm_ln_g = (const float*)d_in[8];
    prm.gm_ln_b = (const float*)d_in[9]; prm.gm_w_s = (const float*)d_in[10]; prm.gm_b_s = (const float*)d_in[11];
    prm.mla_out_g = (const float*)d_in[12]; prm.gm_out_g = (const float*)d_in[13]; prm.w_o = (const float*)d_in[14];
    prm.ln1_g = (const float*)d_in[15]; prm.ln1_b = (const float*)d_in[16]; prm.w_rg = (const float*)d_in[17];
    prm.b_rg = (const float*)d_in[18]; prm.w_re = (const float*)d_in[19]; prm.b_re = (const float*)d_in[20];
    prm.w_gate = (const float*)d_in[21]; prm.w_up = (const float*)d_in[22]; prm.w_down = (const float*)d_in[23];
    prm.ln2_g = (const float*)d_in[24]; prm.ln2_b = (const float*)d_in[25]; prm.w_pg = (const float*)d_in[26];
    prm.b_pg = (const float*)d_in[27]; prm.w_pp = (const float*)d_in[28]; prm.ln3_g = (const float*)d_in[29];
    prm.ln3_b = (const float*)d_in[30];
    prm.out = (float*)d_out; prm.ws = (unsigned char*)d_ws;
    for (int j = 0; j < 16; ++j) prm.inv_freq[j] = (float)pow(10000.0, -(double)j / 16.0);
#if N_LAUNCH_MODE == 0
    const int grid = 1024;
    launch_one<0>(prm, grid, stream); launch_one<1>(prm, grid, stream); launch_one<2>(prm, grid, stream);
    launch_one<3>(prm, grid, stream); launch_one<4>(prm, grid, stream); launch_one<5>(prm, grid, stream);
    launch_one<6>(prm, grid, stream); launch_one<7>(prm, grid, stream); launch_one<8>(prm, grid, stream);
    launch_one<9>(prm, grid, stream); launch_one<10>(prm, grid, stream);
#else
    static int grid_blocks = 0;
    if (!grid_blocks) {
        int dev = 0, cus = 0, per_cu = 0;
        hipGetDevice(&dev);
        hipDeviceGetAttribute(&cus, hipDeviceAttributeMultiprocessorCount, dev);
        if (hipFuncSetAttribute((const void*)fwd_kernel<0, NPHASE>, hipFuncAttributeMaxDynamicSharedMemorySize, LDS_BYTES) != hipSuccess)
            fprintf(stderr, "kernel_launch: hipFuncSetAttribute(%d B dynamic LDS) failed\n", LDS_BYTES);
        hipOccupancyMaxActiveBlocksPerMultiprocessor(&per_cu, (const void*)fwd_kernel<0, NPHASE>, NTHR, LDS_BYTES);
        if (per_cu < 1) fprintf(stderr, "kernel_launch: occupancy query reports %d blocks per CU\n", per_cu);
        (void)hipGetLastError();
        grid_blocks = cus;
    }
    hipMemsetAsync((unsigned char*)d_ws + WS_BAR, 0, XCD_BAR_WORDS * 4, stream);
    hipMemsetAsync((unsigned char*)d_ws + WS_GCNT, 0, 64 * 4 * 256, stream);
#if USE_COOP
    void* args[] = {&prm};
    hipError_t e = hipLaunchCooperativeKernel((const void*)fwd_kernel<0, NPHASE>, dim3(grid_blocks), dim3(NTHR), args, LDS_BYTES, stream);
    if (e != hipSuccess) fprintf(stderr, "cooperative launch failed: %s (grid %d)\n", hipGetErrorString(e), grid_blocks);
#else
    hipLaunchKernelGGL((fwd_kernel<0, NPHASE>), dim3(grid_blocks), dim3(NTHR), LDS_BYTES, stream, prm);
#endif
#endif
}
```

```cpp
#include <hip/hip_runtime.h>
#include <hip/hip_cooperative_groups.h>
#include <stdint.h>
#include <math.h>
#include <stdio.h>
namespace cg = cooperative_groups;

#ifndef USE_COOP
#define USE_COOP 0
#endif
#ifndef N_LAUNCH_MODE
#define N_LAUNCH_MODE 1
#endif

#define DEVINL __device__ __forceinline__
typedef unsigned short bf16_t;
typedef short bf16x8 __attribute__((ext_vector_type(8)));
typedef float f32x4 __attribute__((ext_vector_type(4)));
typedef unsigned u32x4 __attribute__((ext_vector_type(4)));

constexpr int T_ = 16384, D_ = 1024, SEQ_ = 2048;
constexpr float ALPHA_ = 1.189207115002721f;
constexpr float EPS_ = 1e-6f;
constexpr int LDK = 72;
constexpr int NTHR = 512;
constexpr int LDS_STAGE = 131072;
constexpr int LDS_META = LDS_STAGE;
constexpr int LDS_XB = LDS_STAGE + 1024;
constexpr int LDS_RED = LDS_STAGE + 2048;
constexpr int LDS_BYTES = LDS_STAGE + 2048 + 4096;

constexpr size_t MiB = 1ull << 20;
constexpr size_t WS_WGU = 0;
constexpr size_t WS_WD = 64 * MiB;
constexpr size_t WS_WPG = 96 * MiB;
constexpr size_t WS_WPP = 98 * MiB;
constexpr size_t WS_WIN = 98 * MiB + 512 * 1024;
constexpr size_t WS_WO = WS_WIN + 3 * MiB;
constexpr size_t WS_WQ = WS_WO + 2 * MiB;
constexpr size_t WS_WKV = WS_WQ + 512 * 1024;
constexpr size_t WS_WS = WS_WKV + 256 * 1024;
constexpr size_t WS_WRT = WS_WS + 256 * 1024;
constexpr size_t WS_CS = WS_WRT + 256 * 1024;
constexpr size_t WS_PB = WS_CS + 2 * MiB;
constexpr size_t WS_CNT = WS_PB + 8 * MiB;
constexpr size_t WS_LIST = WS_CNT + 8192;
constexpr size_t WS_GATEW = WS_LIST + 2 * MiB;
constexpr size_t WS_ASGEP = WS_GATEW + 128 * 1024;
constexpr size_t WS_LATSS = WS_ASGEP + 128 * 1024;
constexpr size_t WS_ASS = WS_LATSS + 512 * 1024;
constexpr size_t WS_GSS = WS_ASS + 512 * 1024;
constexpr int XCD_BAR_WORDS_C = 3456;
constexpr size_t WS_BAR = 247 * MiB;
constexpr size_t WS_ROWSC = WS_BAR + 64 * 1024;
constexpr size_t WS_PART = WS_ROWSC + 128 * 1024;
constexpr size_t WS_RA = 119 * MiB;
constexpr size_t WS_RB = 151 * MiB;
constexpr size_t WS_RC = 183 * MiB;
constexpr size_t WS_WKV2 = 248 * MiB;
constexpr size_t WS_GCNT = WS_BAR + 16 * 1024;
constexpr size_t WS_WR3 = 248 * MiB + 512 * 1024 + 128 * 1024;
constexpr size_t WS_END = 249 * MiB;
static_assert(WS_GSS + 512 * 1024 <= 119 * MiB && WS_PART + 512 * 1024 <= WS_END && WS_WR3 + 3 * 48 * 1024 * 2 <= WS_END && XCD_BAR_WORDS_C * 4 <= 16 * 1024 && WS_GCNT + 64 * 1024 <= WS_PART, "ws overlap");

struct Params {
    const float* x; const float* p; const int* pos;
    const float* w_in; const float* q_norm_g; const float* w_q_up; const float* kv_norm_g; const float* w_kv_up;
    const float* gm_ln_g; const float* gm_ln_b; const float* gm_w_s; const float* gm_b_s;
    const float* mla_out_g; const float* gm_out_g; const float* w_o; const float* ln1_g; const float* ln1_b;
    const float* w_rg; const float* b_rg; const float* w_re; const float* b_re;
    const float* w_gate; const float* w_up; const float* w_down; const float* ln2_g; const float* ln2_b;
    const float* w_pg; const float* b_pg; const float* w_pp; const float* ln3_g; const float* ln3_b;
    float* out; unsigned char* ws;
    float inv_freq[16];
    int use_cg_sync; int pad_;
};

typedef __bf16 bf16x2_t __attribute__((ext_vector_type(2)));
typedef float f32x2_t __attribute__((ext_vector_type(2)));
DEVINL unsigned pack2(float lo, float hi) { const f32x2_t v = {lo, hi}; return __builtin_bit_cast(unsigned, __builtin_convertvector(v, bf16x2_t)); }
DEVINL uint2 pack4(float a, float b, float c, float d) { return make_uint2(pack2(a, b), pack2(c, d)); }
DEVINL uint2 pack4v(f32x4 v) { return make_uint2(pack2(v[0], v[1]), pack2(v[2], v[3])); }
DEVINL uint4 widen_pair(uint2 a, uint2 b) {
    const auto r0 = __builtin_amdgcn_permlane16_swap(a.x, b.x, false, false);
    const auto r1 = __builtin_amdgcn_permlane16_swap(a.y, b.y, false, false);
    return make_uint4(r0[0], r1[0], r0[1], r1[1]);
}
DEVINL void unwiden(uint4 w, uint2& a, uint2& b) {
    const auto r0 = __builtin_amdgcn_permlane16_swap(w.x, w.z, false, false);
    const auto r1 = __builtin_amdgcn_permlane16_swap(w.y, w.w, false, false);
    a = make_uint2(r0[0], r1[0]); b = make_uint2(r0[1], r1[1]);
}
DEVINL int wide_col(int fq) { return ((fq & 1) << 4) + ((fq >> 1) << 3); }
typedef int v8i_t __attribute__((ext_vector_type(8)));
typedef int v4i_t __attribute__((ext_vector_type(4)));
DEVINL unsigned pack4_f8(float a, float b, float c, float d) { int v = __builtin_amdgcn_cvt_pk_fp8_f32(a, b, 0, false); v = __builtin_amdgcn_cvt_pk_fp8_f32(c, d, v, true); return (unsigned)v; }
DEVINL uint2 widen_pair8(unsigned a, unsigned b) { const auto r = __builtin_amdgcn_permlane16_swap(a, b, false, false); return make_uint2(r[0], r[1]); }
constexpr float F8_YSCALE = 16.f;
constexpr float F8_WSCALE = 64.f;
DEVINL float bf2f(unsigned short b) { return __uint_as_float(((unsigned)b) << 16); }
DEVINL float bflo(unsigned u) { return __uint_as_float(u << 16); }
DEVINL float bfhi(unsigned u) { return __uint_as_float(u & 0xffff0000u); }
DEVINL float xor16_sum(float x) { const unsigned u = __float_as_uint(x); const auto r = __builtin_amdgcn_permlane16_swap(u, u, false, false); return __uint_as_float(r[0]) + __uint_as_float(r[1]); }
DEVINL float xor32_sum(float x) { const unsigned u = __float_as_uint(x); const auto r = __builtin_amdgcn_permlane32_swap(u, u, false, false); return __uint_as_float(r[0]) + __uint_as_float(r[1]); }
DEVINL float quad_sum(float x) { return xor32_sum(xor16_sum(x)); }
template <int CTRL> DEVINL float dpp_f(float x) { return __uint_as_float((unsigned)__builtin_amdgcn_mov_dpp((int)__float_as_uint(x), CTRL, 0xf, 0xf, true)); }
DEVINL float wave_sum(float v) {
    v += dpp_f<0xB1>(v);
    v += dpp_f<0x4E>(v);
    v += dpp_f<0x141>(v);
    v += dpp_f<0x140>(v);
    return quad_sum(v);
}
DEVINL float fast_sigmoid(float x) { return __builtin_amdgcn_rcpf(1.f + __builtin_amdgcn_exp2f(-1.4426950408889634f * x)); }
DEVINL f32x4 gelu4(f32x4 x) {
    const f32x4 w = (x * x) * (-0.044715f * 1.5957691216057308f * 1.4426950408889634f) + (-1.5957691216057308f * 1.4426950408889634f);
    const f32x4 a = x * w;
    f32x4 d;
#pragma unroll
    for (int i = 0; i < 4; ++i) d[i] = __builtin_amdgcn_exp2f(a[i]);
    d = d + 1.f;
#pragma unroll
    for (int i = 0; i < 4; ++i) d[i] = __builtin_amdgcn_rcpf(d[i]);
    return x * d;
}
DEVINL float gelu_tanh(float x) {
    const float z2 = 1.5957691216057308f * (x + 0.044715f * x * x * x);
    return x * fast_sigmoid(z2);
}

template <int MI, int NI, bool TRANS>
DEVINL void mma_ktile(f32x4 (&acc)[MI][NI], const bf16_t* sA, const bf16_t* sB, int lane) {
    const int r16 = lane & 15, kg = (lane >> 4) * 8;
#pragma unroll
    for (int ks = 0; ks < 2; ++ks) {
        bf16x8 a[MI], b[NI];
#pragma unroll
        for (int mi = 0; mi < MI; ++mi) a[mi] = *(const bf16x8*)(sA + (mi * 16 + r16) * LDK + ks * 32 + kg);
#pragma unroll
        for (int ni = 0; ni < NI; ++ni) b[ni] = *(const bf16x8*)(sB + (ni * 16 + r16) * LDK + ks * 32 + kg);
#pragma unroll
        for (int mi = 0; mi < MI; ++mi)
#pragma unroll
            for (int ni = 0; ni < NI; ++ni) {
                if (TRANS) acc[mi][ni] = __builtin_amdgcn_mfma_f32_16x16x32_bf16(a[mi], b[ni], acc[mi][ni], 0, 0, 0);
                else acc[mi][ni] = __builtin_amdgcn_mfma_f32_16x16x32_bf16(b[ni], a[mi], acc[mi][ni], 0, 0, 0);
            }
    }
}

template <bool TRANS, int NI, class ARowF>
DEVINL void gemm_core(f32x4 (&acc)[4][NI], ARowF arow, const bf16_t* __restrict__ Bt, int ldb, int K, bf16_t* smem) {
    bf16_t* sA = smem; bf16_t* sB = smem + 256 * LDK;
    const int t = threadIdx.x, lane = t & 63, w = t >> 6, wr = w >> 1, wc = w & 1;
    const int lrow = t >> 3, lkc = (t & 7) * 8;
    const bf16_t* ap[4]; const bf16_t* bp[2];
#pragma unroll
    for (int i = 0; i < 4; ++i) ap[i] = arow(lrow + 64 * i) + lkc;
    bp[0] = Bt + (size_t)lrow * ldb + lkc;
    bp[1] = Bt + (size_t)(lrow + (NI == 4 ? 64 : 0)) * ldb + lkc;
    u32x4 ra0, ra1, ra2, ra3, rb0, rb1;
    ra0 = *(const u32x4*)(ap[0]); ra1 = *(const u32x4*)(ap[1]); ra2 = *(const u32x4*)(ap[2]); ra3 = *(const u32x4*)(ap[3]);
    rb0 = *(const u32x4*)(bp[0]);
    if (NI == 4) rb1 = *(const u32x4*)(bp[1]);
#pragma nounroll
    for (int k0 = 0; k0 < K; k0 += 64) {
        __syncthreads();
        *(u32x4*)(sA + (lrow + 0) * LDK + lkc) = ra0; *(u32x4*)(sA + (lrow + 64) * LDK + lkc) = ra1;
        *(u32x4*)(sA + (lrow + 128) * LDK + lkc) = ra2; *(u32x4*)(sA + (lrow + 192) * LDK + lkc) = ra3;
        *(u32x4*)(sB + (lrow + 0) * LDK + lkc) = rb0;
        if (NI == 4) *(u32x4*)(sB + (lrow + 64) * LDK + lkc) = rb1;
        __syncthreads();
        if (k0 + 64 < K) {
            const int kn = k0 + 64;
            ra0 = *(const u32x4*)(ap[0] + kn); ra1 = *(const u32x4*)(ap[1] + kn); ra2 = *(const u32x4*)(ap[2] + kn); ra3 = *(const u32x4*)(ap[3] + kn);
            rb0 = *(const u32x4*)(bp[0] + kn);
            if (NI == 4) rb1 = *(const u32x4*)(bp[1] + kn);
        }
        mma_ktile<4, NI, TRANS>(acc, sA + wr * 64 * LDK, sB + wc * 16 * NI * LDK, lane);
    }
}

template <int NI>
DEVINL void zero_acc(f32x4 (&acc)[4][NI]) {
#pragma unroll
    for (int i = 0; i < 4; ++i)
#pragma unroll
        for (int j = 0; j < NI; ++j) acc[i][j] = (f32x4){0.f, 0.f, 0.f, 0.f};
}

struct WS {
    bf16_t *wgu, *wd, *wpg, *wpp, *win, *wo, *wq, *wkv, *wsb, *pb;
    float2* rowsc; float2* part; float* wrt; bf16_t* wr3; float2* cs; int* cnt; int* list; float* gatew; int* asgep; float *lat_ss, *a_ss, *g_ss;
    unsigned char *wgu8, *wd8, *x1f8, *h8, *x2f8;
    bf16_t *xb, *q, *x1b; bf16_t *u, *vln, *ao, *H, *x2b; bf16_t *latq, *latkv, *wkv2, *kr, *k, *vT, *go, *ymoe;
};
DEVINL WS make_ws(unsigned char* ws, float* out = nullptr) {
    WS s;
    s.vln = (bf16_t*)out;
    s.q = (bf16_t*)((unsigned char*)out + 16 * MiB);
    s.wgu8 = ws + WS_WGU; s.x1f8 = ws + WS_WGU + 32 * MiB; s.x2f8 = s.x1f8; s.h8 = ws + WS_WGU + 48 * MiB; s.wd8 = ws + WS_WD;
    s.wgu = (bf16_t*)(ws + WS_WGU); s.wd = (bf16_t*)(ws + WS_WD); s.wpg = (bf16_t*)(ws + WS_WPG); s.wpp = (bf16_t*)(ws + WS_WPP);
    s.win = (bf16_t*)(ws + WS_WIN); s.wo = (bf16_t*)(ws + WS_WO); s.wq = (bf16_t*)(ws + WS_WQ); s.wkv = (bf16_t*)(ws + WS_WKV);
    s.wsb = (bf16_t*)(ws + WS_WS); s.wrt = (float*)(ws + WS_WRT); s.wr3 = (bf16_t*)(ws + WS_WR3); s.cs = (float2*)(ws + WS_CS); s.pb = (bf16_t*)(ws + WS_PB);
    s.rowsc = (float2*)(ws + WS_ROWSC); s.part = (float2*)(ws + WS_PART); s.cnt = (int*)(ws + WS_CNT); s.list = (int*)(ws + WS_LIST); s.gatew = (float*)(ws + WS_GATEW); s.asgep = (int*)(ws + WS_ASGEP);
    s.lat_ss = (float*)(ws + WS_LATSS); s.a_ss = (float*)(ws + WS_ASS); s.g_ss = (float*)(ws + WS_GSS);
    s.xb = (bf16_t*)(ws + WS_RA); s.x1b = s.xb;
    s.ao = (bf16_t*)(ws + WS_RB); s.u = s.ao + 512; s.go = s.u; s.H = s.ao; s.x2b = s.ao;
    s.latq = (bf16_t*)(ws + WS_RC); s.latkv = (bf16_t*)(ws + WS_RC + 8 * MiB); s.kr = (bf16_t*)(ws + WS_RC + 16 * MiB); s.k = (bf16_t*)(ws + WS_RC + 17 * MiB); s.wkv2 = (bf16_t*)(ws + WS_WKV2);
    s.vT = (bf16_t*)(ws + WS_RC + 33 * MiB); s.ymoe = s.latq;
    return s;
}

#define XB_TMO      128
#define XB_XCNT(j)  (256  + 64 * (j))
#define XB_XSUB(j)  (1280 + 64 * (j))
#define XB_XGEN(j)  (2304 + 64 * (j))
#define XB_TOP      3328
#define XB_TOPGEN   3392
#define XCD_BAR_WORDS 3456
#define XB_SPIN_CAP (1u << 24)
#ifndef LAS
#define LAS __attribute__((address_space(3)))
#endif
DEVINL unsigned xb_ld(unsigned* p) { return __hip_atomic_load(p, __ATOMIC_RELAXED, __HIP_MEMORY_SCOPE_AGENT); }
DEVINL unsigned xb_add(unsigned* p, unsigned v) { return __hip_atomic_fetch_add(p, v, __ATOMIC_RELAXED, __HIP_MEMORY_SCOPE_AGENT); }
DEVINL unsigned xb_xcc_id() { return (unsigned)__builtin_amdgcn_s_getreg((3 << 11) | 20) & 0xFu; }
#define XB_SPIN(cond, bar) do { unsigned _sp = 0; while (cond) { __builtin_amdgcn_s_sleep(1); \
    if ((++_sp & 255u) == 0u) { if (xb_ld(&(bar)[XB_TMO])) break; if (_sp > XB_SPIN_CAP) { atomicAdd(&(bar)[XB_TMO], 1u); break; } } } } while (0)
struct XcdBarrier { unsigned* bar; unsigned x; volatile LAS unsigned* st; };
DEVINL XcdBarrier xcd_barrier_post(unsigned* bar, volatile LAS unsigned* st) {
    XcdBarrier b; b.bar = bar; b.x = xb_xcc_id(); b.st = st;
    if (threadIdx.x == 0) (void)xb_add(&bar[XB_XCNT(b.x)], 1u);
    return b;
}
DEVINL void xcd_barrier_complete(unsigned* bar, unsigned x, unsigned& nloc, unsigned& nx) {
    const unsigned G = gridDim.x * gridDim.y * gridDim.z;
    unsigned sum, cnt, mine, sp = 0u;
    for (;;) {
        sum = 0u; cnt = 0u; mine = 0u;
#pragma unroll
        for (unsigned j = 0; j < 16; ++j) { const unsigned c = xb_ld(&bar[XB_XCNT(j)]); sum += c; cnt += (c > 0u) ? 1u : 0u; mine = (j == x) ? c : mine; }
        if (sum == G) break;
        __builtin_amdgcn_s_sleep(1);
        if ((++sp & 255u) == 0u) { if (xb_ld(&bar[XB_TMO])) break; if (sp > XB_SPIN_CAP) { atomicAdd(&bar[XB_TMO], 1u); break; } }
    }
    nloc = mine > 0u ? mine : 1u; nx = cnt > 0u ? cnt : 1u;
}
template <bool FIRST = false>
DEVINL void xcd_barrier(const XcdBarrier& b) {
    asm volatile("s_waitcnt vmcnt(0)" ::: "memory");
    __syncthreads();
    if (threadIdx.x == 0) {
        unsigned* bar = b.bar;
        const unsigned bx = xb_xcc_id();
        __builtin_amdgcn_s_waitcnt(0);
        unsigned nloc = b.st[0], nx = b.st[1];
        if (FIRST) { xcd_barrier_complete(bar, bx, nloc, nx); b.st[0] = nloc; b.st[1] = nx; }
        const unsigned old = xb_add(&bar[XB_XSUB(bx)], 1u);
        const unsigned gen = old / nloc;
        if (old + 1u == (gen + 1u) * nloc) {
            __builtin_amdgcn_fence(__ATOMIC_RELEASE, "agent");
            asm volatile("s_waitcnt vmcnt(0)" ::: "memory");
            const unsigned og = xb_add(&bar[XB_TOP], 1u);
            const unsigned tg = og / nx;
            if (og + 1u == (tg + 1u) * nx) xb_add(&bar[XB_TOPGEN], 1u);
            else XB_SPIN(xb_ld(&bar[XB_TOPGEN]) == tg, bar);
            __builtin_amdgcn_fence(__ATOMIC_ACQUIRE, "agent");
            xb_add(&bar[XB_XGEN(bx)], 1u);
            asm volatile("s_waitcnt vmcnt(0)" ::: "memory");
        } else {
            XB_SPIN(xb_ld(&bar[XB_XGEN(bx)]) == gen, bar);
            __builtin_amdgcn_fence(__ATOMIC_ACQUIRE, "agent");
            asm volatile("s_waitcnt vmcnt(0)" ::: "memory");
        }
    }
    __syncthreads();
}

DEVINL void st_wt8(void* p, uint2 v) { __hip_atomic_store((unsigned long long*)p, ((unsigned long long)v.y << 32) | v.x, __ATOMIC_RELAXED, __HIP_MEMORY_SCOPE_AGENT); }
DEVINL void st_wt16(const void* base, unsigned byte_off, uint4 v) {
    const __amdgpu_buffer_rsrc_t r = __builtin_amdgcn_make_buffer_rsrc((void*)base, (short)0, 0x7fffffff, 0x00027000);
    __builtin_amdgcn_raw_buffer_store_b128((u32x4){v.x, v.y, v.z, v.w}, r, (int)byte_off, 0, 16);
}
DEVINL void group_sync(unsigned* cnt, unsigned target) {
    asm volatile("s_waitcnt vmcnt(0)" ::: "memory");
    __syncthreads();
    if (threadIdx.x == 0) {
        xb_add(cnt, 1u);
        unsigned sp = 0;
        while (xb_ld(cnt) < target) { __builtin_amdgcn_s_sleep(1); if (++sp > XB_SPIN_CAP) break; }
        __builtin_amdgcn_fence(__ATOMIC_ACQUIRE, "agent");
        asm volatile("s_waitcnt vmcnt(0)" ::: "memory");
    }
    __syncthreads();
}

#define LAS __attribute__((address_space(3)))
#ifndef E_SPLIT_V
#define E_SPLIT_V 20
#endif
#ifndef EPI2
#define EPI2 0
#endif
#ifndef P0_REP
#define P0_REP 1
#endif
#ifndef REP_P1
#define REP_P1 1
#endif
#ifndef REP_P4
#define REP_P4 1
#endif
#ifndef REP_P6
#define REP_P6 1
#endif
#ifndef REP_P7
#define REP_P7 1
#endif
#ifndef REP_P9
#define REP_P9 1
#endif
namespace pg8 {
constexpr int BK = 64, HALF = 128, HTB = HALF * BK * 2, STAGE_BYTES = 8 * HTB;
DEVINL int lds_byte(int r, int c) { const int st = (r >> 4) * 2 + (c >> 5), rr = r & 15, cc = c & 31, ob = rr * 64 + cc * 2; return st * 1024 + (ob ^ (((ob >> 9) & 1) << 5)); }
DEVINL void stage_rc(int b, int& R, int& C) { const int st = b / 1024, sb = b % 1024, swz = sb ^ (((sb >> 9) & 1) << 5); R = (st >> 1) * 16 + swz / 64; C = (st & 1) * 32 + (swz % 64) / 2; }
struct Unit { const char* A; const char* B; int a0, a1, a2, a3; };
template <int MIDT, bool FUSED, int EPIREP = 1, bool F8 = false, class Epi, class Sched>
DEVINL void gemm_phase(LAS unsigned char* lds, const Sched& S, const Epi& E, const int K, const int ldb) {
    int tid_ = threadIdx.x; asm volatile("" : "+v"(tid_));
    const int tid = tid_, wid = __builtin_amdgcn_readfirstlane(tid >> 6), lane = tid & 63, wr = wid >> 2, wc = wid & 3, fr = lane & 15, fq = lane >> 4;
    const int nt = K / BK;
    int RA[2], CA[2]; unsigned voffB[2];
#pragma unroll
    for (int i = 0; i < 2; ++i) { stage_rc(tid * 16 + i * 8192, RA[i], CA[i]); voffB[i] = (unsigned)(RA[i] * ldb + CA[i]) * 2u; }
    const size_t kstep = (size_t)(BK * 2);
    const size_t hstepB = (size_t)HALF * ldb * 2;
    const unsigned ldsw = (unsigned)wid * 1024u;
    const int aoff = lds_byte(wr * 64 + fr, fq * 8), boff = lds_byte(wc * 32 + fr, fq * 8);
#define PG8_SA(b, h) (((b) * 2 + (h)) * HTB)
#define PG8_SB(b, h) ((4 + (b) * 2 + (h)) * HTB)
#define PG8_STG(bufoff, gbase, v0, v1) do { \
        __builtin_amdgcn_global_load_lds((const unsigned*)((const char*)(gbase) + (v0)), (LAS unsigned*)(lds + (bufoff) + ldsw), 16, 0, 0); \
        __builtin_amdgcn_global_load_lds((const unsigned*)((const char*)(gbase) + (v1)), (LAS unsigned*)(lds + (bufoff) + ldsw + 8192), 16, 0, 0); } while (0)
#define PG8_STGB(bufoff, gbase) PG8_STG(bufoff, gbase, voffB[0], voffB[1])
#define PG8_LDA(dst, b, h) do { if constexpr (F8) { _Pragma("unroll") for (int m = 0; m < 4; ++m) { const v4i_t lo_ = *(const LAS v4i_t*)(lds + PG8_SA(b, h) + aoff + m * 2048), hi_ = *(const LAS v4i_t*)(lds + PG8_SA(b, h) + aoff + m * 2048 + 1024); \
            dst##8[m] = __builtin_shufflevector(lo_, hi_, 0, 1, 2, 3, 4, 5, 6, 7); } } \
        else { _Pragma("unroll") for (int m = 0; m < 4; ++m) _Pragma("unroll") for (int k = 0; k < 2; ++k) dst[m][k] = *(const LAS bf16x8*)(lds + PG8_SA(b, h) + aoff + m * 2048 + k * 1024); } } while (0)
#define PG8_LDB(dst, b, h) do { if constexpr (F8) { _Pragma("unroll") for (int n = 0; n < 2; ++n) { const v4i_t lo_ = *(const LAS v4i_t*)(lds + PG8_SB(b, h) + boff + n * 2048), hi_ = *(const LAS v4i_t*)(lds + PG8_SB(b, h) + boff + n * 2048 + 1024); \
            dst##8[n] = __builtin_shufflevector(lo_, hi_, 0, 1, 2, 3, 4, 5, 6, 7); } } \
        else { _Pragma("unroll") for (int n = 0; n < 2; ++n) _Pragma("unroll") for (int k = 0; k < 2; ++k) dst[n][k] = *(const LAS bf16x8*)(lds + PG8_SB(b, h) + boff + n * 2048 + k * 1024); } } while (0)
#define PG8_MMA(ai, bj, At, Bt) do { __builtin_amdgcn_s_setprio(1); \
        if constexpr (F8) {   \
            _Pragma("unroll") for (int m = 0; m < 4; ++m) _Pragma("unroll") for (int n = 0; n < 2; ++n) \
                asm volatile("v_mfma_scale_f32_16x16x128_f8f6f4 %0, %1, %2, %0, %3, %3 op_sel_hi:[0,0,0]" : "+v"(acc[ai][bj][m][n]) : "v"(Bt##8[n]), "v"(At##8[m]), "v"(f8scale)); \
        } else { _Pragma("unroll") for (int m = 0; m < 4; ++m) _Pragma("unroll") for (int n = 0; n < 2; ++n) _Pragma("unroll") for (int k = 0; k < 2; ++k) \
            acc[ai][bj][m][n] = __builtin_amdgcn_mfma_f32_16x16x32_bf16(Bt[n][k], At[m][k], acc[ai][bj][m][n], 0, 0, 0); } \
        __builtin_amdgcn_s_setprio(0); } while (0)
#define PG8_WAIT_V(n) asm volatile("s_waitcnt vmcnt(" #n ")" ::: "memory")
#define PG8_WAIT_L(n) asm volatile("s_waitcnt lgkmcnt(" #n ")" ::: "memory")
#define PG8_BAR __builtin_amdgcn_s_barrier()
#define PG8_SCHED __builtin_amdgcn_sched_barrier(0)
    Unit cur, nxt; int ui = 0;
    if (!S.next(0, cur)) return;
    f32x4 acc[2][2][4][2];
#pragma unroll
    for (int a = 0; a < 2; ++a)
#pragma unroll
        for (int b = 0; b < 2; ++b)
#pragma unroll
            for (int m = 0; m < 4; ++m)
#pragma unroll
                for (int n = 0; n < 2; ++n) acc[a][b][m][n] = (f32x4){0.f, 0.f, 0.f, 0.f};
    const int f8scale = 0x7f7f7f7f;
    bf16x8 At[4][2], B0[2][2], B1[2][2]; v8i_t At8[4], B08[2], B18[2];
    unsigned vc00, vc01, vc10, vc11, vn00, vn01, vn10, vn11;
    vc00 = S.arow(cur, RA[0]) + CA[0] * 2; vc01 = S.arow(cur, RA[1]) + CA[1] * 2;
    vc10 = S.arow(cur, 128 + RA[0]) + CA[0] * 2; vc11 = S.arow(cur, 128 + RA[1]) + CA[1] * 2;
    const char* cA = cur.A; const char* cB = cur.B;
    PG8_STGB(PG8_SB(0, 0), cB); PG8_STG(PG8_SA(0, 0), cA, vc00, vc01); PG8_STGB(PG8_SB(0, 1), cB + hstepB); PG8_STG(PG8_SA(0, 1), cA, vc10, vc11);
    if (wr == 1) PG8_BAR;
    PG8_WAIT_V(4); PG8_BAR;
    PG8_STGB(PG8_SB(1, 0), cB + kstep); PG8_STG(PG8_SA(1, 0), cA + kstep, vc00, vc01); PG8_STGB(PG8_SB(1, 1), cB + hstepB + kstep);
    PG8_WAIT_V(6); PG8_BAR;
    for (;;) {
        const bool has_next = S.next(ui + 1, nxt);
        const char* nA = has_next ? nxt.A : cA; const char* nB = has_next ? nxt.B : cB;
        if (has_next) {
            vn00 = S.arow(nxt, RA[0]) + CA[0] * 2; vn01 = S.arow(nxt, RA[1]) + CA[1] * 2;
            vn10 = S.arow(nxt, 128 + RA[0]) + CA[0] * 2; vn11 = S.arow(nxt, 128 + RA[1]) + CA[1] * 2;
        } else { vn00 = vc00; vn01 = vc01; vn10 = vc10; vn11 = vc11; }
        const int ntu = S.ktiles(cur, nt);
#pragma nounroll
        for (int t = 0; t < ntu; t += 2) {
            const bool last = (t == ntu - 2);
            if (MIDT > 0 && t == MIDT) E.mid(acc, cur, wr, wc, fr, fq);
            const char* a1 = cA + (size_t)(t + 1) * kstep;
            const char* a2 = last ? nA : cA + (size_t)(t + 2) * kstep; const char* b2 = last ? nB : cB + (size_t)(t + 2) * kstep;
            const char* a3 = a2 + kstep; const char* b3 = b2 + kstep;
            const unsigned w00 = last ? vn00 : vc00, w01 = last ? vn01 : vc01, w10 = last ? vn10 : vc10, w11 = last ? vn11 : vc11;
            PG8_LDB(B0, 0, 0); PG8_SCHED; PG8_LDA(At, 0, 0); PG8_STG(PG8_SA(1, 1), a1, vc10, vc11);
            PG8_WAIT_L(8); PG8_BAR; PG8_WAIT_L(0); PG8_MMA(0, 0, At, B0); PG8_BAR; PG8_SCHED;
            PG8_LDB(B1, 0, 1); PG8_STGB(PG8_SB(0, 0), b2);
            PG8_BAR; PG8_WAIT_L(0); PG8_MMA(0, 1, At, B1); PG8_BAR;
            PG8_LDA(At, 0, 1); PG8_STG(PG8_SA(0, 0), a2, w00, w01);
            PG8_BAR; PG8_WAIT_L(0); PG8_MMA(1, 0, At, B0); PG8_BAR; PG8_SCHED;
            PG8_STGB(PG8_SB(0, 1), b2 + hstepB);
            PG8_WAIT_V(6); PG8_BAR; PG8_MMA(1, 1, At, B1); PG8_BAR;
            PG8_LDB(B0, 1, 0); PG8_SCHED; PG8_LDA(At, 1, 0); PG8_STG(PG8_SA(0, 1), a2, w10, w11);
            PG8_WAIT_L(8); PG8_BAR; PG8_WAIT_L(0); PG8_MMA(0, 0, At, B0); PG8_BAR; PG8_SCHED;
            PG8_LDB(B1, 1, 1); PG8_STGB(PG8_SB(1, 0), b3);
            PG8_BAR; PG8_WAIT_L(0); PG8_MMA(0, 1, At, B1); PG8_BAR;
            PG8_LDA(At, 1, 1); PG8_STG(PG8_SA(1, 0), a3, w00, w01);
            PG8_BAR; PG8_WAIT_L(0); PG8_MMA(1, 0, At, B0); PG8_BAR; PG8_SCHED;
            PG8_STGB(PG8_SB(1, 1), b3 + hstepB);
            PG8_WAIT_V(6); PG8_BAR; PG8_MMA(1, 1, At, B1); PG8_BAR;
        }
        if constexpr (F8) asm volatile("s_nop 15\n\ts_nop 15" ::: "memory");
        if (!FUSED) { E(acc, cur, wr, wc, fr, fq); if (EPIREP > 1) { asm volatile("s_waitcnt vmcnt(0)" ::: "memory"); E(acc, cur, wr, wc, fr, fq); } }
        if (!has_next) break;
#pragma unroll
        for (int a = 0; a < 2; ++a)
#pragma unroll
            for (int b = 0; b < 2; ++b)
#pragma unroll
                for (int m = 0; m < 4; ++m)
#pragma unroll
                    for (int n = 0; n < 2; ++n) acc[a][b][m][n] = (f32x4){0.f, 0.f, 0.f, 0.f};
        cur = nxt; cA = nA; cB = nB; ++ui;
        vc00 = vn00; vc01 = vn01; vc10 = vn10; vc11 = vn11;
    }
    PG8_WAIT_V(0);
    if (wr == 0) PG8_BAR;
    PG8_BAR;
    if constexpr (FUSED) E.final(acc, cur, wr, wc, fr, fq, lds);
#undef PG8_SA
#undef PG8_SB
#undef PG8_STG
#undef PG8_STGB
#undef PG8_LDA
#undef PG8_LDB
#undef PG8_MMA
#undef PG8_WAIT_V
#undef PG8_WAIT_L
#undef PG8_BAR
#undef PG8_SCHED
}
struct DenseOrder {
    const char* A; const char* B; int lda, ldb, nM, nN, G, c, rep;
    DEVINL bool next(int i, Unit& u) const {
        const int nwg = nM * nN; const long L = (long)i * G + c; if (L >= (long)nwg * rep) return false;
        int wgid = (int)(L % nwg); { const int q = nwg / 8, r = nwg % 8, xcd = wgid % 8, off = wgid / 8; wgid = (xcd < r ? xcd * (q + 1) : r * (q + 1) + (xcd - r) * q) + off; }
        const int nig = 8 * nN, gid = wgid / nig, fm = gid * 8, gsz = (nM - fm) < 8 ? (nM - fm) : 8;
        const int pm = fm + ((wgid % nig) % gsz), pn = (wgid % nig) / gsz;
        u.A = A + (size_t)pm * 256 * lda * 2; u.B = B + (size_t)pn * 256 * ldb * 2; u.a0 = pm; u.a1 = pn; u.a2 = 0; u.a3 = 0; return true;
    }
    DEVINL unsigned arow(const Unit&, int r) const { return (unsigned)(r * lda) * 2u; }
    DEVINL int ktiles(const Unit&, int nt) const { return nt; }
};
}

DEVINL int drow_map(int mode, int n) {
    switch (mode) {
        case 1: {
            if (n < 256) return n;
            if (n < 384) return 256 + (n - 256);
            if (n < 416) return 384 + (n - 384);
            if (n < 928) return 512 + (n - 416);
            const int c = n - 928, gq = c >> 6, ch = c & 63;
            return 1024 + (gq >> 2) * 256 + 128 * (ch >> 5) + 32 * (gq & 3) + (ch & 31);
        }
        case 2: { const int h = n / 96, d = n - h * 96; return d < 64 ? h * 64 + d : 512 + h * 32 + (d - 64); }
        case 5: { const int h = n >> 7, d = n & 127; return d < 64 ? h * 64 + d : 512 + h * 64 + (d - 64); }
        case 3: { const int hb = n >> 4; return (hb >> 3) * 256 + (hb & 1) * 128 + ((hb >> 1) & 3) * 32 + (n & 15); }
        case 4: { const int hb = n >> 4; return (hb >> 3) * 256 + (hb & 1) * 128 + ((hb >> 1) & 3) * 32 + 16 + (n & 15); }
        default: return n;
    }
}
DEVINL void tr_tile(const float* __restrict__ src, int ld_s, int k0, int n0, int Nlim, bf16_t* __restrict__ dst, int ld_d,
                    const float* __restrict__ gain, int mode, float* smf, const bool f8 = false) {
    int t = threadIdx.x; asm volatile("" : "+v"(t));
    __syncthreads();
#pragma unroll
    for (int i = 0; i < 2; ++i) {
        const int c = t + NTHR * i, r = c >> 4, c4 = (c & 15) * 4, n = n0 + c4;
        float4 v = make_float4(0.f, 0.f, 0.f, 0.f);
        if (n < Nlim) { const f32x4 t4 = __builtin_nontemporal_load((const f32x4*)(src + (size_t)(k0 + r) * ld_s + n)); v = make_float4(t4[0], t4[1], t4[2], t4[3]); }
        const float g = gain ? gain[k0 + r] : 1.f;
        smf[r * 65 + c4 + 0] = v.x * g; smf[r * 65 + c4 + 1] = v.y * g; smf[r * 65 + c4 + 2] = v.z * g; smf[r * 65 + c4 + 3] = v.w * g;
    }
    __syncthreads();
    {
        const int c = t, nn = c >> 3, kc = (c & 7) * 8, n = n0 + nn;
        if (n < Nlim) {
            float e[8];
#pragma unroll
            for (int j = 0; j < 8; ++j) e[j] = smf[(kc + j) * 65 + nn];
            if (f8) {
                *(uint2*)((unsigned char*)dst + (size_t)drow_map(mode, n) * ld_d + k0 + kc) = make_uint2(pack4_f8(e[0] * F8_WSCALE, e[1] * F8_WSCALE, e[2] * F8_WSCALE, e[3] * F8_WSCALE),
                                                                                                        pack4_f8(e[4] * F8_WSCALE, e[5] * F8_WSCALE, e[6] * F8_WSCALE, e[7] * F8_WSCALE));
            } else {
                uint4 o; o.x = pack2(e[0], e[1]); o.y = pack2(e[2], e[3]); o.z = pack2(e[4], e[5]); o.w = pack2(e[6], e[7]);
                *(uint4*)(dst + (size_t)drow_map(mode, n) * ld_d + k0 + kc) = o;
            }
        }
    }
}

DEVINL void cvt8(const float* __restrict__ s, bf16_t* __restrict__ d) {
    const f32x4 a4 = __builtin_nontemporal_load((const f32x4*)s), b4 = __builtin_nontemporal_load((const f32x4*)(s + 4));
    const float4 a = make_float4(a4[0], a4[1], a4[2], a4[3]), b = make_float4(b4[0], b4[1], b4[2], b4[3]);
    uint4 o; o.x = pack2(a.x, a.y); o.y = pack2(a.z, a.w); o.z = pack2(b.x, b.y); o.w = pack2(b.z, b.w);
    *(uint4*)d = o;
}

#ifndef WD_SPLIT_V
#define WD_SPLIT_V 4
#endif
constexpr int WD_SPLIT = WD_SPLIT_V;
constexpr int E_SPLIT = E_SPLIT_V;
DEVINL void conv_gateup_tile(const Params& p, const WS& s, int v, float* smf) {
    const int e = v >> 8, r = v & 255, up = r >> 7, q = r & 127, kt = q >> 3, nt = q & 7;
    tr_tile((up ? p.w_up : p.w_gate) + (size_t)e * 1024 * 512, 512, kt * 64, nt * 64, 512, s.wgu + (size_t)e * 1024 * 1024, 1024, nullptr, up ? 4 : 3, smf);
}
DEVINL void conv_down_tile(const Params& p, const WS& s, int v, float* smf) {
    const int e = v >> 7, r = v & 127, kt = r >> 4, nt = r & 15;
    tr_tile(p.w_down + (size_t)e * 512 * 1024, 1024, kt * 64, nt * 64, 1024, s.wd + (size_t)e * 1024 * 512, 512, nullptr, 0, smf);
}
DEVINL void cet_load(const Params& p, int kind, int v, int lr, int lc4, f32x4& a, f32x4& b) {
    const float* src; int ld_s, k0, n0;
    if (kind == 0) { const int e_ = v >> 8, r_ = v & 255, up_ = r_ >> 7, q_ = r_ & 127; k0 = (q_ >> 3) * 64; n0 = (q_ & 7) * 64; src = (up_ ? p.w_up : p.w_gate) + (size_t)e_ * 1024 * 512; ld_s = 512; }
    else { const int e_ = v >> 7, r_ = v & 127; k0 = (r_ >> 4) * 64; n0 = (r_ & 15) * 64; src = p.w_down + (size_t)e_ * 512 * 1024; ld_s = 1024; }
    a = __builtin_nontemporal_load((const f32x4*)(src + (size_t)(k0 + lr) * ld_s + n0 + lc4));
    b = __builtin_nontemporal_load((const f32x4*)(src + (size_t)(k0 + lr + 32) * ld_s + n0 + lc4));
}
DEVINL void cet_store(const WS& s, int kind, int v, const float* sm, int nn, int kc) {
    unsigned char* dst; int ld_d, mode, k0, n0;
    if (kind == 0) { const int e_ = v >> 8, r_ = v & 255, up_ = r_ >> 7, q_ = r_ & 127; k0 = (q_ >> 3) * 64; n0 = (q_ & 7) * 64; dst = s.wgu8 + (size_t)e_ * 1024 * 1024; ld_d = 1024; mode = up_ ? 4 : 3; }
    else { const int e_ = v >> 7, r_ = v & 127; k0 = (r_ >> 4) * 64; n0 = (r_ & 15) * 64; dst = s.wd8 + (size_t)e_ * 1024 * 512; ld_d = 512; mode = 0; }
    float e[8];
#pragma unroll
    for (int j = 0; j < 8; ++j) e[j] = sm[(kc + j) * 65 + nn];
    *(uint2*)(dst + (size_t)drow_map(mode, n0 + nn) * ld_d + k0 + kc) = make_uint2(pack4_f8(e[0] * F8_WSCALE, e[1] * F8_WSCALE, e[2] * F8_WSCALE, e[3] * F8_WSCALE),
                                                                                 pack4_f8(e[4] * F8_WSCALE, e[5] * F8_WSCALE, e[6] * F8_WSCALE, e[7] * F8_WSCALE));
}
DEVINL void cet_lds(float* sm, int lr, int lc4, f32x4 a, f32x4 b) {
    sm[lr * 65 + lc4 + 0] = a[0]; sm[lr * 65 + lc4 + 1] = a[1]; sm[lr * 65 + lc4 + 2] = a[2]; sm[lr * 65 + lc4 + 3] = a[3];
    sm[(lr + 32) * 65 + lc4 + 0] = b[0]; sm[(lr + 32) * 65 + lc4 + 1] = b[1]; sm[(lr + 32) * 65 + lc4 + 2] = b[2]; sm[(lr + 32) * 65 + lc4 + 3] = b[3];
}
struct CetPre { f32x4 a0, a1, b0, b1; };
DEVINL void cet_prefetch(const Params& p, int kind, int first, int last, int stride, CetPre& q) {
    int t = threadIdx.x; asm volatile("" : "+v"(t));
    q.a0 = q.a1 = q.b0 = q.b1 = (f32x4){0.f, 0.f, 0.f, 0.f};
    if (first < last) cet_load(p, kind, first, t >> 4, (t & 15) * 4, q.a0, q.a1);
    if (first + stride < last) cet_load(p, kind, first + stride, t >> 4, (t & 15) * 4, q.b0, q.b1);
}
DEVINL void conv_expert_tiles(const Params& p, const WS& s, int kind, int first, int last, int stride, float* smf, const CetPre* pre = nullptr) {
    if (first >= last) return;
    int t = threadIdx.x; asm volatile("" : "+v"(t));
    const int lr = t >> 4, lc4 = (t & 15) * 4;
    const int nn = t >> 3, kc = (t & 7) * 8;
    f32x4 a0 = {0.f, 0.f, 0.f, 0.f}, a1 = a0, b0 = a0, b1 = a0;
    if (pre) { a0 = pre->a0; a1 = pre->a1; b0 = pre->b0; b1 = pre->b1; }
    else {
        cet_load(p, kind, first, lr, lc4, a0, a1);
        if (first + stride < last) cet_load(p, kind, first + stride, lr, lc4, b0, b1);
    }
    __syncthreads();
    int v = first;
    for (;;) {
        cet_lds(smf, lr, lc4, a0, a1);
        if (v + 2 * stride < last) cet_load(p, kind, v + 2 * stride, lr, lc4, a0, a1);
        __syncthreads();
        cet_store(s, kind, v, smf, nn, kc);
        v += stride; if (v >= last) break;
        cet_lds(smf + 64 * 65, lr, lc4, b0, b1);
        if (v + 2 * stride < last) cet_load(p, kind, v + 2 * stride, lr, lc4, b0, b1);
        __syncthreads();
        cet_store(s, kind, v, smf + 64 * 65, nn, kc);
        v += stride; if (v >= last) break;
    }
    __syncthreads();
}
DEVINL void helper_slot(int U, int G, int c, int& j, int& nh) {
    const int R = (U + G - 1) / G, nidle = R * G - U;
    if (nidle >= 64) { nh = nidle; j = c - (G - nidle); } else { nh = G; j = c; }
}
__device__ void phase0(const Params& p, unsigned char* smem) {
    const WS s = make_ws(p.ws, p.out);
    const int G = gridDim.x, bid = blockIdx.x, t = threadIdx.x;
    const size_t gtid = (size_t)bid * NTHR + t, gstride = (size_t)G * NTHR;
    for (size_t i0 = gtid; i0 < (size_t)T_ * D_ / 8 * P0_REP; i0 += gstride) { const size_t i = i0 % ((size_t)T_ * D_ / 8); cvt8(p.x + i * 8, s.xb + i * 8); }
    for (size_t i = gtid; i < (size_t)T_ * 256 / 8; i += gstride) cvt8(p.p + i * 8, s.pb + i * 8);
    CetPre cpre; cet_prefetch(p, 0, bid, E_SPLIT * 256, G, cpre);
    for (size_t i = gtid; i < 8 * 128 * 128 / 8; i += gstride) {
        const int e0 = (int)i * 8, tt = (e0 >> 7) & 127, s0 = e0 & 127;
        float v[8];
#pragma unroll
        for (int j = 0; j < 8; ++j) v[j] = (s0 + j <= tt) ? p.gm_w_s[e0 + j] : 0.f;
        uint4 o; o.x = pack2(v[0], v[1]); o.y = pack2(v[2], v[3]); o.z = pack2(v[4], v[5]); o.w = pack2(v[6], v[7]);
        *(uint4*)(s.wsb + e0) = o;
    }
    for (size_t i = gtid; i < 48 * 1024; i += gstride) {
        const int n = (int)i >> 10, k = (int)i & 1023;
        const float wv = n < 4 ? p.w_rg[k * 4 + n] : (n < 36 ? p.w_re[k * 32 + (n - 4)] : 0.f);
        const unsigned hi = pack2(wv, 0.f) & 0xffffu; const float r1 = wv - bf2f((unsigned short)hi);
        const unsigned mid = pack2(r1, 0.f) & 0xffffu; const float r2 = r1 - bf2f((unsigned short)mid);
        const unsigned lo = pack2(r2, 0.f) & 0xffffu;
        s.wr3[i] = (bf16_t)hi; s.wr3[48 * 1024 + i] = (bf16_t)mid; s.wr3[2 * 48 * 1024 + i] = (bf16_t)lo;
    }
    for (size_t i = gtid; i < (size_t)T_ * 16; i += gstride) {
        const int tok = (int)(i >> 4), j = (int)i & 15;
        const float ang = (float)p.pos[tok] * p.inv_freq[j];
        float sn, cs; sincosf(ang, &sn, &cs);
        s.cs[i] = make_float2(cs, sn);
    }
    for (size_t i = gtid; i < 96 * 1024 / 8; i += gstride) *(uint4*)(s.win + 416 * 1024 + i * 8) = make_uint4(0, 0, 0, 0);
    if (bid == 0 && t < 32) s.cnt[t * 64] = 0;
    float* smf = (float*)smem;
    constexpr int J0 = 368, J1 = J0 + 48, J2 = J1 + 32, J3 = J2 + 256, J4 = J3 + 256, J5 = J4 + 64, J6 = J5;
    for (int u0 = bid; u0 < J6 * P0_REP; u0 += G) {
        const int u = u0 % J6;
        if (u < J0) { const int kt = u / 23, nt = u % 23; tr_tile(p.w_in, 1440, kt * 64, nt * 64, 1440, s.win, 1024, nullptr, 1, smf); }
        else if (u < J1) { const int v = u - J0, kt = v / 12, nt = v % 12; tr_tile(p.w_q_up, 768, kt * 64, nt * 64, 768, s.wq, 256, p.q_norm_g, 2, smf); }
        else if (u < J2) { const int v = u - J1, kt = v / 16, nt = v % 16; tr_tile(p.w_kv_up, 1024, kt * 64, nt * 64, 1024, s.wkv2, 256, p.kv_norm_g, 5, smf); }
        else if (u < J3) { const int v = u - J2, kt = v / 16, nt = v % 16; tr_tile(p.w_o, 1024, kt * 64, nt * 64, 1024, s.wo, 1024, kt < 8 ? p.mla_out_g : p.gm_out_g - 512, 0, smf); }
        else if (u < J4) { const int v = u - J3, kt = v / 16, nt = v % 16; tr_tile(p.w_pg, 1024, kt * 64, nt * 64, 1024, s.wpg, 1024, nullptr, 0, smf, true); }
        else if (u < J5) { const int v = u - J4, kt = v / 16, nt = v % 16; tr_tile(p.w_pp, 1024, kt * 64, nt * 64, 1024, s.wpp, 256, nullptr, 0, smf); }
    }
    conv_expert_tiles(p, s, 0, bid, E_SPLIT * 256, G, smf, &cpre);
}

struct EpiP1 {
    const Params* p; WS s; unsigned char* smem;
    DEVINL void mid(f32x4 (&)[2][2][4][2], const pg8::Unit&, int, int, int, int) const {}
    DEVINL void operator()(const f32x4 (&acc)[2][2][4][2], const pg8::Unit& u, int wr, int wc, int fr, int fq) const {
        const int pm = u.a0, pn = u.a1;
        if (pn < 2) {
            float* red = (float*)(smem + LDS_RED);
            float4 ck[2][4][2];
            if (pn == 1 && wc == 0) {
#pragma unroll
                for (int ai = 0; ai < 2; ++ai)
#pragma unroll
                    for (int m = 0; m < 4; ++m) {
                        const float4* cp = (const float4*)(s.cs + (size_t)(pm * 256 + ai * 128 + wr * 64 + m * 16 + fr) * 16 + fq * 4);
                        ck[ai][m][0] = cp[0]; ck[ai][m][1] = cp[1];
                    }
            }
#pragma unroll
            for (int ai = 0; ai < 2; ++ai)
#pragma unroll
                for (int m = 0; m < 4; ++m) {
                    float ss = 0.f;
#pragma unroll
                    for (int bj = 0; bj < 2; ++bj)
#pragma unroll
                        for (int n = 0; n < 2; ++n) if (pn == 0 || bj == 0) { const f32x4 v = acc[ai][bj][m][n]; ss += v[0] * v[0] + v[1] * v[1] + v[2] * v[2] + v[3] * v[3]; }
                    ss = quad_sum(ss);
                    if (fq == 0) red[(ai * 128 + wr * 64 + m * 16 + fr) * 4 + wc] = ss;
                }
            __syncthreads();
#pragma unroll
            for (int ai = 0; ai < 2; ++ai)
#pragma unroll
                for (int m = 0; m < 4; ++m) {
                    const int rl = ai * 128 + wr * 64 + m * 16 + fr, row = pm * 256 + rl;
                    const f32x4 r4 = *(const f32x4*)(red + rl * 4);
                    const float rstd = rsqrtf(((r4[0] + r4[1]) + (r4[2] + r4[3])) * (pn == 0 ? 1.f / 256.f : 1.f / 128.f) + EPS_);
                    if (pn == 0) {
#pragma unroll
                        for (int bj = 0; bj < 2; ++bj)
                            *(uint4*)(s.latq + (size_t)row * 256 + bj * 128 + wc * 32 + wide_col(fq)) = widen_pair(pack4v(acc[ai][bj][m][0] * rstd), pack4v(acc[ai][bj][m][1] * rstd));
                    } else {
                        *(uint4*)(s.latkv + (size_t)row * 256 + wc * 32 + wide_col(fq)) = widen_pair(pack4v(acc[ai][0][m][0] * rstd), pack4v(acc[ai][0][m][1] * rstd));
                        if (wc == 0) {
                            float o1[4], o2[4];
                            const float2 cr[4] = {make_float2(ck[ai][m][0].x, ck[ai][m][0].y), make_float2(ck[ai][m][0].z, ck[ai][m][0].w), make_float2(ck[ai][m][1].x, ck[ai][m][1].y), make_float2(ck[ai][m][1].z, ck[ai][m][1].w)};
#pragma unroll
                            for (int r = 0; r < 4; ++r) {
                                const float2 c = cr[r];
                                const float x1 = acc[ai][1][m][0][r], x2 = acc[ai][1][m][1][r];
                                o1[r] = x1 * c.x - x2 * c.y; o2[r] = x1 * c.y + x2 * c.x;
                            }
                            *(uint4*)(s.kr + (size_t)row * 32 + wide_col(fq)) = widen_pair(pack4(o1[0], o1[1], o1[2], o1[3]), pack4(o2[0], o2[1], o2[2], o2[3]));
                        }
                    }
                }
            __syncthreads();
            return;
        }
        float4 vg[2][2], vb[2][2];
        if (pn >= 4) {
#pragma unroll
            for (int bj = 0; bj < 2; ++bj)
#pragma unroll
                for (int n = 0; n < 2; ++n) { const int ch = ((pn - 4) * 4 + wc) * 64 + bj * 32 + n * 16 + fq * 4; vg[bj][n] = *(const float4*)(p->gm_ln_g + ch); vb[bj][n] = *(const float4*)(p->gm_ln_b + ch); }
        }
#pragma unroll
        for (int ai = 0; ai < 2; ++ai)
#pragma unroll
            for (int m = 0; m < 4; ++m) {
                const int row = pm * 256 + ai * 128 + wr * 64 + m * 16 + fr;
                if (pn < 4) {
#pragma unroll
                    for (int bj = 0; bj < 2; ++bj) {
                        const f32x4 v0 = acc[ai][bj][m][0], v1 = acc[ai][bj][m][1];
                        *(uint4*)(s.u + (size_t)row * 1024 + (pn - 2) * 256 + bj * 128 + wc * 32 + wide_col(fq)) =
                            widen_pair(pack4v(gelu4(v0)), pack4v(gelu4(v1)));
                    }
                } else {
                    float gv[2][2][4]; float sum = 0.f;
#pragma unroll
                    for (int bj = 0; bj < 2; ++bj)
#pragma unroll
                        for (int n = 0; n < 2; ++n)
{ const f32x4 g4 = gelu4(acc[ai][bj][m][n]);
#pragma unroll
                              for (int r = 0; r < 4; ++r) { gv[bj][n][r] = g4[r]; sum += g4[r]; } }
                    sum = quad_sum(sum);
                    const float mean = sum * (1.f / 64.f); float sq = 0.f;
#pragma unroll
                    for (int bj = 0; bj < 2; ++bj)
#pragma unroll
                        for (int n = 0; n < 2; ++n)
#pragma unroll
                            for (int r = 0; r < 4; ++r) { const float d = gv[bj][n][r] - mean; sq += d * d; }
                    sq = quad_sum(sq);
                    const float rstd = rsqrtf(sq * (1.f / 64.f) + EPS_);
                    const int g = (pn - 4) * 4 + wc;
#pragma unroll
                    for (int bj = 0; bj < 2; ++bj) {
                        uint2 pk[2];
#pragma unroll
                        for (int n = 0; n < 2; ++n) {
                            const float4 gg = vg[bj][n], bb = vb[bj][n];
                            pk[n] = pack4((gv[bj][n][0] - mean) * rstd * gg.x + bb.x, (gv[bj][n][1] - mean) * rstd * gg.y + bb.y,
                                          (gv[bj][n][2] - mean) * rstd * gg.z + bb.z, (gv[bj][n][3] - mean) * rstd * gg.w + bb.w);
                        }
                        *(uint4*)(s.vln + (size_t)row * 512 + g * 64 + bj * 32 + wide_col(fq)) = widen_pair(pk[0], pk[1]);
                    }
                }
            }
    }
};
__device__ void phase1(const Params& p, unsigned char* smem) {
    const WS s = make_ws(p.ws, p.out);
    pg8::DenseOrder S{(const char*)s.xb, (const char*)s.win, 1024, 1024, 64, 6, (int)gridDim.x, (int)blockIdx.x, REP_P1};
    EpiP1 E{&p, s, smem};
    pg8::gemm_phase<0, false, (EPI2 == 1 ? 2 : 1)>((LAS unsigned char*)smem, S, E, 1024, 1024);
    int j, nh; helper_slot(64 * 6 * REP_P1, (int)gridDim.x, (int)blockIdx.x, j, nh);
    if (j >= 0) { conv_expert_tiles(p, s, 0, E_SPLIT * 256 + j, 32 * 256, nh, (float*)smem); conv_expert_tiles(p, s, 1, j, WD_SPLIT * 128, nh, (float*)smem); }
}

constexpr float QSCALE_ = 0.10206207261596577f * 1.4426950408889634f;
DEVINL size_t pp_off(int row, int col) { return (size_t)(row >> 8) * 1048576 + 524288 + (size_t)(row & 255) * 1024 + col; }
struct EpiP9a {
    bf16_t* pp;
    DEVINL void mid(f32x4 (&)[2][2][4][2], const pg8::Unit&, int, int, int, int) const {}
    DEVINL void operator()(const f32x4 (&acc)[2][2][4][2], const pg8::Unit& u, int wr, int wc, int fr, int fq) const {
#pragma unroll
        for (int ai = 0; ai < 2; ++ai)
#pragma unroll
            for (int m = 0; m < 4; ++m) {
                const int row = u.a0 * 256 + ai * 128 + wr * 64 + m * 16 + fr;
#pragma unroll
                for (int bj = 0; bj < 2; ++bj)
                {
                    const f32x4 y0 = acc[ai][bj][m][0] * F8_YSCALE, y1 = acc[ai][bj][m][1] * F8_YSCALE;
                    *(uint2*)((unsigned char*)pp + pp_off(row, u.a1 * 256 + bj * 128 + wc * 32 + wide_col(fq))) = widen_pair8(pack4_f8(y0[0], y0[1], y0[2], y0[3]), pack4_f8(y1[0], y1[1], y1[2], y1[3]));
                }
            }
    }
};
struct PpOrder {
    const char* A; const char* B; int mode, G, c;
    DEVINL bool next(int i, pg8::Unit& u) const {
        const int v = i * G + c, cnt = mode == 0 ? 256 : (mode == 1 ? 64 : 192); if (v >= cnt) return false;
        const int id = mode == 0 ? v : (mode == 1 ? 160 + v : (v < 160 ? v : v + 64)), pm = id >> 2, pn = id & 3;
        u.A = A + (size_t)pm * 256 * 256 * 2; u.B = B + (size_t)pn * 256 * 256 * 2; u.a0 = pm; u.a1 = pn; u.a2 = 0; u.a3 = 0; return true;
    }
    DEVINL unsigned arow(const pg8::Unit&, int r) const { return (unsigned)r * 512u; }
    DEVINL int ktiles(const pg8::Unit&, int nt) const { return nt; }
};
DEVINL int p2_pos(int c, int G) {
    if (G != 256) return c;
    const int x = c & 7, j = c >> 3;
    return j < 24 ? x * 24 + j : 192 + x * 8 + (j - 24);
}
struct P2Order {
    const char *latq, *latkv, *wq, *wkv2; int G, c;
    DEVINL bool next(int i, pg8::Unit& u) const {
        const int L = i * G + p2_pos(c, G); if (L >= 448) return false;
        if (L < 192) { const int pm = L / 3, pn = L - pm * 3; u.A = latq + (size_t)pm * 256 * 512; u.B = wq + (size_t)pn * 256 * 512; u.a0 = pm; u.a1 = pn; u.a2 = 0; }
        else if (L < 320) { const int v = L - 192, pm = v >> 1, pn = v & 1; u.A = latkv + (size_t)pm * 256 * 512; u.B = wkv2 + (size_t)pn * 256 * 512; u.a0 = pm; u.a1 = pn; u.a2 = 1; }
        else { const int v = L - 320, pn = v >> 1, pm = v & 1; u.A = wkv2 + (size_t)(512 + pm * 256) * 512; u.B = latkv + (size_t)pn * 256 * 512; u.a0 = pm; u.a1 = pn; u.a2 = 2; }
        u.a3 = 0; return true;
    }
    DEVINL unsigned arow(const pg8::Unit&, int r) const { return (unsigned)r * 512u; }
    DEVINL int ktiles(const pg8::Unit& u, int nt) const { return u.a2 == 0 ? nt : 2; }
};
struct EpiP2 {
    WS s;
    DEVINL void mid(f32x4 (&)[2][2][4][2], const pg8::Unit&, int, int, int, int) const {}
    DEVINL void operator()(const f32x4 (&acc)[2][2][4][2], const pg8::Unit& u, int wr, int wc, int fr, int fq) const {
        if (u.a2 < 2) {
            if (u.a2 == 1) {
#pragma unroll
                for (int ai = 0; ai < 2; ++ai)
#pragma unroll
                    for (int m = 0; m < 4; ++m) {
                        const int row = u.a0 * 256 + ai * 128 + wr * 64 + m * 16 + fr;
#pragma unroll
                        for (int bj = 0; bj < 2; ++bj) {
                            const int col = u.a1 * 256 + bj * 128 + wc * 32 + wide_col(fq);
                            *(uint4*)(s.k + ((size_t)row * 8 + (col >> 6)) * 64 + (col & 63)) = widen_pair(pack4v(acc[ai][bj][m][0]), pack4v(acc[ai][bj][m][1]));
                        }
                    }
            } else if (u.a1 < 2) {
#pragma unroll
                for (int ai = 0; ai < 2; ++ai)
#pragma unroll
                    for (int m = 0; m < 4; ++m) {
                        const int row = u.a0 * 256 + ai * 128 + wr * 64 + m * 16 + fr;
#pragma unroll
                        for (int bj = 0; bj < 2; ++bj) {
                            const int col = u.a1 * 256 + bj * 128 + wc * 32 + wide_col(fq);
                            *(uint4*)(s.q + ((size_t)row * 8 + (col >> 6)) * 96 + (col & 63)) = widen_pair(pack4v(acc[ai][bj][m][0] * QSCALE_), pack4v(acc[ai][bj][m][1] * QSCALE_));
                        }
                    }
            } else {
#pragma unroll
                for (int ai = 0; ai < 2; ++ai) {
                    float4 cq[4][2];
#pragma unroll
                    for (int m = 0; m < 4; ++m) { const float4* cp = (const float4*)(s.cs + (size_t)(u.a0 * 256 + ai * 128 + wr * 64 + m * 16 + fr) * 16 + fq * 4); cq[m][0] = cp[0]; cq[m][1] = cp[1]; }
#pragma unroll
                    for (int m = 0; m < 4; ++m) {
                        const int row = u.a0 * 256 + ai * 128 + wr * 64 + m * 16 + fr;
                        const float4 c01 = cq[m][0], c23 = cq[m][1];
                        const float2 csr[4] = {make_float2(c01.x, c01.y), make_float2(c01.z, c01.w), make_float2(c23.x, c23.y), make_float2(c23.z, c23.w)};
#pragma unroll
                        for (int bj = 0; bj < 2; ++bj) {
                            const int h = bj * 4 + wc; float o1[4], o2[4];
#pragma unroll
                            for (int r = 0; r < 4; ++r) {
                                const float2 c = csr[r];
                                const float x1 = acc[ai][bj][m][0][r] * QSCALE_, x2 = acc[ai][bj][m][1][r] * QSCALE_;
                                o1[r] = x1 * c.x - x2 * c.y; o2[r] = x1 * c.y + x2 * c.x;
                            }
                            *(uint4*)(s.q + ((size_t)row * 8 + h) * 96 + 64 + wide_col(fq)) = widen_pair(pack4(o1[0], o1[1], o1[2], o1[3]), pack4(o2[0], o2[1], o2[2], o2[3]));
                        }
                    }
                }
            }
        } else {
#pragma unroll
            for (int bj = 0; bj < 2; ++bj) {
                const int tok = u.a1 * 256 + bj * 128 + wc * 32 + wide_col(fq);
                const int b = tok >> 11, sq = tok & 2047;
#pragma unroll
                for (int ai = 0; ai < 2; ++ai)
#pragma unroll
                    for (int m = 0; m < 4; ++m) {
                        const int ch = u.a0 * 256 + ai * 128 + wr * 64 + m * 16 + fr;
                        *(uint4*)(s.vT + ((size_t)(b * 512 + ch)) * 2048 + sq) = widen_pair(pack4v(acc[ai][bj][m][0]), pack4v(acc[ai][bj][m][1]));
                    }
            }
        }
    }
};
__device__ void gmlp_phase(const Params& p, const WS& s, bf16_t* smem, bf16_t* gout, int tmask) {
    constexpr int LDG = 144;
    int t = threadIdx.x; asm volatile("" : "+v"(t));
    const int lane = t & 63, w = t >> 6, r16 = lane & 15, g4 = (lane >> 4) * 4, kg = (lane >> 4) * 8;
    int u = blockIdx.x; const int ustep = 8 * (((int)gridDim.x - ((int)blockIdx.x & 7) + 7) >> 3), uend = 1024;
    if (u >= 1024) return;
    u32x4 ra0, ra1, ra2, ra3, rb0, rb1; uint4 ru0, ru1, cu0, cu1;
#define GM_LOAD(uu) do { const int cidx_ = (uu) >> 3, g_ = (uu) & 7, tok0_ = cidx_ * 128; \
        const bf16_t* vp_ = s.vln + (size_t)(tok0_ + 2 * lane) * 512 + g_ * 64 + w * 8; \
        rb0 = *(const u32x4*)(vp_); rb1 = *(const u32x4*)(vp_ + 512); \
        const bf16_t* up_ = s.u + (size_t)(tok0_ + w * 16 + r16) * 1024 + g_ * 64 + wide_col(lane >> 4); \
        ru0 = *(const uint4*)(up_); ru1 = *(const uint4*)(up_ + 32); } while (0)
#define GM_STORE(buf) do { bf16_t* sB_ = smem + 128 * LDG + (buf) * (64 * LDG); \
        unsigned* bd_ = (unsigned*)(sB_ + (w * 8) * LDG + 2 * lane); \
        bd_[0 * (LDG / 2)] = (rb0[0] & 0xffffu) | (rb1[0] << 16); bd_[1 * (LDG / 2)] = (rb0[0] >> 16) | (rb1[0] & 0xffff0000u); \
        bd_[2 * (LDG / 2)] = (rb0[1] & 0xffffu) | (rb1[1] << 16); bd_[3 * (LDG / 2)] = (rb0[1] >> 16) | (rb1[1] & 0xffff0000u); \
        bd_[4 * (LDG / 2)] = (rb0[2] & 0xffffu) | (rb1[2] << 16); bd_[5 * (LDG / 2)] = (rb0[2] >> 16) | (rb1[2] & 0xffff0000u); \
        bd_[6 * (LDG / 2)] = (rb0[3] & 0xffffu) | (rb1[3] << 16); bd_[7 * (LDG / 2)] = (rb0[3] >> 16) | (rb1[3] & 0xffff0000u); } while (0)
    __syncthreads();
    {
        const bf16_t* wp_ = s.wsb + ((size_t)(u & 7) * 128 + (t >> 4)) * 128 + (t & 15) * 8;
        ra0 = *(const u32x4*)(wp_); ra1 = *(const u32x4*)(wp_ + 32 * 128); ra2 = *(const u32x4*)(wp_ + 64 * 128); ra3 = *(const u32x4*)(wp_ + 96 * 128);
    }
    GM_LOAD(u);
    { bf16_t* ad_ = smem + (t >> 4) * LDG + (t & 15) * 8; *(u32x4*)(ad_) = ra0; *(u32x4*)(ad_ + 32 * LDG) = ra1; *(u32x4*)(ad_ + 64 * LDG) = ra2; *(u32x4*)(ad_ + 96 * LDG) = ra3; }
    GM_STORE(0);
    cu0 = ru0; cu1 = ru1;
    __syncthreads();
    int cur = 0;
#pragma nounroll
    for (;;) {
        const int un = u + ustep; const bool has_next = un < uend;
        if (has_next) GM_LOAD(un);
        const bf16_t* sA = smem; const bf16_t* sB = smem + 128 * LDG + cur * (64 * LDG);
        f32x4 acc[4];
#pragma unroll
        for (int j = 0; j < 4; ++j) acc[j] = (f32x4){0.f, 0.f, 0.f, 0.f};
#pragma unroll
        for (int ks = 0; ks < 4; ++ks) {
            const bf16x8 af = *(const bf16x8*)(sA + (w * 16 + r16) * LDG + ks * 32 + kg);
#pragma unroll
            for (int ni = 0; ni < 4; ++ni) {
                const bf16x8 bfr = *(const bf16x8*)(sB + (ni * 16 + r16) * LDG + ks * 32 + kg);
                acc[ni] = __builtin_amdgcn_mfma_f32_16x16x32_bf16(bfr, af, acc[ni], 0, 0, 0);
            }
        }
        {
            const int cidx = u >> 3, g = u & 7, tt = w * 16 + r16, tok = cidx * 128 + tt;
            const float bias = p.gm_b_s[g * 128 + tt]; float ss = 0.f;
            uint2 uu[4]; unwiden(cu0, uu[0], uu[1]); unwiden(cu1, uu[2], uu[3]);
            uint2 pk[4];
#pragma unroll
            for (int ni = 0; ni < 4; ++ni) {
                const f32x4 a = acc[ni];
                const float v0 = bflo(uu[ni].x) * (a[0] + bias), v1 = bfhi(uu[ni].x) * (a[1] + bias), v2 = bflo(uu[ni].y) * (a[2] + bias), v3 = bfhi(uu[ni].y) * (a[3] + bias);
                ss += v0 * v0 + v1 * v1 + v2 * v2 + v3 * v3;
                pk[ni] = pack4(v0, v1, v2, v3);
            }
#pragma unroll
            for (int ni = 0; ni < 4; ni += 2)
                *(uint4*)(gout + (size_t)(tok & tmask) * 1024 + g * 64 + ni * 16 + wide_col(lane >> 4)) = widen_pair(pk[ni], pk[ni + 1]);
            ss = quad_sum(ss);
            if (lane < 16) s.g_ss[tok * 8 + g] = ss;
        }
        if (!has_next) break;
        GM_STORE(cur ^ 1);
        cu0 = ru0; cu1 = ru1;
        __syncthreads();
        cur ^= 1; u = un;
    }
#undef GM_LOAD
#undef GM_STORE
}
__device__ void phase2(const Params& p, unsigned char* smem, bool do_gmlp = true) {
    const WS s = make_ws(p.ws, p.out);
    {
        P2Order S{(const char*)s.latq, (const char*)s.latkv, (const char*)s.wq, (const char*)s.wkv2, (int)gridDim.x, (int)blockIdx.x};
        EpiP2 E{s};
        pg8::gemm_phase<0, false, (EPI2 == 2 ? 2 : 1)>((LAS unsigned char*)smem, S, E, 256, 256);
    }
    if (do_gmlp && gridDim.x == 256 && p2_pos((int)blockIdx.x, 256) >= 192) {
        PpOrder Sa{(const char*)s.pb, (const char*)s.wpp, 1, 64, p2_pos((int)blockIdx.x, 256) - 192};
        EpiP9a Ea{(bf16_t*)p.out};
        pg8::gemm_phase<0, false>((LAS unsigned char*)smem, Sa, Ea, 256, 256);
    }
    if (do_gmlp) gmlp_phase(p, s, (bf16_t*)smem, s.go, 0xffffff);
}

DEVINL float quad_max(float x) {
    const unsigned u = __float_as_uint(x);
    const auto r = __builtin_amdgcn_permlane16_swap(u, u, false, false);
    const float m = fmaxf(__uint_as_float(r[0]), __uint_as_float(r[1]));
    const unsigned v = __float_as_uint(m);
    const auto q = __builtin_amdgcn_permlane32_swap(v, v, false, false);
    return fmaxf(__uint_as_float(q[0]), __uint_as_float(q[1]));
}
DEVINL bf16x8 as_bf16x8(u32x4 v) { return __builtin_bit_cast(bf16x8, v); }
constexpr float ATT_TAU = 12.f;
__device__ void attn_unit(const WS& s, int b, int h, int qb, bf16_t* smem) {
    constexpr int LK = 112, LV = 72;
    const int t = threadIdx.x, lane = t & 63, w = t >> 6, r16 = lane & 15, g = lane >> 4, kg = g * 8;
    const int q0 = qb * 256, tokb = b * 2048, qw0 = q0 + w * 32;
    bf16x8 qf[2][3];
#pragma unroll
    for (int ni = 0; ni < 2; ++ni)
#pragma unroll
        for (int ks = 0; ks < 3; ++ks)
            qf[ni][ks] = *(const bf16x8*)(s.q + ((size_t)(tokb + qw0 + ni * 16 + r16) * 8 + h) * 96 + ks * 32 + kg);
    f32x4 accO[4][2];
#pragma unroll
    for (int i = 0; i < 4; ++i)
#pragma unroll
        for (int j = 0; j < 2; ++j) accO[i][j] = (f32x4){0.f, 0.f, 0.f, 0.f};
    float mref[2] = {0.f, 0.f};
    f32x4 accL[2] = {(f32x4){0.f, 0.f, 0.f, 0.f}, (f32x4){0.f, 0.f, 0.f, 0.f}};
    const unsigned one2 = (r16 == 0) ? 0x3f803f80u : 0u;
    const bf16x8 vones = as_bf16x8((u32x4){one2, one2, one2, one2});
    const int nt = 4 * (qb + 1);
    const bf16_t* kp0; const bf16_t* kp1; int ks0, ks1, kd0, kd1;
    const bool k2 = t < 256;
    {
        int c = t, row = c / 12, part = c - row * 12;
        kp0 = part < 8 ? s.k + ((size_t)(tokb + row) * 8 + h) * 64 + part * 8 : s.kr + (size_t)(tokb + row) * 32 + (part - 8) * 8; ks0 = part < 8 ? 512 : 32; kd0 = row * LK + part * 8;
        c = k2 ? t + 512 : t; row = c / 12; part = c - row * 12;
        kp1 = part < 8 ? s.k + ((size_t)(tokb + row) * 8 + h) * 64 + part * 8 : s.kr + (size_t)(tokb + row) * 32 + (part - 8) * 8; ks1 = part < 8 ? 512 : 32; kd1 = row * LK + part * 8;
    }
    const int vrow = t >> 3, vkc = (t & 7) * 8;
    const bf16_t* vp0 = s.vT + ((size_t)((b * 8 + h) * 64 + vrow)) * 2048 + vkc;
    u32x4 rk0, rk1, rv0;
    rk0 = *(const u32x4*)kp0; rk1 = *(const u32x4*)kp1; rv0 = *(const u32x4*)vp0;
    constexpr int STG = 64 * LK + 64 * LV;
    __syncthreads();
    *(u32x4*)(smem + kd0) = rk0; if (k2) *(u32x4*)(smem + kd1) = rk1;
    *(u32x4*)(smem + 64 * LK + vrow * LV + vkc) = rv0;
    if (nt > 1) { rk0 = *(const u32x4*)(kp0 + (size_t)64 * ks0); rk1 = *(const u32x4*)(kp1 + (size_t)64 * ks1); rv0 = *(const u32x4*)(vp0 + 64); }
    __syncthreads();
#pragma nounroll
    for (int kt = 0; kt < nt; ++kt) {
        const bf16_t* sK = smem + (kt & 1) * STG; const bf16_t* sV = sK + 64 * LK;
        if (kt + 1 < nt) {
            bf16_t* dK = smem + ((kt + 1) & 1) * STG;
            *(u32x4*)(dK + kd0) = rk0; if (k2) *(u32x4*)(dK + kd1) = rk1;
            *(u32x4*)(dK + 64 * LK + vrow * LV + vkc) = rv0;
            if (kt + 2 < nt) {
                const int kn = (kt + 2) * 64;
                rk0 = *(const u32x4*)(kp0 + (size_t)kn * ks0); rk1 = *(const u32x4*)(kp1 + (size_t)kn * ks1);
                rv0 = *(const u32x4*)(vp0 + kn);
            }
        }
        const int key0 = kt * 64;
        if (key0 <= qw0 + 31) {
            f32x4 sacc[4][2];
            const f32x4 cin[2] = {(f32x4){-mref[0], -mref[0], -mref[0], -mref[0]}, (f32x4){-mref[1], -mref[1], -mref[1], -mref[1]}};
#pragma unroll
            for (int ks = 0; ks < 3; ++ks) {
                bf16x8 a[4];
#pragma unroll
                for (int mi = 0; mi < 4; ++mi) a[mi] = *(const bf16x8*)(sK + (mi * 16 + r16) * LK + ks * 32 + kg);
#pragma unroll
                for (int mi = 0; mi < 4; ++mi)
#pragma unroll
                    for (int ni = 0; ni < 2; ++ni) sacc[mi][ni] = __builtin_amdgcn_mfma_f32_16x16x32_bf16(a[mi], qf[ni][ks], ks == 0 ? cin[ni] : sacc[mi][ni], 0, 0, 0);
            }
            if (key0 + 63 > qw0) {
#pragma unroll
                for (int mi = 0; mi < 4; ++mi)
#pragma unroll
                    for (int ni = 0; ni < 2; ++ni)
#pragma unroll
                        for (int r = 0; r < 4; ++r)
                            if (key0 + mi * 16 + g * 4 + r > qw0 + ni * 16 + r16) sacc[mi][ni][r] = -1e30f;
            }
#pragma unroll
            for (int ni = 0; ni < 2; ++ni) {
                float mx = -1e30f;
#pragma unroll
                for (int mi = 0; mi < 4; ++mi)
#pragma unroll
                    for (int r = 0; r < 4; ++r) mx = fmaxf(mx, sacc[mi][ni][r]);
                mx = quad_max(mx);
                if (kt == 0 || __any(mx > ATT_TAU)) {
                    const float d = kt == 0 ? mx : fmaxf(mx, 0.f);
#pragma unroll
                    for (int mi = 0; mi < 4; ++mi)
#pragma unroll
                        for (int r = 0; r < 4; ++r) sacc[mi][ni][r] -= d;
                    const float al = __builtin_amdgcn_exp2f(-d);
                    accL[ni] = accL[ni] * al;
#pragma unroll
                    for (int mo = 0; mo < 4; ++mo) accO[mo][ni] = accO[mo][ni] * al;
                    mref[ni] += d;
                }
#pragma unroll
                for (int mi = 0; mi < 4; ++mi)
#pragma unroll
                    for (int r = 0; r < 4; ++r) sacc[mi][ni][r] = __builtin_amdgcn_exp2f(sacc[mi][ni][r]);
            }
#pragma unroll
            for (int kb = 0; kb < 2; ++kb) {
                bf16x8 pf[2];
#pragma unroll
                for (int ni = 0; ni < 2; ++ni) {
                    const f32x4 s0 = sacc[2 * kb][ni], s1 = sacc[2 * kb + 1][ni];
                    u32x4 pk; pk[0] = pack2(s0[0], s0[1]); pk[1] = pack2(s0[2], s0[3]); pk[2] = pack2(s1[0], s1[1]); pk[3] = pack2(s1[2], s1[3]);
                    pf[ni] = as_bf16x8(pk);
                    accL[ni] = __builtin_amdgcn_mfma_f32_16x16x32_bf16(vones, pf[ni], accL[ni], 0, 0, 0);
                }
#pragma unroll
                for (int mo = 0; mo < 4; ++mo) {
                    const bf16_t* vsrc = sV + (mo * 16 + r16) * LV + 32 * kb + 4 * g;
                    const uint2 lo = *(const uint2*)vsrc, hi = *(const uint2*)(vsrc + 16);
                    u32x4 vv; vv[0] = lo.x; vv[1] = lo.y; vv[2] = hi.x; vv[3] = hi.y;
                    const bf16x8 vf = as_bf16x8(vv);
#pragma unroll
                    for (int ni = 0; ni < 2; ++ni) accO[mo][ni] = __builtin_amdgcn_mfma_f32_16x16x32_bf16(vf, pf[ni], accO[mo][ni], 0, 0, 0);
                }
            }
        }
        __syncthreads();
    }
#pragma unroll
    for (int ni = 0; ni < 2; ++ni) {
        float l = accL[ni][0]; l = quad_sum(l);
        const float inv = 1.f / l;
        const int tok = tokb + qw0 + ni * 16 + r16; float ss = 0.f;
#pragma unroll
        for (int mo = 0; mo < 4; mo += 2) {
            const f32x4 v = accO[mo][ni] * inv, v2 = accO[mo + 1][ni] * inv;
            ss += v[0] * v[0] + v[1] * v[1] + v[2] * v[2] + v[3] * v[3]; ss += v2[0] * v2[0] + v2[1] * v2[1] + v2[2] * v2[2] + v2[3] * v2[3];
            *(uint4*)(s.ao + (size_t)tok * 1024 + h * 64 + mo * 16 + wide_col(g)) = widen_pair(pack4v(v), pack4v(v2));
        }
        ss = quad_sum(ss);
        if (lane < 16) s.a_ss[tok * 8 + h] = ss;
    }
}
__device__ void phase3(const Params& p, unsigned char* smem) {
    const WS s = make_ws(p.ws, p.out);
    for (int u = blockIdx.x; u < 512; u += gridDim.x) {
        const int half = u >> 8, v = u & 255, x = v >> 6, bh = v & 63;
        attn_unit(s, bh >> 3, bh & 7, half ? x : 7 - x, (bf16_t*)smem);
    }
}

DEVINL void router_prefetch_w(const WS& s, u32x4 (&wp)[2][3][3]) {
    int t = threadIdx.x; asm volatile("" : "+v"(t));
    const int kb = 128 * (t >> 6) + 8 * ((t & 63) >> 4), i16 = t & 15;
#pragma unroll
    for (int q = 0; q < 2; ++q)
#pragma unroll
        for (int pc = 0; pc < 3; ++pc)
#pragma unroll
            for (int nt = 0; nt < 3; ++nt) wp[q][pc][nt] = *(const u32x4*)(s.wr3 + (size_t)pc * 48 * 1024 + (size_t)(nt * 16 + i16) * 1024 + kb + 32 * q);
}
DEVINL void router_superunit(const Params& p, const WS& s, unsigned char* smem, const int u, u32x4 (&wp)[2][3][3]) {
    int t = threadIdx.x; asm volatile("" : "+v"(t));
    const int lane = t & 63, w = t >> 6, i16 = lane & 15, g = lane >> 4;
    f32x4* racc = (f32x4*)smem;
    float* slog = (float*)(smem + 98304);
    int* hist = (int*)(smem + 98304 + 12288);
    {
        const int kb = 128 * w + 8 * g;
        f32x4 acc[4][3];
#pragma unroll
        for (int tl = 0; tl < 4; ++tl)
#pragma unroll
            for (int nt = 0; nt < 3; ++nt) acc[tl][nt] = (f32x4){0.f, 0.f, 0.f, 0.f};
        u32x4 xa[4][4], w2[3][3];
#pragma unroll
        for (int q = 0; q < 4; ++q)
#pragma unroll
            for (int tl = 0; tl < 4; ++tl) xa[q][tl] = *(const u32x4*)(s.x1b + (size_t)(u * 64 + tl * 16 + i16) * 1024 + kb + 32 * q);
#pragma unroll
        for (int pc = 0; pc < 3; ++pc)
#pragma unroll
            for (int nt = 0; nt < 3; ++nt) w2[pc][nt] = *(const u32x4*)(s.wr3 + (size_t)pc * 48 * 1024 + (size_t)(nt * 16 + i16) * 1024 + kb + 64);
        asm volatile("" ::: "memory");
#define RT_MMA(q, W) _Pragma("unroll") for (int pc = 0; pc < 3; ++pc) _Pragma("unroll") for (int tl = 0; tl < 4; ++tl) _Pragma("unroll") for (int nt = 0; nt < 3; ++nt) \
            acc[tl][nt] = __builtin_amdgcn_mfma_f32_16x16x32_bf16(as_bf16x8(xa[q][tl]), as_bf16x8(W[pc][nt]), acc[tl][nt], 0, 0, 0)
        RT_MMA(0, wp[0]);
        asm volatile("" ::: "memory");
#pragma unroll
        for (int pc = 0; pc < 3; ++pc)
#pragma unroll
            for (int nt = 0; nt < 3; ++nt) wp[0][pc][nt] = *(const u32x4*)(s.wr3 + (size_t)pc * 48 * 1024 + (size_t)(nt * 16 + i16) * 1024 + kb + 96);
        asm volatile("" ::: "memory");
        RT_MMA(1, wp[1]);
        RT_MMA(2, w2);
        RT_MMA(3, wp[0]);
#undef RT_MMA
        __syncthreads();
#pragma unroll
        for (int tl = 0; tl < 4; ++tl)
#pragma unroll
            for (int nt = 0; nt < 3; ++nt) racc[(w * 12 + tl * 3 + nt) * 64 + lane] = acc[tl][nt];
        if (t < 32) hist[t] = 0;
        __syncthreads();
        for (int item = t; item < 12 * 64; item += NTHR) {
            const int tn = item >> 6, ln = item & 63, tl = tn / 3, nt = tn - tl * 3;
            f32x4 v = racc[tn * 64 + ln];
#pragma unroll
            for (int ww = 1; ww < 8; ++ww) v = v + racc[(ww * 12 + tn) * 64 + ln];
            const int n = nt * 16 + (ln & 15), gq = ln >> 4;
#pragma unroll
            for (int r = 0; r < 4; ++r) slog[(tl * 16 + 4 * gq + r) * 48 + n] = v[r];
        }
        __syncthreads();
        int e0 = 0, e1 = 0, rk0 = 0, rk1 = 0; float gate0 = 0.f, gate1 = 0.f;
        if (t < 64) {
            const float* lg = slog + t * 48;
            const float l0 = lg[0] + p.b_rg[0], l1 = lg[1] + p.b_rg[1], l2 = lg[2] + p.b_rg[2], l3 = lg[3] + p.b_rg[3];
            int gi = 0; float gm = l0;
            if (l1 > gm) { gm = l1; gi = 1; }
            if (l2 > gm) { gm = l2; gi = 2; }
            if (l3 > gm) { gm = l3; gi = 3; }
            const float gp = 1.f / (expf(l0 - gm) + expf(l1 - gm) + expf(l2 - gm) + expf(l3 - gm));
            float le[8];
#pragma unroll
            for (int j = 0; j < 8; ++j) le[j] = lg[4 + gi * 8 + j] + p.b_re[gi * 8 + j];
            int i0 = 0; float m0v = le[0];
#pragma unroll
            for (int j = 1; j < 8; ++j) if (le[j] > m0v) { m0v = le[j]; i0 = j; }
            int i1 = -1; float m1v = -3.0e38f;
#pragma unroll
            for (int j = 0; j < 8; ++j) if (j != i0 && le[j] > m1v) { m1v = le[j]; i1 = j; }
            const float pe1 = expf(m1v - m0v);
            gate0 = gp / (1.f + pe1); gate1 = gp * pe1 / (1.f + pe1);
            e0 = gi * 8 + i0; e1 = gi * 8 + i1;
            rk0 = atomicAdd(&hist[e0], 1); rk1 = atomicAdd(&hist[e1], 1);
        }
        __syncthreads();
        if (t < 32) { const int c = hist[t]; hist[32 + t] = c ? atomicAdd(&s.cnt[t * 64], c) : 0; }
        __syncthreads();
        if (t < 64) {
            const int tk = u * 64 + t;
            const int pos0 = hist[32 + e0] + rk0, pos1 = hist[32 + e1] + rk1;
            s.list[e0 * 16384 + pos0] = tk * 2; s.gatew[tk * 2] = gate0; s.asgep[tk * 2] = (e0 << 16) | pos0;
            s.list[e1 * 16384 + pos1] = tk * 2 + 1; s.gatew[tk * 2 + 1] = gate1; s.asgep[tk * 2 + 1] = (e1 << 16) | pos1;
        }
    }
}

__device__ void phase5(const Params& p, unsigned char* smem) {
    const WS s = make_ws(p.ws, p.out);
    for (int u = blockIdx.x; u < T_ / 64; u += gridDim.x) { u32x4 wpre[2][3][3]; router_prefetch_w(s, wpre); router_superunit(p, s, smem, u, wpre); }
}

struct EpiP4 {
    const Params* p; WS s; unsigned* gcnt; const float2* rsc;
    DEVINL void mid(f32x4 (&acc)[2][2][4][2], const pg8::Unit& u, int wr, int wc, int fr, int fq) const {
#pragma unroll
        for (int ai = 0; ai < 2; ++ai)
#pragma unroll
            for (int m = 0; m < 4; ++m) {
                const float sc = rsc[ai * 128 + wr * 64 + m * 16 + fr].x;
#pragma unroll
                for (int bj = 0; bj < 2; ++bj)
#pragma unroll
                    for (int n = 0; n < 2; ++n) acc[ai][bj][m][n] = acc[ai][bj][m][n] * sc;
            }
    }
    DEVINL void operator()(const f32x4 (&)[2][2][4][2], const pg8::Unit&, int, int, int, int) const {}
    DEVINL void final(f32x4 (&acc)[2][2][4][2], const pg8::Unit& u, int wr_, int wc_, int fr_, int fq_, LAS unsigned char* lds) const {
        float2* red = (float2*)lds;
        int t2 = threadIdx.x; asm volatile("" : "+v"(t2));
        const int wid2 = t2 >> 6, wr = wid2 >> 2, wc = wid2 & 3, fr = t2 & 15, fq = (t2 >> 4) & 3;
        const int row0 = u.a0 * 256 + wr * 64 + fr, col0 = u.a1 * 256 + wc * 32 + fq * 4;
        float rgv[2][4];
#pragma unroll
        for (int ai = 0; ai < 2; ++ai)
#pragma unroll
            for (int m = 0; m < 4; ++m) rgv[ai][m] = rsc[wr * 64 + fr + ai * 128 + m * 16].y;
        const int colw = u.a1 * 256 + wc * 32 + wide_col(fq);
        constexpr int PFD = 4;
        uint4 xn[PFD][2];
#pragma unroll
        for (int d = 0; d < PFD; ++d)
#pragma unroll
            for (int bj = 0; bj < 2; ++bj) xn[d][bj] = *(const uint4*)(s.xb + (size_t)(row0 + (d >> 2) * 128 + (d & 3) * 16) * 1024 + colw + bj * 128);
        asm volatile("" ::: "memory");
#pragma unroll
        for (int it = 0; it < 8; ++it) {
            const int ai = it >> 2, m = it & 3, rl = ai * 128 + wr * 64 + m * 16 + fr;
            uint2 xc[2][2];
#pragma unroll
            for (int bj = 0; bj < 2; ++bj) unwiden(xn[it % PFD][bj], xc[bj][0], xc[bj][1]);
            asm volatile("" ::: "memory");
            if (it + PFD < 8) {
                const int ai2 = (it + PFD) >> 2, m2 = (it + PFD) & 3;
#pragma unroll
                for (int bj = 0; bj < 2; ++bj) xn[it % PFD][bj] = *(const uint4*)(s.xb + (size_t)(row0 + ai2 * 128 + m2 * 16) * 1024 + colw + bj * 128);
            }
            asm volatile("" ::: "memory");
            float sum = 0.f, sq = 0.f;
#pragma unroll
            for (int bj = 0; bj < 2; ++bj)
#pragma unroll
                for (int n = 0; n < 2; ++n) {
                    const f32x4 xf = {bflo(xc[bj][n].x), bfhi(xc[bj][n].x), bflo(xc[bj][n].y), bfhi(xc[bj][n].y)};
                    const f32x4 a = acc[ai][bj][m][n] * rgv[ai][m] + xf * ALPHA_;
                    acc[ai][bj][m][n] = a;
                    sum += (a[0] + a[1]) + (a[2] + a[3]); sq += (a[0] * a[0] + a[1] * a[1]) + (a[2] * a[2] + a[3] * a[3]);
                }
            sum = quad_sum(sum); sq = quad_sum(sq);
            if (fq == 0) red[rl * 4 + wc] = make_float2(sum, sq);
        }
        __syncthreads();
        int tl = threadIdx.x; asm volatile("" : "+v"(tl));
        if (tl < 256) {
            const float2 r0 = red[tl * 4 + 0], r1 = red[tl * 4 + 1], r2 = red[tl * 4 + 2], r3 = red[tl * 4 + 3];
            st_wt8(&s.part[(size_t)(u.a0 * 256 + tl) * 4 + u.a1], make_uint2(__float_as_uint((r0.x + r1.x) + (r2.x + r3.x)), __float_as_uint((r0.y + r1.y) + (r2.y + r3.y))));
        }
        group_sync(gcnt + (u.a0 * 4 + 0) * 64, 4u);
        float mean[2][4], rstd[2][4];
#pragma unroll
        for (int ai = 0; ai < 2; ++ai)
#pragma unroll
            for (int m = 0; m < 4; ++m) {
                const int row = row0 + ai * 128 + m * 16;
                const float4 p01 = *(const float4*)(s.part + (size_t)row * 4), p23 = *(const float4*)(s.part + (size_t)row * 4 + 2);
                const float mu = ((p01.x + p01.z) + (p23.x + p23.z)) * (1.f / 1024.f);
                const float var = ((p01.y + p01.w) + (p23.y + p23.w)) * (1.f / 1024.f) - mu * mu;
                mean[ai][m] = mu; rstd[ai][m] = rsqrtf(fmaxf(var, 0.f) + EPS_);
            }
        f32x4 gg[2][2], bb[2][2];
#pragma unroll
        for (int bj = 0; bj < 2; ++bj)
#pragma unroll
            for (int n = 0; n < 2; ++n) { gg[bj][n] = *(const f32x4*)(p->ln1_g + col0 + bj * 128 + n * 16); bb[bj][n] = *(const f32x4*)(p->ln1_b + col0 + bj * 128 + n * 16); }
#pragma unroll
        for (int ai = 0; ai < 2; ++ai)
#pragma unroll
            for (int m = 0; m < 4; ++m) {
                const int row = row0 + ai * 128 + m * 16;
#pragma unroll
                for (int bj = 0; bj < 2; ++bj) {
                    const f32x4 o0 = (acc[ai][bj][m][0] - mean[ai][m]) * rstd[ai][m] * gg[bj][0] + bb[bj][0], o1 = (acc[ai][bj][m][1] - mean[ai][m]) * rstd[ai][m] * gg[bj][1] + bb[bj][1];
                    st_wt16(s.x1b, (unsigned)(row * 1024 + u.a1 * 256 + wc * 32 + bj * 128 + wide_col(fq)) * 2u, widen_pair(pack4v(o0), pack4v(o1)));
                    *(uint2*)(s.x1f8 + (size_t)row * 1024 + u.a1 * 256 + wc * 32 + bj * 128 + wide_col(fq)) = widen_pair8(pack4_f8(o0[0], o0[1], o0[2], o0[3]), pack4_f8(o1[0], o1[1], o1[2], o1[3]));
                }
            }
        u32x4 wpre[2][3][3]; router_prefetch_w(s, wpre);
        group_sync(gcnt + (u.a0 * 4 + 1) * 64, 4u);
        router_superunit(*p, s, (unsigned char*)lds, u.a0 * 4 + u.a1, wpre);
    }
};
__device__ void phase4(const Params& p, unsigned char* smem) {
    const WS s = make_ws(p.ws, p.out);
    pg8::DenseOrder S{(const char*)s.ao, (const char*)s.wo, 1024, 1024, 64, 4, (int)gridDim.x, (int)blockIdx.x, REP_P4};
    { pg8::Unit u;
      for (int i = 0; S.next(i, u); ++i)
          if (threadIdx.x < 256) {
              const int row = u.a0 * 256 + threadIdx.x;
              const float4 a0 = *(const float4*)(s.a_ss + row * 8), a1 = *(const float4*)(s.a_ss + row * 8 + 4);
              const float4 g0 = *(const float4*)(s.g_ss + row * 8), g1 = *(const float4*)(s.g_ss + row * 8 + 4);
              const float ra = rsqrtf((a0.x + a0.y + a0.z + a0.w + a1.x + a1.y + a1.z + a1.w) * (1.f / 512.f) + EPS_);
              const float rg = rsqrtf((g0.x + g0.y + g0.z + g0.w + g1.x + g1.y + g1.z + g1.w) * (1.f / 512.f) + EPS_);
              ((float2*)(smem + LDS_RED))[threadIdx.x] = make_float2(ra / rg, rg);
          }
      __syncthreads(); }
    EpiP4 E{&p, s, (unsigned*)(p.ws + WS_GCNT), (const float2*)(smem + LDS_RED)};
    pg8::gemm_phase<8, true>((LAS unsigned char*)smem, S, E, 1024, 1024);
}

struct MoeMeta { int cnt[32]; int tstart[33]; int hbase[33]; };
DEVINL void moe_meta(const WS& s, MoeMeta* mm) {
    __syncthreads();
    if (threadIdx.x < 32) mm->cnt[threadIdx.x] = s.cnt[threadIdx.x * 64];
    __syncthreads();
    if (threadIdx.x < 64) {
        const int e = threadIdx.x & 31, c = mm->cnt[e];
        int ts = (c + 255) >> 8, hb = c;
#pragma unroll
        for (int o = 1; o < 32; o <<= 1) { const int a = __shfl_up(ts, o, 32), b = __shfl_up(hb, o, 32); if (e >= o) { ts += a; hb += b; } }
        if (threadIdx.x < 32) { mm->tstart[e + 1] = ts; mm->hbase[e + 1] = hb; if (e == 0) { mm->tstart[0] = 0; mm->hbase[0] = 0; } }
    }
    __syncthreads();
}
struct MoeOrder {
    const MoeMeta* mm; const int* list; const char* Abase; const char* Bbase; size_t bstride_e, bstride_pn; int mode, G, c, rep; unsigned rowbytes;
    DEVINL bool next(int i, pg8::Unit& u) const {
        const int nwg = mm->tstart[32] * 4; const long L = (long)i * G + c; if (L >= (long)nwg * rep) return false;
        int wgid = (int)(L % nwg); { const int q = nwg / 8, r = nwg % 8, xcd = wgid % 8, off = wgid / 8; wgid = (xcd < r ? xcd * (q + 1) : r * (q + 1) + (xcd - r) * q) + off; }
        const int ti = wgid >> 2, pn = wgid & 3;
        const int e = __builtin_popcount((unsigned)__ballot(mm->tstart[(threadIdx.x & 31) + 1] <= ti));
        const int it = ti - mm->tstart[e];
        u.A = Abase; u.B = Bbase + (size_t)e * bstride_e + (size_t)pn * bstride_pn;
        u.a0 = e * 16384 + it * 256; u.a1 = mm->hbase[e] + it * 256; u.a2 = pn; u.a3 = min(256, mm->cnt[e] - it * 256);
        return true;
    }
    DEVINL unsigned arow(const pg8::Unit& u, int r) const {
        const int rr = min(r, u.a3 - 1);
        if (mode == 0) return (unsigned)(list[u.a0 + rr] >> 1) * rowbytes;
        return (unsigned)(u.a1 + rr) * rowbytes;
    }
    DEVINL int ktiles(const pg8::Unit&, int nt) const { return nt; }
};
struct EpiP6 {
    WS s;
    DEVINL void mid(f32x4 (&)[2][2][4][2], const pg8::Unit&, int, int, int, int) const {}
    DEVINL void operator()(const f32x4 (&acc)[2][2][4][2], const pg8::Unit& u, int wr, int wc, int fr, int fq) const {
#pragma unroll
        for (int ai = 0; ai < 2; ++ai)
#pragma unroll
            for (int m = 0; m < 4; ++m) {
                const int r = ai * 128 + wr * 64 + m * 16 + fr;
                unsigned hp[2];
#pragma unroll
                for (int bj = 0; bj < 2; ++bj) {
                    const f32x4 gt = acc[ai][bj][m][0] * (1.f / F8_WSCALE), up = acc[ai][bj][m][1] * (1.f / F8_WSCALE);
                    float hv[4];
#pragma unroll
                    for (int q = 0; q < 4; ++q) hv[q] = gt[q] * fast_sigmoid(gt[q]) * up[q];
                    hp[bj] = pack4_f8(hv[0], hv[1], hv[2], hv[3]);
                }
                const uint2 wv = widen_pair8(hp[0], hp[1]);
                if (r < u.a3) *(uint2*)(s.h8 + (size_t)(u.a1 + r) * 512 + u.a2 * 128 + wc * 32 + wide_col(fq)) = wv;
            }
    }
};
struct EpiP7 {
    WS s;
    DEVINL void mid(f32x4 (&)[2][2][4][2], const pg8::Unit&, int, int, int, int) const {}
    DEVINL void operator()(const f32x4 (&acc)[2][2][4][2], const pg8::Unit& u, int wr, int wc, int fr, int fq) const {
#pragma unroll
        for (int ai = 0; ai < 2; ++ai)
#pragma unroll
            for (int m = 0; m < 4; ++m) {
                const int r = ai * 128 + wr * 64 + m * 16 + fr;
                constexpr float iw = F8_YSCALE / F8_WSCALE;
                uint2 wv[2];
#pragma unroll
                for (int bj = 0; bj < 2; ++bj) {
                    const f32x4 y0 = acc[ai][bj][m][0] * iw, y1 = acc[ai][bj][m][1] * iw;
                    wv[bj] = widen_pair8(pack4_f8(y0[0], y0[1], y0[2], y0[3]), pack4_f8(y1[0], y1[1], y1[2], y1[3]));
                }
                if (r < u.a3) {
#pragma unroll
                    for (int bj = 0; bj < 2; ++bj)
                        *(uint2*)((unsigned char*)s.ymoe + (size_t)(u.a1 + r) * 1024 + u.a2 * 256 + bj * 128 + wc * 32 + wide_col(fq)) = wv[bj];
                }
            }
    }
};
DEVINL void ln2_rows64(const Params& p, const WS& s, const MoeMeta* mm, const int tok0) {
    int t = threadIdx.x; asm volatile("" : "+v"(t));
    const int lane = t & 63, w = t >> 6;
    int2 epv[2][4]; float2 gv[2][4];
#pragma unroll
    for (int hh = 0; hh < 2; ++hh)
#pragma unroll
        for (int r = 0; r < 4; ++r) { const int tok = tok0 + w + 8 * (hh * 4 + r); epv[hh][r] = *(const int2*)(s.asgep + tok * 2); gv[hh][r] = *(const float2*)(s.gatew + tok * 2); }
#pragma unroll
    for (int half = 0; half < 2; ++half) {
        float v[4][16];
#pragma unroll
        for (int r = 0; r < 4; ++r) {
            const int tok = tok0 + w + 8 * (half * 4 + r);
            const int ep0 = epv[half][r].x, ep1 = epv[half][r].y;
            const float g0 = gv[half][r].x * (1.f / F8_YSCALE), g1 = gv[half][r].y * (1.f / F8_YSCALE);
            const size_t r0 = (size_t)(mm->hbase[ep0 >> 16] + (ep0 & 0xffff)) * 1024, r1 = (size_t)(mm->hbase[ep1 >> 16] + (ep1 & 0xffff)) * 1024;
#pragma unroll
            for (int i = 0; i < 2; ++i) {
                const int c = i * 512 + lane * 8;
                const uint4 a = *(const uint4*)(s.x1b + (size_t)tok * 1024 + c);
                const uint2 y0 = *(const uint2*)((const unsigned char*)s.ymoe + r0 + c), y1 = *(const uint2*)((const unsigned char*)s.ymoe + r1 + c);
                const f32x2_t y0a = __builtin_amdgcn_cvt_pk_f32_fp8((int)y0.x, false), y0b = __builtin_amdgcn_cvt_pk_f32_fp8((int)y0.x, true), y0c = __builtin_amdgcn_cvt_pk_f32_fp8((int)y0.y, false), y0d = __builtin_amdgcn_cvt_pk_f32_fp8((int)y0.y, true);
                const f32x2_t y1a = __builtin_amdgcn_cvt_pk_f32_fp8((int)y1.x, false), y1b = __builtin_amdgcn_cvt_pk_f32_fp8((int)y1.x, true), y1c = __builtin_amdgcn_cvt_pk_f32_fp8((int)y1.y, false), y1d = __builtin_amdgcn_cvt_pk_f32_fp8((int)y1.y, true);
                v[r][i * 8 + 0] = ALPHA_ * bflo(a.x) + (g0 * y0a[0] + g1 * y1a[0]); v[r][i * 8 + 1] = ALPHA_ * bfhi(a.x) + (g0 * y0a[1] + g1 * y1a[1]);
                v[r][i * 8 + 2] = ALPHA_ * bflo(a.y) + (g0 * y0b[0] + g1 * y1b[0]); v[r][i * 8 + 3] = ALPHA_ * bfhi(a.y) + (g0 * y0b[1] + g1 * y1b[1]);
                v[r][i * 8 + 4] = ALPHA_ * bflo(a.z) + (g0 * y0c[0] + g1 * y1c[0]); v[r][i * 8 + 5] = ALPHA_ * bfhi(a.z) + (g0 * y0c[1] + g1 * y1c[1]);
                v[r][i * 8 + 6] = ALPHA_ * bflo(a.w) + (g0 * y0d[0] + g1 * y1d[0]); v[r][i * 8 + 7] = ALPHA_ * bfhi(a.w) + (g0 * y0d[1] + g1 * y1d[1]);
            }
        }
        float4 lg[2][2], lb[2][2];
#pragma unroll
        for (int i = 0; i < 2; ++i) { const int c = i * 512 + lane * 8; lg[i][0] = *(const float4*)(p.ln2_g + c); lg[i][1] = *(const float4*)(p.ln2_g + c + 4); lb[i][0] = *(const float4*)(p.ln2_b + c); lb[i][1] = *(const float4*)(p.ln2_b + c + 4); }
#pragma unroll
        for (int r = 0; r < 4; ++r) {
            const int tok = tok0 + w + 8 * (half * 4 + r);
            float sum = 0.f;
#pragma unroll
            for (int i = 0; i < 16; ++i) sum += v[r][i];
            const float mean = wave_sum(sum) * (1.f / 1024.f); float sq = 0.f;
#pragma unroll
            for (int i = 0; i < 16; ++i) { const float d = v[r][i] - mean; sq += d * d; }
            const float rstd = rsqrtf(wave_sum(sq) * (1.f / 1024.f) + EPS_);
            unsigned f8d[4];
#pragma unroll
            for (int i = 0; i < 2; ++i) {
                const int c = i * 512 + lane * 8;
                const float4 gg = lg[i][0], bb = lb[i][0], gh = lg[i][1], bh = lb[i][1];
                const float o0 = (v[r][i * 8 + 0] - mean) * rstd * gg.x + bb.x, o1 = (v[r][i * 8 + 1] - mean) * rstd * gg.y + bb.y, o2 = (v[r][i * 8 + 2] - mean) * rstd * gg.z + bb.z, o3 = (v[r][i * 8 + 3] - mean) * rstd * gg.w + bb.w;
                const float o4 = (v[r][i * 8 + 4] - mean) * rstd * gh.x + bh.x, o5 = (v[r][i * 8 + 5] - mean) * rstd * gh.y + bh.y, o6 = (v[r][i * 8 + 6] - mean) * rstd * gh.z + bh.z, o7 = (v[r][i * 8 + 7] - mean) * rstd * gh.w + bh.w;
                const uint2 lo = pack4(o0, o1, o2, o3), hi = pack4(o4, o5, o6, o7);
                st_wt16(s.x2b, (unsigned)(tok * 1024 + c) * 2u, make_uint4(lo.x, lo.y, hi.x, hi.y));
                f8d[i * 2] = pack4_f8(o0, o1, o2, o3); f8d[i * 2 + 1] = pack4_f8(o4, o5, o6, o7);
            }
            {
                const bool odd = lane & 1;
                const unsigned s0 = odd ? f8d[0] : f8d[2], s1 = odd ? f8d[1] : f8d[3];
                const unsigned r0_ = (unsigned)__builtin_amdgcn_mov_dpp((int)s0, 0xB1, 0xf, 0xf, true), r1_ = (unsigned)__builtin_amdgcn_mov_dpp((int)s1, 0xB1, 0xf, 0xf, true);
                const uint4 o = odd ? make_uint4(r0_, r1_, f8d[2], f8d[3]) : make_uint4(f8d[0], f8d[1], r0_, r1_);
                st_wt16(s.x2f8, (unsigned)(tok * 1024 + (odd ? 512 : 0) + (lane >> 1) * 16), o);
            }
        }
    }
}

__device__ void phase6(const Params& p, unsigned char* smem, MoeMeta* mm) {
    const WS s = make_ws(p.ws, p.out);
    moe_meta(s, mm);
    MoeOrder S{mm, s.list, (const char*)s.x1f8, (const char*)s.wgu8, (size_t)1024 * 1024, (size_t)256 * 1024, 0, (int)gridDim.x, (int)blockIdx.x, REP_P6, 1024u};
    EpiP6 E{s};
    pg8::gemm_phase<0, false, (EPI2 == 6 ? 2 : 1), true>((LAS unsigned char*)smem, S, E, 512, 512);
    int j, nh; helper_slot(mm->tstart[32] * 4 * REP_P6, (int)gridDim.x, (int)blockIdx.x, j, nh);
    if (j >= 0) {
        conv_expert_tiles(p, s, 1, WD_SPLIT * 128 + j, 32 * 128, nh, (float*)smem);
    }
}
__device__ void phase7(const Params& p, unsigned char* smem, MoeMeta* mm) {
    const WS s = make_ws(p.ws, p.out);
#if N_LAUNCH_MODE == 0
    moe_meta(s, mm);
#endif
    MoeOrder S{mm, s.list, (const char*)s.h8, (const char*)s.wd8, (size_t)1024 * 512, (size_t)256 * 512, 1, (int)gridDim.x, (int)blockIdx.x, REP_P7, 512u};
    EpiP7 E{s};
    pg8::gemm_phase<0, false, (EPI2 == 7 ? 2 : 1), true>((LAS unsigned char*)smem, S, E, 256, 256);
    int j, nh; helper_slot(mm->tstart[32] * 4 * REP_P7, (int)gridDim.x, (int)blockIdx.x, j, nh);
    if (j >= 0) {
        PpOrder Sa{(const char*)s.pb, (const char*)s.wpp, gridDim.x == 256 ? 2 : 0, nh, j};
        EpiP9a Ea{(bf16_t*)p.out};
        pg8::gemm_phase<0, false, (EPI2 == 9 ? 2 : 1)>((LAS unsigned char*)smem, Sa, Ea, 256, 256);
    }
}

struct EpiP9b {
    const Params* p; WS s; const bf16_t* pp; unsigned* gcnt;
    DEVINL void mid(f32x4 (&)[2][2][4][2], const pg8::Unit&, int, int, int, int) const {}
    DEVINL void operator()(const f32x4 (&)[2][2][4][2], const pg8::Unit&, int, int, int, int) const {}
    DEVINL void final(f32x4 (&acc)[2][2][4][2], const pg8::Unit& u, int wr_, int wc_, int fr_, int fq_, LAS unsigned char* lds) const {
        float2* red = (float2*)lds;
        int t2 = threadIdx.x; asm volatile("" : "+v"(t2));
        const int wid2 = t2 >> 6, wr = wid2 >> 2, wc = wid2 & 3, fr = t2 & 15, fq = (t2 >> 4) & 3;
        const int row0 = u.a0 * 256 + wr * 64 + fr, col0 = u.a1 * 256 + wc * 32 + fq * 4;
        const int colw = u.a1 * 256 + wc * 32 + wide_col(fq);
        f32x4 bpg[2][2];
#pragma unroll
        for (int bj = 0; bj < 2; ++bj)
#pragma unroll
            for (int n = 0; n < 2; ++n) bpg[bj][n] = *(const f32x4*)(p->b_pg + col0 + bj * 128 + n * 16);
        constexpr int PFD = 3;
        uint4 xn[PFD][2]; uint2 pn_[PFD][2];
#pragma unroll
        for (int d = 0; d < PFD; ++d) {
            const int rn = row0 + (d >> 2) * 128 + (d & 3) * 16;
#pragma unroll
            for (int bj = 0; bj < 2; ++bj) { xn[d][bj] = *(const uint4*)(s.x2b + (size_t)rn * 1024 + colw + bj * 128); pn_[d][bj] = *(const uint2*)((const unsigned char*)pp + pp_off(rn, colw + bj * 128)); }
        }
        asm volatile("" ::: "memory");
#pragma unroll
        for (int it = 0; it < 8; ++it) {
            const int ai = it >> 2, m = it & 3, rl = ai * 128 + wr * 64 + m * 16 + fr;
            float sum = 0.f, sq = 0.f;
#pragma unroll
            for (int bj = 0; bj < 2; ++bj) {
                uint2 xs[2]; unsigned ps[2];
                unwiden(xn[it % PFD][bj], xs[0], xs[1]);
                { const auto r_ = __builtin_amdgcn_permlane16_swap(pn_[it % PFD][bj].x, pn_[it % PFD][bj].y, false, false); ps[0] = r_[0]; ps[1] = r_[1]; }
#pragma unroll
                for (int n = 0; n < 2; ++n) {
                    const f32x4 a = acc[ai][bj][m][n] * (1.f / F8_WSCALE) + bpg[bj][n];
                    const uint2 xr = xs[n];
                    const f32x2_t p01 = __builtin_amdgcn_cvt_pk_f32_fp8((int)ps[n], false), p23 = __builtin_amdgcn_cvt_pk_f32_fp8((int)ps[n], true);
                    f32x4 o;
                    o[0] = ALPHA_ * bflo(xr.x) + (p01[0] * (1.f / F8_YSCALE)) * fast_sigmoid(a[0]);
                    o[1] = ALPHA_ * bfhi(xr.x) + (p01[1] * (1.f / F8_YSCALE)) * fast_sigmoid(a[1]);
                    o[2] = ALPHA_ * bflo(xr.y) + (p23[0] * (1.f / F8_YSCALE)) * fast_sigmoid(a[2]);
                    o[3] = ALPHA_ * bfhi(xr.y) + (p23[1] * (1.f / F8_YSCALE)) * fast_sigmoid(a[3]);
                    acc[ai][bj][m][n] = o;
                    sum += (o[0] + o[1]) + (o[2] + o[3]); sq += (o[0] * o[0] + o[1] * o[1]) + (o[2] * o[2] + o[3] * o[3]);
                }
            }
            asm volatile("" ::: "memory");
            if (it + PFD < 8) {
                const int rn = row0 + ((it + PFD) >> 2) * 128 + ((it + PFD) & 3) * 16; const size_t ro = (size_t)rn * 1024 + colw;
#pragma unroll
                for (int bj = 0; bj < 2; ++bj) { xn[it % PFD][bj] = *(const uint4*)(s.x2b + ro + bj * 128); pn_[it % PFD][bj] = *(const uint2*)((const unsigned char*)pp + pp_off(rn, colw + bj * 128)); }
            }
            asm volatile("" ::: "memory");
            sum = quad_sum(sum); sq = quad_sum(sq);
            if (fq == 0) red[rl * 4 + wc] = make_float2(sum, sq);
        }
        __syncthreads();
        int tl = threadIdx.x; asm volatile("" : "+v"(tl));
        if (tl < 256) {
            const float2 r0 = red[tl * 4 + 0], r1 = red[tl * 4 + 1], r2 = red[tl * 4 + 2], r3 = red[tl * 4 + 3];
            st_wt8(&s.part[(size_t)(u.a0 * 256 + tl) * 4 + u.a1], make_uint2(__float_as_uint((r0.x + r1.x) + (r2.x + r3.x)), __float_as_uint((r0.y + r1.y) + (r2.y + r3.y))));
        }
        group_sync(gcnt + (u.a0 * 4 + 2) * 64, 4u);
        float mean[2][4], rstd[2][4];
#pragma unroll
        for (int ai = 0; ai < 2; ++ai)
#pragma unroll
            for (int m = 0; m < 4; ++m) {
                const int row = row0 + ai * 128 + m * 16;
                const float4 p01 = *(const float4*)(s.part + (size_t)row * 4), p23 = *(const float4*)(s.part + (size_t)row * 4 + 2);
                const float mu = ((p01.x + p01.z) + (p23.x + p23.z)) * (1.f / 1024.f);
                const float var = ((p01.y + p01.w) + (p23.y + p23.w)) * (1.f / 1024.f) - mu * mu;
                mean[ai][m] = mu; rstd[ai][m] = rsqrtf(fmaxf(var, 0.f) + EPS_);
            }
        f32x4 g3[2][2], b3[2][2];
#pragma unroll
        for (int bj = 0; bj < 2; ++bj)
#pragma unroll
            for (int n = 0; n < 2; ++n) { g3[bj][n] = *(const f32x4*)(p->ln3_g + col0 + bj * 128 + n * 16); b3[bj][n] = *(const f32x4*)(p->ln3_b + col0 + bj * 128 + n * 16); }
#pragma unroll
        for (int ai = 0; ai < 2; ++ai)
#pragma unroll
            for (int m = 0; m < 4; ++m) {
                const int row = row0 + ai * 128 + m * 16;
#pragma unroll
                for (int bj = 0; bj < 2; ++bj)
#pragma unroll
                    for (int n = 0; n < 2; ++n) {
                        const f32x4 gg = g3[bj][n], bb = b3[bj][n];
                        *(f32x4*)(p->out + (size_t)row * 1024 + col0 + bj * 128 + n * 16) = (acc[ai][bj][m][n] - mean[ai][m]) * rstd[ai][m] * gg + bb;
                    }
                asm volatile("" ::: "memory");
            }
    }
};
__device__ void phase9(const Params& p, unsigned char* smem, MoeMeta* mm) {
    const WS s = make_ws(p.ws, p.out);
#if N_LAUNCH_MODE == 0
    moe_meta(s, mm);
#endif
    unsigned* gcnt = (unsigned*)(p.ws + WS_GCNT);
    pg8::DenseOrder S{(const char*)s.x2f8, (const char*)s.wpg, 512, 512, 64, 4, (int)gridDim.x, (int)blockIdx.x, 1};
    pg8::Unit u0;
    if (!S.next(0, u0)) return;
    ln2_rows64(p, s, mm, u0.a0 * 256 + u0.a1 * 64);
    group_sync(gcnt + (u0.a0 * 4 + 3) * 64, 4u);
    const bf16_t* pp = (const bf16_t*)p.out;
    {
        EpiP9b E{&p, s, pp, gcnt};
        pg8::gemm_phase<0, true, 1, true>((LAS unsigned char*)smem, S, E, 512, 512);
    }
}

constexpr int NPHASE = 11;
template <int LO, int HI>
__global__ void __launch_bounds__(NTHR, 2) fwd_kernel(Params p) {
    extern __shared__ __attribute__((aligned(16))) unsigned char smem[];
    MoeMeta& mm = *(MoeMeta*)(smem + LDS_META);
    XcdBarrier bar;
    if (HI - LO > 1) {
        if (threadIdx.x < 4) ((unsigned*)(smem + LDS_XB))[threadIdx.x] = 0u;
        __syncthreads();
        bar = xcd_barrier_post((unsigned*)(p.ws + WS_BAR), (volatile LAS unsigned*)(smem + LDS_XB));
#if USE_COOP
        if (p.use_cg_sync) cg::this_grid().sync();
#endif
    }
#ifndef REP_PHASE
#define REP_PHASE -1
#endif
#define PH(k) _Pragma("nounroll") for (int rep_ = 0; rep_ < ((REP_PHASE == (k)) ? 2 + p.use_cg_sync : 1); ++rep_) if (LO <= (k) && (k) < HI)
#define SYNC(k) if (LO <= (k) && (k) + 1 < HI) { if ((k) == LO) xcd_barrier<true>(bar); else xcd_barrier<false>(bar); }
    PH(0) { phase0(p, smem); if (REP_PHASE == 0 && rep_ == 0) xcd_barrier<true>(bar); } SYNC(0)
    PH(1) { phase1(p, smem); if (REP_PHASE == 1 && rep_ == 0) xcd_barrier(bar); } SYNC(1)
    PH(2) { phase2(p, smem, REP_PHASE != 2 || rep_ == 1); if (REP_PHASE == 2 && rep_ == 0) xcd_barrier(bar); } SYNC(2)
    PH(3) { phase3(p, smem); if (REP_PHASE == 3 && rep_ == 0) xcd_barrier(bar); } SYNC(3)
    PH(4) { phase4(p, smem); } SYNC(4)
    PH(6) { phase6(p, smem, &mm); if (REP_PHASE == 6 && rep_ == 0) xcd_barrier(bar); } SYNC(6)
    PH(7) { phase7(p, smem, &mm); if (REP_PHASE == 7 && rep_ == 0) xcd_barrier(bar); } SYNC(7)
    PH(9) { phase9(p, smem, &mm); }
#undef PH
#undef SYNC
}

template <int K> static void launch_one(const Params& prm, int grid, hipStream_t stream) {
    hipFuncSetAttribute((const void*)fwd_kernel<K, K + 1>, hipFuncAttributeMaxDynamicSharedMemorySize, LDS_BYTES);
    hipLaunchKernelGGL((fwd_kernel<K, K + 1>), dim3(grid), dim3(NTHR), LDS_BYTES, stream, prm);
}

extern "C" void kernel_launch(void* const* d_in, const int* in_sizes, int n_in, void* d_out, int out_size, void* d_ws, size_t ws_size,
                              hipStream_t stream) {
    if (n_in != 31 || ws_size < WS_END) { fprintf(stderr, "kernel_launch: unexpected n_in %d / ws_size %zu\n", n_in, ws_size); return; }
    Params prm{};
    prm.x = (const float*)d_in[0]; prm.p = (const float*)d_in[1]; prm.pos = (const int*)d_in[2];
    prm.w_in = (const float*)d_in[3]; prm.q_norm_g = (const float*)d_in[4]; prm.w_q_up = (const float*)d_in[5];
    prm.kv_norm_g = (const float*)d_in[6]; prm.w_kv_up = (const float*)d_in[7]; prm.gm_ln_g = (const float*)d_in[8];
    prm.gm_ln_b = (const float*)d_in[9]; prm.gm_w_s = (const float*)d_in[10]; prm.gm_b_s = (const float*)d_in[11];
    prm.mla_out_g = (const float*)d_in[12]; prm.gm_out_g = (const float*)d_in[13]; prm.w_o = (const float*)d_in[14];
    prm.ln1_g = (const float*)d_in[15]; prm.ln1_b = (const float*)d_in[16]; prm.w_rg = (const float*)d_in[17];
    prm.b_rg = (const float*)d_in[18]; prm.w_re = (const float*)d_in[19]; prm.b_re = (const float*)d_in[20];
    prm.w_gate = (const float*)d_in[21]; prm.w_up = (const float*)d_in[22]; prm.w_down = (const float*)d_in[23];
    prm.ln2_g = (const float*)d_in[24]; prm.ln2_b = (const float*)d_in[25]; prm.w_pg = (const float*)d_in[26];
    prm.b_pg = (const float*)d_in[27]; prm.w_pp = (const float*)d_in[28]; prm.ln3_g = (const float*)d_in[29];
    prm.ln3_b = (const float*)d_in[30];
    prm.out = (float*)d_out; prm.ws = (unsigned char*)d_ws;
    for (int j = 0; j < 16; ++j) prm.inv_freq[j] = (float)pow(10000.0, -(double)j / 16.0);
#if N_LAUNCH_MODE == 0
    const int grid = 1024;
    launch_one<0>(prm, grid, stream); launch_one<1>(prm, grid, stream); launch_one<2>(prm, grid, stream);
    launch_one<3>(prm, grid, stream); launch_one<4>(prm, grid, stream); launch_one<5>(prm, grid, stream);
    launch_one<6>(prm, grid, stream); launch_one<7>(prm, grid, stream); launch_one<8>(prm, grid, stream);
    launch_one<9>(prm, grid, stream); launch_one<10>(prm, grid, stream);
#else
    static int grid_blocks = 0;
    if (!grid_blocks) {
        int dev = 0, cus = 0, per_cu = 0;
        hipGetDevice(&dev);
        hipDeviceGetAttribute(&cus, hipDeviceAttributeMultiprocessorCount, dev);
        if (hipFuncSetAttribute((const void*)fwd_kernel<0, NPHASE>, hipFuncAttributeMaxDynamicSharedMemorySize, LDS_BYTES) != hipSuccess)
            fprintf(stderr, "kernel_launch: hipFuncSetAttribute(%d B dynamic LDS) failed\n", LDS_BYTES);
        hipOccupancyMaxActiveBlocksPerMultiprocessor(&per_cu, (const void*)fwd_kernel<0, NPHASE>, NTHR, LDS_BYTES);
        if (per_cu < 1) fprintf(stderr, "kernel_launch: occupancy query reports %d blocks per CU\n", per_cu);
        (void)hipGetLastError();
        grid_blocks = cus;
    }
    static_assert(XCD_BAR_WORDS == XCD_BAR_WORDS_C, "barrier size");
    hipMemsetAsync((unsigned char*)d_ws + WS_BAR, 0, (WS_GCNT - WS_BAR) + 64 * 4 * 256, stream);
#if USE_COOP
    void* args[] = {&prm};
    hipError_t e = hipLaunchCooperativeKernel((const void*)fwd_kernel<0, NPHASE>, dim3(grid_blocks), dim3(NTHR), args, LDS_BYTES, stream);
    if (e != hipSuccess) fprintf(stderr, "cooperative launch failed: %s (grid %d)\n", hipGetErrorString(e), grid_blocks);
#else
    hipLaunchKernelGGL((fwd_kernel<0, NPHASE>), dim3(grid_blocks), dim3(NTHR), LDS_BYTES, stream, prm);
#endif
#endif
}
```
